# Optimizing an MI355X kernel written in HIP

```python
import math
import jax, jax.numpy as jnp
from jax import lax
import numpy as np

D_MODEL = 1024
BATCH = 32
SEQ = 2048
DEPTH = 1

HEAD_DIM = 64
MIX_WIDTH = D_MODEL
N_HEADS_A = (MIX_WIDTH // 2) // HEAD_DIM
N_HEADS_B = (MIX_WIDTH // 2) // HEAD_DIM
D_NOPE = HEAD_DIM
D_ROPE = HEAD_DIM // 2
KV_RANK = 2 * HEAD_DIM
V_DIM = HEAD_DIM
IDX_HEADS = 8
IDX_DIM = HEAD_DIM
TOPK_MAX = 256
Q_BLOCK = 128
DILATED_PATTERNS = ((128, 1), (512, 4), (2048, 16))
CROSS_HEADS = 4
CROSS_HEAD_DIM = D_MODEL // CROSS_HEADS
MEM_TOKENS = 256
D_FF = 4 * D_MODEL
ROPE_THETA = 10000.0
NORM_EPS = 1e-6

IN_SIZES = (N_HEADS_A * D_NOPE,
            N_HEADS_A * D_ROPE,
            KV_RANK,
            D_ROPE,
            IDX_HEADS * IDX_DIM,
            IDX_DIM,
            IDX_HEADS,
            3 * N_HEADS_B * HEAD_DIM)
IN_COLS = 512 + 256 + 128 + 32 + 512 + 64 + 8 + 1536 if D_MODEL == 1024 else int(np.sum(IN_SIZES))

kernel_name = "hybrid_dsa_dilated_xattn_block"


def rmsnorm(x, g):
    xf = x.astype(jnp.float32)
    y = xf * lax.rsqrt(jnp.mean(xf * xf, axis=-1, keepdims=True) + NORM_EPS)
    return (y * g.astype(jnp.float32)).astype(x.dtype)


def rope(x):
    S, d = x.shape[1], x.shape[-1]
    inv = ROPE_THETA ** (-jnp.arange(0, d, 2, dtype=jnp.float32) / d)
    ang = jnp.arange(S, dtype=jnp.float32)[:, None] * inv[None, :]
    cos = jnp.cos(ang)[None, :, None, :].astype(x.dtype)
    sin = jnp.sin(ang)[None, :, None, :].astype(x.dtype)
    x1, x2 = jnp.split(x, 2, axis=-1)
    return jnp.concatenate([x1 * cos - x2 * sin, x2 * cos + x1 * sin], axis=-1)


def dsa_sparse_attention(q_nope, q_rope, c_kv, k_rope, q_idx, k_idx, w_idx, w_uk, w_uv):
    B, S = q_nope.shape[0], q_nope.shape[1]
    topk = min(TOPK_MAX, S // 4)
    nb = S // Q_BLOCK
    scale = (D_NOPE + D_ROPE) ** -0.5
    q_lat = jnp.einsum('bshn,hnc->bshc', q_nope, w_uk)
    w_eff = w_idx.astype(jnp.float32) * (IDX_HEADS ** -0.5) * (IDX_DIM ** -0.5)
    key_pos = jnp.arange(S)
    gather = jax.vmap(lambda table, ix: table[ix])

    def to_blocks(a):
        return jnp.moveaxis(a.reshape((B, nb, Q_BLOCK) + a.shape[2:]), 1, 0)

    def block(args):
        ql, qr, qi, wi, blk = args
        q_pos = blk * Q_BLOCK + jnp.arange(Q_BLOCK)
        causal = key_pos[None, :] <= q_pos[:, None]
        logits = jnp.einsum('bqhd,bsd->bhqs', qi, k_idx).astype(jnp.float32)
        index = jnp.einsum('bhqs,bqh->bqs', jax.nn.relu(logits), wi)
        index = jnp.where(causal[None], index, -jnp.inf)
        _, sel = lax.top_k(index, topk)
        valid = sel <= q_pos[None, :, None]
        c_sel = gather(c_kv, sel)
        r_sel = gather(k_rope, sel)
        s = (jnp.einsum('bqhc,bqkc->bhqk', ql, c_sel)
             + jnp.einsum('bqhr,bqkr->bhqk', qr, r_sel)).astype(jnp.float32) * scale
        s = jnp.where(valid[:, None], s, -jnp.inf)
        p = jax.nn.softmax(s, axis=-1).astype(c_sel.dtype)
        return jnp.einsum('bhqk,bqkc->bqhc', p, c_sel)

    o_lat = lax.map(block, (to_blocks(q_lat), to_blocks(q_rope), to_blocks(q_idx),
                            to_blocks(w_eff), jnp.arange(nb)))
    o_lat = jnp.moveaxis(o_lat, 0, 1).reshape(B, S, N_HEADS_A, KV_RANK)
    return jnp.einsum('bshc,hcv->bshv', o_lat, w_uv)


def dilated_pattern(q, k, v, window, dilation):
    B, H, S, d = q.shape
    n = S // dilation
    w_sub = window // dilation
    nb = -(-n // Q_BLOCK)
    pad = nb * Q_BLOCK - n

    def split(a):
        a = a.reshape(B, H, n, dilation, d).transpose(0, 1, 3, 2, 4)
        a = jnp.pad(a, ((0, 0), (0, 0), (0, 0), (0, pad), (0, 0)))
        return a.reshape(B, H, dilation, nb, Q_BLOCK, d)

    def with_prev(a):
        prev = jnp.concatenate([jnp.zeros_like(a[:, :, :, :1]), a[:, :, :, :-1]], axis=3)
        return jnp.concatenate([prev, a], axis=4)

    qb = split(q)
    kk = with_prev(split(k))
    vv = with_prev(split(v))
    s = jnp.einsum('bhrnqd,bhrnkd->bhrnqk', qb, kk).astype(jnp.float32) * (d ** -0.5)
    rel = (jnp.arange(Q_BLOCK)[:, None] + Q_BLOCK) - jnp.arange(2 * Q_BLOCK)[None, :]
    band = (rel >= 0) & (rel <= w_sub)
    has_prev = (jnp.arange(nb)[:, None, None] > 0) | (jnp.arange(2 * Q_BLOCK)[None, None, :] >= Q_BLOCK)
    mask = band[None] & has_prev
    s = jnp.where(mask, s, -jnp.inf)
    lse = jax.nn.logsumexp(s, axis=-1)
    p = jnp.exp(s - lse[..., None]).astype(v.dtype)
    o = jnp.einsum('bhrnqk,bhrnkd->bhrnqd', p, vv)

    def merge(a, tail):
        a = a.reshape((B, H, dilation, nb * Q_BLOCK) + tail)[:, :, :, :n]
        return jnp.swapaxes(a, 2, 3).reshape((B, H, S) + tail)

    return merge(o, (d,)), merge(lse, ())


def dilated_attention(q, k, v):
    outs, lses = [], []
    for window, dilation in DILATED_PATTERNS:
        o, l = dilated_pattern(q, k, v, window, dilation)
        outs.append(o)
        lses.append(l)
    alpha = jax.nn.softmax(jnp.stack(lses, axis=0), axis=0).astype(q.dtype)
    return jnp.sum(alpha[..., None] * jnp.stack(outs, axis=0), axis=0)


def setup_inputs(seed: int = 0) -> dict:
    key = jax.random.key(seed)
    ks = jax.random.split(key, 20)
    f32 = jnp.float32

    def w(k, shape, fan_in):
        return jax.random.normal(k, shape, f32) * (fan_in ** -0.5)

    def gain(k, shape):
        return 1.0 + 0.02 * jax.random.normal(k, shape, f32)

    L = DEPTH
    return {
        "x": jax.random.normal(ks[0], (BATCH, SEQ, D_MODEL), f32),
        "mem": jax.random.normal(ks[1], (BATCH, MEM_TOKENS, D_MODEL), f32),
        "norm_mix_g": gain(ks[2], (L, D_MODEL)),
        "w_in": w(ks[3], (L, D_MODEL, IN_COLS), D_MODEL),
        "kv_norm_g": gain(ks[4], (L, KV_RANK)),
        "w_uk": w(ks[5], (L, N_HEADS_A, D_NOPE, KV_RANK), D_NOPE),
        "w_uv": w(ks[6], (L, N_HEADS_A, KV_RANK, V_DIM), KV_RANK),
        "w_out": w(ks[7], (L, N_HEADS_A * V_DIM + N_HEADS_B * HEAD_DIM, D_MODEL), MIX_WIDTH),
        "norm_cross_g": gain(ks[8], (L, D_MODEL)),
        "norm_mem_g": gain(ks[9], (L, D_MODEL)),
        "w_q_cross": w(ks[10], (L, D_MODEL, CROSS_HEADS * CROSS_HEAD_DIM), D_MODEL),
        "w_kv_cross": w(ks[11], (L, D_MODEL, 2 * CROSS_HEADS * CROSS_HEAD_DIM), D_MODEL),
        "w_o_cross": w(ks[12], (L, CROSS_HEADS * CROSS_HEAD_DIM, D_MODEL), CROSS_HEADS * CROSS_HEAD_DIM),
        "norm_mlp_g": gain(ks[13], (L, D_MODEL)),
        "w_up": w(ks[14], (L, D_MODEL, D_FF), D_MODEL),
        "w_down": w(ks[15], (L, D_FF, D_MODEL), D_FF),
        "norm_final_g": gain(ks[16], (D_MODEL,)),
    }


def reference(x, mem, norm_mix_g, w_in, kv_norm_g, w_uk, w_uv, w_out, norm_cross_g, norm_mem_g,
              w_q_cross, w_kv_cross, w_o_cross, norm_mlp_g, w_up, w_down, norm_final_g):
    B, S, _ = x.shape
    M = mem.shape[1]
    split_at = [int(c) for c in np.cumsum(IN_SIZES)[:-1]]
    for l in range(DEPTH):
        h = rmsnorm(x, norm_mix_g[l])
        proj = h @ w_in[l]
        p_qn, p_qr, p_ckv, p_kr, p_qi, p_ki, p_wi, p_qkv = jnp.split(proj, split_at, axis=-1)
        q_nope = p_qn.reshape(B, S, N_HEADS_A, D_NOPE)
        q_rope = rope(p_qr.reshape(B, S, N_HEADS_A, D_ROPE))
        c_kv = rmsnorm(p_ckv, kv_norm_g[l])
        k_rope = rope(p_kr[:, :, None, :])[:, :, 0]
        q_idx = rope(p_qi.reshape(B, S, IDX_HEADS, IDX_DIM))
        k_idx = rope(p_ki[:, :, None, :])[:, :, 0]
        o_a = dsa_sparse_attention(q_nope, q_rope, c_kv, k_rope, q_idx, k_idx, p_wi, w_uk[l], w_uv[l])
        qkv = p_qkv.reshape(B, S, 3, N_HEADS_B, HEAD_DIM)
        q_b = rope(qkv[:, :, 0]).transpose(0, 2, 1, 3)
        k_b = rope(qkv[:, :, 1]).transpose(0, 2, 1, 3)
        v_b = qkv[:, :, 2].transpose(0, 2, 1, 3)
        o_b = dilated_attention(q_b, k_b, v_b).transpose(0, 2, 1, 3)
        heads = jnp.concatenate([o_a.reshape(B, S, N_HEADS_A * V_DIM),
                                 o_b.reshape(B, S, N_HEADS_B * HEAD_DIM)], axis=-1)
        x = x + heads @ w_out[l]
        hc = rmsnorm(x, norm_cross_g[l])
        m = rmsnorm(mem, norm_mem_g[l])
        qc = (hc @ w_q_cross[l]).reshape(B, S, CROSS_HEADS, CROSS_HEAD_DIM)
        kvc = (m @ w_kv_cross[l]).reshape(B, M, 2, CROSS_HEADS, CROSS_HEAD_DIM)
        sc = jnp.einsum('bshd,bmhd->bhsm', qc, kvc[:, :, 0]).astype(jnp.float32) * (CROSS_HEAD_DIM ** -0.5)
        pc = jax.nn.softmax(sc, axis=-1).astype(x.dtype)
        oc = jnp.einsum('bhsm,bmhd->bshd', pc, kvc[:, :, 1]).reshape(B, S, CROSS_HEADS * CROSS_HEAD_DIM)
        x = x + oc @ w_o_cross[l]
        hm = rmsnorm(x, norm_mlp_g[l])
        x = x + jnp.square(jax.nn.relu(hm @ w_up[l])) @ w_down[l]
    return rmsnorm(x, norm_final_g)
```

```cpp
#include <hip/hip_runtime.h>
#include <hip/hip_cooperative_groups.h>
#include <cstdio>
#include <cstdint>
namespace cg = cooperative_groups;
namespace pg8 {
#define PG8_LAS __attribute__((address_space(3)))
typedef unsigned short bf16_t;
typedef short bf16x8 __attribute__((ext_vector_type(8)));
typedef float f32x4 __attribute__((ext_vector_type(4)));
typedef unsigned u32x4 __attribute__((ext_vector_type(4)));
constexpr int BM = 256, BK = 64, HALF = 128, HTB = HALF * BK * 2  , STAGE_BYTES = 8 * HTB, NXCD = 8, WGM = 8;

__host__ __device__ __forceinline__ int lds_byte(int r, int c) { const int st = (r >> 4) * 2 + (c >> 5), rr = r & 15, cc = c & 31, ob = rr * 64 + cc * 2; return st * 1024 + (ob ^ (((ob >> 9) & 1) << 5)); }
__host__ __device__ __forceinline__ void stage_rc(int b, int& R, int& C) { const int st = b / 1024, sb = b % 1024, swz = sb ^ (((sb >> 9) & 1) << 5); R = (st >> 1) * 16 + swz / 64; C = (st & 1) * 32 + (swz % 64) / 2; }
__host__ __device__ __forceinline__ int perm32(int rho) { const int n = rho >> 4, i = rho & 15; return 8 * (i >> 2) + 4 * n + (i & 3); }

struct Unit { int pm, pn; };
struct Gemm { const bf16_t* A; const bf16_t* Bt; int M, N, K; };

struct StaticOrder {
    int nM, nN, nwg, G, c;
    __host__ __device__ void init(int M, int N, int G_, int c_) { nM = M / BM; nN = N / BM; nwg = nM * nN; G = G_; c = c_; }
    __host__ __device__ bool next(int i, Unit& u) const {
        const long L = (long)i * G + c; if (L >= nwg) return false;
        int wgid = (int)L; { const int q = nwg / NXCD, r = nwg % NXCD, xcd = wgid % NXCD, off = wgid / NXCD; wgid = (xcd < r ? xcd * (q + 1) : r * (q + 1) + (xcd - r) * q) + off; }
        const int nig = WGM * nN, gid = wgid / nig, fm = gid * WGM, gsz = (nM - fm) < WGM ? (nM - fm) : WGM;
        u.pm = fm + ((wgid % nig) % gsz); u.pn = (wgid % nig) / gsz; return true;
    }
    __device__ __forceinline__ void a_ready(const Unit&) const {}
    __device__ __forceinline__ void done(const Unit&) const {}
};


template <class Epi, class Sched, bool ALIGN_EPI = false, bool SP2 = false>
__device__ __forceinline__ void gemm_phase(PG8_LAS unsigned char* lds, const Gemm g, const Sched& S, const Epi& E) {
    int tid_ = threadIdx.x; asm volatile("" : "+v"(tid_));
    const int tid = tid_, wid = __builtin_amdgcn_readfirstlane(tid >> 6), lane = tid & 63, wr = wid >> 2, wc = wid & 3, fr = lane & 15, fq = lane >> 4;
    const int K = g.K, nt = K / BK;
    unsigned voffA[2], voffB[2];
#pragma unroll
    for (int i = 0; i < 2; ++i) { int R, C; stage_rc(tid * 16 + i * 8192, R, C); const int Rb = Epi::PERM ? ((R & ~31) + perm32(R & 31)) : R;
        voffA[i] = (unsigned)(R * K + C) * 2u; voffB[i] = (unsigned)(Rb * K + C) * 2u; }
    const size_t kstep = (size_t)(BK * 2);
    const size_t hstep = (size_t)HALF * K * 2;
    const size_t tstep = 2 * hstep;
    const unsigned ldsw = (unsigned)wid * 1024u;
    const int aoff = lds_byte(wr * 64 + fr, fq * 8), boff = lds_byte(wc * 32 + fr, fq * 8);
#define PG8_SA(b, h) (((b) * 2 + (h)) * HTB)
#define PG8_SB(b, h) ((4 + (b) * 2 + (h)) * HTB)
#define PG8_STAGE(bufoff, gbase, voff) do { _Pragma("unroll") for (int _i = 0; _i < 2; ++_i) \
        __builtin_amdgcn_global_load_lds((const unsigned*)((const char*)(gbase) + (voff)[_i]), (PG8_LAS unsigned*)(lds + (bufoff) + ldsw + _i * 8192), 16, 0, 0); } while (0)
#define PG8_LDA(dst, b, h) do { _Pragma("unroll") for (int m = 0; m < 4; ++m) _Pragma("unroll") for (int k = 0; k < 2; ++k) dst[m][k] = *(const PG8_LAS bf16x8*)(lds + PG8_SA(b, h) + aoff + m * 2048 + k * 1024); } while (0)
#define PG8_LDB(dst, b, h) do { _Pragma("unroll") for (int n = 0; n < 2; ++n) _Pragma("unroll") for (int k = 0; k < 2; ++k) dst[n][k] = *(const PG8_LAS bf16x8*)(lds + PG8_SB(b, h) + boff + n * 2048 + k * 1024); } while (0)
#define PG8_MMA(ai, bj, At, Bt) do { __builtin_amdgcn_s_setprio(1); _Pragma("unroll") for (int m = 0; m < 4; ++m) _Pragma("unroll") for (int n = 0; n < 2; ++n) _Pragma("unroll") for (int k = 0; k < 2; ++k) \
        acc[ai][bj][m][n] = __builtin_amdgcn_mfma_f32_16x16x32_bf16(Bt[n][k], At[m][k], acc[ai][bj][m][n], 0, 0, 0); __builtin_amdgcn_s_setprio(0); } while (0)
#define PG8_WAIT_V(n) asm volatile("s_waitcnt vmcnt(" #n ")" ::: "memory")
#define PG8_WAIT_L(n) asm volatile("s_waitcnt lgkmcnt(" #n ")" ::: "memory")
#define PG8_BAR __builtin_amdgcn_s_barrier()
#define PG8_SCHED __builtin_amdgcn_sched_barrier(0)
    Unit cur, nxt; int ui = 0;
    if (!S.next(0, cur)) return;
    f32x4 acc[2][2][4][2];
#pragma unroll
    for (int a = 0; a < 2; ++a)
#pragma unroll
        for (int b = 0; b < 2; ++b)
#pragma unroll
            for (int m = 0; m < 4; ++m)
#pragma unroll
                for (int n = 0; n < 2; ++n) acc[a][b][m][n] = (f32x4){0.f, 0.f, 0.f, 0.f};
    bf16x8 At[4][2], B0[2][2], B1[2][2];
    const char* cA = (const char*)g.A + (size_t)cur.pm * tstep; const char* cB = (const char*)g.Bt + (size_t)cur.pn * tstep;
    S.a_ready(cur);
    if constexpr (SP2) {
        PG8_STAGE(PG8_SB(0, 0), cB, voffB); PG8_STAGE(PG8_SB(0, 1), cB + hstep, voffB); PG8_STAGE(PG8_SA(0, 0), cA, voffA); PG8_STAGE(PG8_SA(0, 1), cA + hstep, voffA);
        if (wr == 1) PG8_BAR;
        PG8_WAIT_V(2); PG8_BAR;
        PG8_STAGE(PG8_SB(1, 0), cB + kstep, voffB); PG8_STAGE(PG8_SA(1, 0), cA + kstep, voffA); PG8_STAGE(PG8_SB(1, 1), cB + hstep + kstep, voffB);
        PG8_WAIT_V(6); PG8_BAR;
    } else {
        PG8_STAGE(PG8_SB(0, 0), cB, voffB); PG8_STAGE(PG8_SA(0, 0), cA, voffA); PG8_STAGE(PG8_SB(0, 1), cB + hstep, voffB); PG8_STAGE(PG8_SA(0, 1), cA + hstep, voffA);
        if (wr == 1) PG8_BAR;
        PG8_WAIT_V(4); PG8_BAR;
        PG8_STAGE(PG8_SB(1, 0), cB + kstep, voffB); PG8_STAGE(PG8_SA(1, 0), cA + kstep, voffA); PG8_STAGE(PG8_SB(1, 1), cB + hstep + kstep, voffB);
        PG8_WAIT_V(6); PG8_BAR;
    }
    for (;;) {
        const bool has_next = S.next(ui + 1, nxt);
        const char* nA = has_next ? (const char*)g.A + (size_t)nxt.pm * tstep : cA; const char* nB = has_next ? (const char*)g.Bt + (size_t)nxt.pn * tstep : cB;
        for (int t = 0; t < nt; t += 2) {
            const bool last = (t == nt - 2);
            const char* a1 = cA + (size_t)(t + 1) * kstep;
            const char* a2 = last ? nA : cA + (size_t)(t + 2) * kstep; const char* b2 = last ? nB : cB + (size_t)(t + 2) * kstep;
            const char* a3 = a2 + kstep; const char* b3 = b2 + kstep;
            if (last && has_next) S.a_ready(nxt);
            if constexpr (SP2) {
            PG8_LDB(B0, 0, 0); PG8_LDB(B1, 0, 1); PG8_SCHED; PG8_LDA(At, 0, 0); PG8_STAGE(PG8_SA(1, 1), a1 + hstep, voffA);
            PG8_WAIT_V(8); PG8_WAIT_L(0); PG8_BAR; PG8_MMA(0, 0, At, B0); PG8_MMA(0, 1, At, B1); PG8_BAR; PG8_SCHED;
            PG8_LDA(At, 0, 1); PG8_STAGE(PG8_SB(0, 0), b2, voffB); PG8_STAGE(PG8_SB(0, 1), b2 + hstep, voffB); PG8_STAGE(PG8_SA(0, 0), a2, voffA);
            PG8_WAIT_V(8); PG8_WAIT_L(0); PG8_BAR; PG8_MMA(1, 0, At, B0); PG8_MMA(1, 1, At, B1); PG8_BAR; PG8_SCHED;
            PG8_LDB(B0, 1, 0); PG8_LDB(B1, 1, 1); PG8_SCHED; PG8_LDA(At, 1, 0); PG8_STAGE(PG8_SA(0, 1), a2 + hstep, voffA);
            PG8_WAIT_V(8); PG8_WAIT_L(0); PG8_BAR; PG8_MMA(0, 0, At, B0); PG8_MMA(0, 1, At, B1); PG8_BAR; PG8_SCHED;
            PG8_LDA(At, 1, 1); PG8_STAGE(PG8_SB(1, 0), b3, voffB); PG8_STAGE(PG8_SB(1, 1), b3 + hstep, voffB); PG8_STAGE(PG8_SA(1, 0), a3, voffA);
            PG8_WAIT_V(8); PG8_WAIT_L(0); PG8_BAR; PG8_MMA(1, 0, At, B0); PG8_MMA(1, 1, At, B1); PG8_BAR; PG8_SCHED;
            } else {
            PG8_LDB(B0, 0, 0); PG8_SCHED; PG8_LDA(At, 0, 0); PG8_STAGE(PG8_SA(1, 1), a1 + hstep, voffA);
            PG8_WAIT_L(8); PG8_BAR; PG8_WAIT_L(0); PG8_MMA(0, 0, At, B0); PG8_BAR; PG8_SCHED;
            PG8_LDB(B1, 0, 1); PG8_STAGE(PG8_SB(0, 0), b2, voffB);
            PG8_BAR; PG8_WAIT_L(0); PG8_MMA(0, 1, At, B1); PG8_BAR;
            PG8_LDA(At, 0, 1); PG8_STAGE(PG8_SA(0, 0), a2, voffA);
            PG8_BAR; PG8_WAIT_L(0); PG8_MMA(1, 0, At, B0); PG8_BAR; PG8_SCHED;
            PG8_STAGE(PG8_SB(0, 1), b2 + hstep, voffB);
            PG8_WAIT_V(6); PG8_BAR; PG8_MMA(1, 1, At, B1); PG8_BAR;
            PG8_LDB(B0, 1, 0); PG8_SCHED; PG8_LDA(At, 1, 0); PG8_STAGE(PG8_SA(0, 1), a2 + hstep, voffA);
            PG8_WAIT_L(8); PG8_BAR; PG8_WAIT_L(0); PG8_MMA(0, 0, At, B0); PG8_BAR; PG8_SCHED;
            PG8_LDB(B1, 1, 1); PG8_STAGE(PG8_SB(1, 0), b3, voffB);
            PG8_BAR; PG8_WAIT_L(0); PG8_MMA(0, 1, At, B1); PG8_BAR;
            PG8_LDA(At, 1, 1); PG8_STAGE(PG8_SA(1, 0), a3, voffA);
            PG8_BAR; PG8_WAIT_L(0); PG8_MMA(1, 0, At, B0); PG8_BAR; PG8_SCHED;
            PG8_STAGE(PG8_SB(1, 1), b3 + hstep, voffB);
            PG8_WAIT_V(6); PG8_BAR; PG8_MMA(1, 1, At, B1); PG8_BAR;
            }
        }
        if constexpr (ALIGN_EPI) { if (wr == 0) PG8_BAR; }
        if constexpr (!Epi::AFTER_DRAIN) { E(acc, cur, wr, wc, fr, fq); S.done(cur); }
        if (!has_next) break;
#pragma unroll
        for (int a = 0; a < 2; ++a)
#pragma unroll
            for (int b = 0; b < 2; ++b)
#pragma unroll
                for (int m = 0; m < 4; ++m)
#pragma unroll
                    for (int n = 0; n < 2; ++n) acc[a][b][m][n] = (f32x4){0.f, 0.f, 0.f, 0.f};
        cur = nxt; cA = nA; cB = nB; ++ui;
        if constexpr (ALIGN_EPI) { if (wr == 1) PG8_BAR; }
    }
    PG8_WAIT_V(0);
    if constexpr (!ALIGN_EPI) { if (wr == 0) PG8_BAR; }
    PG8_BAR;
    if constexpr (Epi::AFTER_DRAIN) { E.fused(acc, cur, wr, wc, fr, fq, lds, wid, lane); S.done(cur); }
#undef PG8_SA
#undef PG8_SB
#undef PG8_STAGE
#undef PG8_LDA
#undef PG8_LDB
#undef PG8_MMA
#undef PG8_WAIT_V
#undef PG8_WAIT_L
#undef PG8_BAR
#undef PG8_SCHED
}
}


constexpr int NB = 32, SEQ = 2048, DM = 1024, T = NB * SEQ, MEMT = 256, TM = NB * MEMT, FF = 4096;
constexpr int NIN = 3584;
constexpr int KOUT = 1536;
constexpr int W_IN_COLS = 3048;
constexpr float EPS = 1e-6f, LOG2E = 1.4426950408889634f;
constexpr float SCALE_A = 0.10206207261596577f * LOG2E;
constexpr float SCALE_B = 0.125f * LOG2E;
constexpr float SCALE_C = 0.0625f * LOG2E;
constexpr float IDX_W = 0.044194173824159216f;
constexpr int NWAVES = 8;

constexpr size_t MiB = 1u << 20;
constexpr size_t WS_CTL = 0, WS_TAB64 = 1 * MiB, WS_TAB32 = 1 * MiB + 512 * 1024, WS_RSTD1 = 2 * MiB, WS_RSTDM = 2 * MiB + 512 * 1024;
constexpr size_t WS_P1 = 4 * MiB, WS_P2 = 8 * MiB, WS_P3 = 12 * MiB;
constexpr size_t WS_WIN = 16 * MiB, WS_WOUT = 24 * MiB, WS_WQ = 28 * MiB, WS_WKV = 30 * MiB, WS_WO = 34 * MiB, WS_WUP = 36 * MiB, WS_WDN = 44 * MiB;
constexpr size_t WS_XB = 52 * MiB, WS_MEMB = 180 * MiB, WS_KVC = 196 * MiB, WS_MASK = 228 * MiB, WS_HX = 244 * MiB;
constexpr size_t WS_QL = 436 * MiB, WS_QR = 564 * MiB, WS_CKVF = 596 * MiB, WS_CKV = 628 * MiB, WS_KR = 644 * MiB, WS_KI = 648 * MiB, WS_WI = 656 * MiB, WS_QI = 658 * MiB;
constexpr size_t WS_QB = 722 * MiB, WS_KB = 786 * MiB, WS_VB = 850 * MiB;
constexpr size_t WS_QC = 436 * MiB, WS_OC = 564 * MiB, WS_HID = 436 * MiB, WS_END = 948 * MiB;

constexpr int LDS_BYTES = 147456;

#define GAS __attribute__((address_space(1)))
#define LAS __attribute__((address_space(3)))
typedef unsigned short bf16;
typedef unsigned v4u __attribute__((ext_vector_type(4)));
typedef unsigned v2u __attribute__((ext_vector_type(2)));
typedef float f32x4 __attribute__((ext_vector_type(4)));
typedef float f32x2 __attribute__((ext_vector_type(2)));
#define LDS_WAIT() asm volatile("s_waitcnt lgkmcnt(0)" ::: "memory")

__device__ __forceinline__ unsigned f2bf(float f) { unsigned u = __builtin_bit_cast(unsigned, f); return (u + 0x7fffu + ((u >> 16) & 1u)) >> 16; }
__device__ __forceinline__ unsigned pk2(float lo, float hi) { return f2bf(lo) | (f2bf(hi) << 16); }
__device__ __forceinline__ float bflo(unsigned w) { return __uint_as_float(w << 16); }
__device__ __forceinline__ float bfhi(unsigned w) { return __uint_as_float(w & 0xffff0000u); }
__device__ __forceinline__ float wave_sum(float v) {
#pragma unroll
    for (int o = 1; o < 64; o <<= 1) v += __shfl_xor(v, o);
    return v;
}
__device__ __forceinline__ float wave_max(float v) {
#pragma unroll
    for (int o = 1; o < 64; o <<= 1) v = fmaxf(v, __shfl_xor(v, o));
    return v;
}

struct Frame {
    LAS unsigned char* lds;
    int tid, lane, wave, G, gw, NGW;
    const __attribute__((address_space(4))) char* kargs;
    float* out;
    unsigned char* ws;
    size_t z;
};
__device__ __forceinline__ const float* inp(const Frame& F, int i) {
    const __attribute__((address_space(4))) char* p = F.kargs; asm volatile("" : "+s"(p));
    return *(const float* const __attribute__((address_space(4)))*)(p + 8 * i);
}
template <class TT> __device__ __forceinline__ TT* wsp(const Frame& F, size_t off) { return (TT*)(F.ws + F.z + off); }
__device__ __forceinline__ float* outp(const Frame& F) { return (float*)((unsigned char*)F.out + F.z); }
__device__ __forceinline__ void phase_ctx(Frame& F) {
    size_t z = 0; asm volatile("" : "+s"(z)); F.z = z;
    int tid = threadIdx.x; asm volatile("" : "+v"(tid));
    F.tid = tid; F.lane = tid & 63; F.wave = __builtin_amdgcn_readfirstlane(tid >> 6); F.G = gridDim.x; F.gw = blockIdx.x * NWAVES + F.wave; F.NGW = F.G * NWAVES;
}

__device__ __forceinline__ float rstd_from_parts(const float* part, int row) {
    const f32x4* p = (const f32x4*)(part + (size_t)row * 16);
    const f32x4 a = p[0], b = p[1], c = p[2], d = p[3];
    const float s = ((a[0] + a[1]) + (a[2] + a[3])) + ((b[0] + b[1]) + (b[2] + b[3])) + ((c[0] + c[1]) + (c[2] + c[3])) + ((d[0] + d[1]) + (d[2] + d[3]));
    return 1.0f / sqrtf(s * (1.0f / DM) + EPS);
}
__device__ __forceinline__ f32x4 rope4(f32x4 v, f32x4 cs) { return (f32x4){v[0] * cs[0] - v[1] * cs[1], v[1] * cs[0] + v[0] * cs[1], v[2] * cs[2] - v[3] * cs[3], v[3] * cs[2] + v[2] * cs[3]}; }
__device__ __forceinline__ v4u pack8(f32x4 a, f32x4 b) { v4u w; w.x = pk2(a[0], a[1]); w.y = pk2(a[2], a[3]); w.z = pk2(b[0], b[1]); w.w = pk2(b[2], b[3]); return w; }

struct EpiInProj {
    static constexpr bool PERM = true, AFTER_DRAIN = false;
    const float* rstd; const float* tab64; const float* tab32;
    bf16 *QL, *QR, *KR, *KI, *QI, *QB, *KB, *VB; float *CKVF, *WI;
    __device__ __forceinline__ void operator()(const pg8::f32x4 (&acc)[2][2][4][2], const pg8::Unit& u, int wr, int wc, int fr, int fq) const {
        const int pn = u.pn;
#pragma unroll
        for (int ai = 0; ai < 2; ++ai)
#pragma unroll
            for (int m = 0; m < 4; ++m) {
                const int row = u.pm * 256 + ai * 128 + wr * 64 + m * 16 + fr, pos = row & (SEQ - 1);
                const float rs = rstd[row];
                if (pn < 4) {
#pragma unroll
                    for (int bj = 0; bj < 2; ++bj) { const f32x4 a = acc[ai][bj][m][0] * (rs * SCALE_A), b = acc[ai][bj][m][1] * (rs * SCALE_A);
                        *(v4u*)(QL + (size_t)row * 1024 + pn * 256 + bj * 128 + wc * 32 + 8 * fq) = pack8(a, b); }
                } else if (pn == 4) {
                    const f32x4 cs0 = *(const f32x4*)(tab32 + ((size_t)pos * 16 + 4 * fq) * 2), cs1 = *(const f32x4*)(tab32 + ((size_t)pos * 16 + 4 * fq + 2) * 2);
#pragma unroll
                    for (int bj = 0; bj < 2; ++bj) { const f32x4 a = rope4(acc[ai][bj][m][0] * (rs * SCALE_A), cs0), b = rope4(acc[ai][bj][m][1] * (rs * SCALE_A), cs1);
                        *(v4u*)(QR + (size_t)row * 256 + bj * 128 + wc * 32 + 8 * fq) = pack8(a, b); }
                } else if (pn == 5) {
                    { const f32x4 a = acc[ai][0][m][0] * rs, b = acc[ai][0][m][1] * rs; float* o = CKVF + (size_t)row * 128 + wc * 32 + 8 * fq; *(f32x4*)o = a; *(f32x4*)(o + 4) = b; }
                    if (wc == 0) {
                        const f32x4 cs0 = *(const f32x4*)(tab32 + ((size_t)pos * 16 + 4 * fq) * 2), cs1 = *(const f32x4*)(tab32 + ((size_t)pos * 16 + 4 * fq + 2) * 2);
                        const f32x4 a = rope4(acc[ai][1][m][0] * rs, cs0), b = rope4(acc[ai][1][m][1] * rs, cs1);
                        *(v4u*)(KR + (size_t)row * 32 + 8 * fq) = pack8(a, b);
                    } else if (wc < 3) {
                        const int tb = 16 * (wc - 1) + 4 * fq;
                        const f32x4 cs0 = *(const f32x4*)(tab64 + ((size_t)pos * 32 + tb) * 2), cs1 = *(const f32x4*)(tab64 + ((size_t)pos * 32 + tb + 2) * 2);
                        const f32x4 a = rope4(acc[ai][1][m][0] * rs, cs0), b = rope4(acc[ai][1][m][1] * rs, cs1);
                        *(v4u*)(KI + (size_t)row * 64 + 32 * (wc - 1) + 8 * fq) = pack8(a, b);
                    } else if (fq == 0) {
                        const f32x4 a = acc[ai][1][m][0] * (rs * IDX_W), b = acc[ai][1][m][1] * (rs * IDX_W); float* o = WI + (size_t)row * 8; *(f32x4*)o = a; *(f32x4*)(o + 4) = b;
                    }
                } else if (pn < 12) {
                    const int tb = 16 * (wc & 1) + 4 * fq;
                    const f32x4 cs0 = *(const f32x4*)(tab64 + ((size_t)pos * 32 + tb) * 2), cs1 = *(const f32x4*)(tab64 + ((size_t)pos * 32 + tb + 2) * 2);
                    const float sc = (pn == 8 || pn == 9) ? rs * SCALE_B : rs;
                    const size_t eoff = (size_t)row * 512 + (pn & 1) * 256 + wc * 32 + 8 * fq;
#pragma unroll
                    for (int bj = 0; bj < 2; ++bj) { const f32x4 a = rope4(acc[ai][bj][m][0] * sc, cs0), b = rope4(acc[ai][bj][m][1] * sc, cs1); const v4u w = pack8(a, b);
                        if (pn < 8) *(v4u*)(QI + eoff + bj * 128) = w; else if (pn < 10) *(v4u*)(QB + eoff + bj * 128) = w; else *(v4u*)(KB + eoff + bj * 128) = w; }
                } else {
#pragma unroll
                    for (int bj = 0; bj < 2; ++bj) { const f32x4 a = acc[ai][bj][m][0] * rs, b = acc[ai][bj][m][1] * rs;
                        *(v4u*)(VB + (size_t)row * 512 + (pn & 1) * 256 + bj * 128 + wc * 32 + 8 * fq) = pack8(a, b); }
                }
            }
    }
};
template <int ACT  > struct EpiRowScale {
    static constexpr bool PERM = true, AFTER_DRAIN = false;
    bf16* O; int ldc; const float* rstd_direct; const float* parts; float cs;
    __device__ __forceinline__ void operator()(const pg8::f32x4 (&acc)[2][2][4][2], const pg8::Unit& u, int wr, int wc, int fr, int fq) const {
#pragma unroll
        for (int ai = 0; ai < 2; ++ai)
#pragma unroll
            for (int m = 0; m < 4; ++m) {
                const int row = u.pm * 256 + ai * 128 + wr * 64 + m * 16 + fr;
                const float rs = (parts ? rstd_from_parts(parts, row) : rstd_direct[row]) * cs;
#pragma unroll
                for (int bj = 0; bj < 2; ++bj) { f32x4 a = acc[ai][bj][m][0] * rs, b = acc[ai][bj][m][1] * rs;
                    if (ACT == 1) {
#pragma unroll
                        for (int e = 0; e < 4; ++e) { const float x = fmaxf(a[e], 0.f), y = fmaxf(b[e], 0.f); a[e] = x * x; b[e] = y * y; } }
                    *(v4u*)(O + (size_t)row * ldc + u.pn * 256 + bj * 128 + wc * 32 + 8 * fq) = pack8(a, b); }
            }
    }
};
struct EpiResid {
    static constexpr bool PERM = true, AFTER_DRAIN = false;
    const float* resid; float* OUT; bf16* XBo; float* parts;
    __device__ __forceinline__ void operator()(const pg8::f32x4 (&acc)[2][2][4][2], const pg8::Unit& u, int wr, int wc, int fr, int fq) const {
#pragma unroll
        for (int ai = 0; ai < 2; ++ai)
#pragma unroll
            for (int m = 0; m < 4; ++m) {
                const int row = u.pm * 256 + ai * 128 + wr * 64 + m * 16 + fr;
                float ss = 0.f;
#pragma unroll
                for (int bj = 0; bj < 2; ++bj) { const size_t off = (size_t)row * DM + u.pn * 256 + bj * 128 + wc * 32 + 8 * fq;
                    const f32x4 a = *(const f32x4*)(resid + off) + acc[ai][bj][m][0], b = *(const f32x4*)(resid + off + 4) + acc[ai][bj][m][1];
                    *(f32x4*)(OUT + off) = a; *(f32x4*)(OUT + off + 4) = b;
                    if (XBo) *(v4u*)(XBo + off) = pack8(a, b);
                    ss += (a[0] * a[0] + a[1] * a[1]) + (a[2] * a[2] + a[3] * a[3]) + (b[0] * b[0] + b[1] * b[1]) + (b[2] * b[2] + b[3] * b[3]); }
                ss += __shfl_xor(ss, 16); ss += __shfl_xor(ss, 32);
                if (fq == 0) parts[(size_t)row * 16 + u.pn * 4 + wc] = ss;
            }
    }
};

template <class Map>
__device__ __forceinline__ void transpose_item(const float* W, int srcN, const float* g, bf16* WT, int ldk, int koff, LAS float* scr, int k0, int n0, int lane, const Map& map) {
    const int sc = map(n0 + (lane & 31));
#pragma unroll 8
    for (int i = 0; i < 32; ++i) { const int kk = 2 * i + (lane >> 5); float v = (sc >= 0) ? W[(size_t)(k0 + kk) * srcN + sc] : 0.f; if (g) v *= g[k0 + kk]; scr[kk * 33 + (lane & 31)] = v; }
    LDS_WAIT(); asm volatile("" ::: "memory");
    const int c = lane & 7;
#pragma unroll
    for (int j = 0; j < 4; ++j) { const int n = (lane >> 3) + 8 * j; const LAS float* s = scr + (8 * c) * 33 + n;
        v4u o; o.x = pk2(s[0 * 33], s[1 * 33]); o.y = pk2(s[2 * 33], s[3 * 33]); o.z = pk2(s[4 * 33], s[5 * 33]); o.w = pk2(s[6 * 33], s[7 * 33]);
        *(v4u*)(WT + (size_t)(n0 + n) * ldk + koff + k0 + 8 * c) = o; }
    LDS_WAIT(); asm volatile("" ::: "memory");
}
struct MapId { __device__ __forceinline__ int operator()(int n) const { return n; } };
__device__ __forceinline__ int il64(int p) { return (p >> 1) + 32 * (p & 1); }
__device__ __forceinline__ int il32(int p) { return (p >> 1) + 16 * (p & 1); }
struct MapIn {
    __device__ __forceinline__ int operator()(int nn) const {
        int n = nn - 1024;
        if (n < 256) return 512 + (n >> 5) * 32 + il32(n & 31);
        n -= 256;
        if (n < 256) { if (n < 128) return 768 + n; if (n < 160) return 896 + il32(n - 128); if (n < 224) return 1440 + il64(n - 160); if (n < 232) return 1504 + (n - 224); return -1; }
        n -= 256;
        if (n < 512) return 928 + (n >> 6) * 64 + il64(n & 63);
        n -= 512;
        if (n < 512) return 1512 + (n >> 6) * 64 + il64(n & 63);
        n -= 512;
        if (n < 512) return 2024 + (n >> 6) * 64 + il64(n & 63);
        n -= 512;
        return 2536 + n;
    }
};

__device__ __forceinline__ void p0_prologue(Frame& F) {
    LAS float* scr = (LAS float*)(F.lds + F.wave * 16384);
    const int gw = F.gw, NGW = F.NGW, lane = F.lane;
    const float *x = inp(F, 0), *mem = inp(F, 1), *g_mix = inp(F, 2), *w_in = inp(F, 3), *w_uk = inp(F, 5), *w_uv = inp(F, 6), *w_out = inp(F, 7), *g_cross = inp(F, 8), *g_mem = inp(F, 9);
    const float *w_q = inp(F, 10), *w_kv = inp(F, 11), *w_o = inp(F, 12), *g_mlp = inp(F, 13), *w_up = inp(F, 14), *w_dn = inp(F, 15);
    bf16 *WIN = wsp<bf16>(F, WS_WIN), *WOUT = wsp<bf16>(F, WS_WOUT), *WQ = wsp<bf16>(F, WS_WQ), *WKV = wsp<bf16>(F, WS_WKV), *WO = wsp<bf16>(F, WS_WO), *WUP = wsp<bf16>(F, WS_WUP), *WDN = wsp<bf16>(F, WS_WDN);
    constexpr int I_IN = 16 * (2560 / 32), I_OUT2 = 8 * 32, I_Q = 16 * 32, I_KV = 16 * 64, I_O = 16 * 32, I_UP = 16 * 128, I_DN = 64 * 32;
    constexpr int NIT = I_IN + I_OUT2 + I_Q + I_KV + I_O + I_UP + I_DN;
    for (int it = gw; it < NIT; it += NGW) {
        int r = it;
        if (r < I_IN) { const int nb = r % 80, kb = r / 80; transpose_item(w_in, W_IN_COLS, g_mix, WIN, DM, 0, scr, 64 * kb, 1024 + 32 * nb, lane, MapIn()); continue; } r -= I_IN;
        if (r < I_OUT2) { const int nb = r % 32, kb = r / 32; transpose_item(w_out + (size_t)512 * DM, DM, nullptr, WOUT, KOUT, 1024, scr, 64 * kb, 32 * nb, lane, MapId()); continue; } r -= I_OUT2;
        if (r < I_Q) { const int nb = r % 32, kb = r / 32; transpose_item(w_q, DM, g_cross, WQ, DM, 0, scr, 64 * kb, 32 * nb, lane, MapId()); continue; } r -= I_Q;
        if (r < I_KV) { const int nb = r % 64, kb = r / 64; transpose_item(w_kv, 2048, g_mem, WKV, DM, 0, scr, 64 * kb, 32 * nb, lane, MapId()); continue; } r -= I_KV;
        if (r < I_O) { const int nb = r % 32, kb = r / 32; transpose_item(w_o, DM, nullptr, WO, DM, 0, scr, 64 * kb, 32 * nb, lane, MapId()); continue; } r -= I_O;
        if (r < I_UP) { const int nb = r % 128, kb = r / 128; transpose_item(w_up, FF, g_mlp, WUP, DM, 0, scr, 64 * kb, 32 * nb, lane, MapId()); continue; } r -= I_UP;
        { const int nb = r % 32, kb = r / 32; transpose_item(w_dn, DM, nullptr, WDN, FF, 0, scr, 64 * kb, 32 * nb, lane, MapId()); }
    }
    for (int it = gw; it < 8 * 16 * 8; it += NGW) {
        const int cg8 = it & 7, kb = (it >> 3) & 15, h = it >> 7, k = kb * 64 + lane;
        float a[16];
#pragma unroll
        for (int c = 0; c < 16; ++c) a[c] = 0.f;
        const float* wrow = w_in + (size_t)k * W_IN_COLS + h * 64;
        const float* uk = w_uk + (size_t)h * 64 * 128 + cg8 * 16 + (lane & 15);
#pragma unroll 2
        for (int j = 0; j < 64; ++j) {
            const float wv = wrow[j]; const float u = uk[(size_t)j * 128];
#pragma unroll
            for (int c = 0; c < 16; ++c) a[c] += wv * __shfl(u, c);
        }
        const float gk = g_mix[k];
#pragma unroll
        for (int c = 0; c < 16; ++c) WIN[(size_t)(h * 128 + cg8 * 16 + c) * DM + k] = (bf16)f2bf(a[c] * gk);
    }
    for (int it = gw; it < 8 * 16 * 8; it += NGW) {
        const int cg8 = it & 7, nb = (it >> 3) & 15, h = it >> 7, n = nb * 64 + lane;
        float a[16];
#pragma unroll
        for (int c = 0; c < 16; ++c) a[c] = 0.f;
        const float* uv = w_uv + (size_t)(h * 128 + cg8 * 16 + (lane & 15)) * 64;
#pragma unroll 2
        for (int v = 0; v < 64; ++v) {
            const float wv = w_out[(size_t)(h * 64 + v) * DM + n]; const float u = uv[v];
#pragma unroll
            for (int c = 0; c < 16; ++c) a[c] += wv * __shfl(u, c);
        }
        v4u o0, o1; o0.x = pk2(a[0], a[1]); o0.y = pk2(a[2], a[3]); o0.z = pk2(a[4], a[5]); o0.w = pk2(a[6], a[7]); o1.x = pk2(a[8], a[9]); o1.y = pk2(a[10], a[11]); o1.z = pk2(a[12], a[13]); o1.w = pk2(a[14], a[15]);
        bf16* d = WOUT + (size_t)n * KOUT + h * 128 + cg8 * 16; *(v4u*)d = o0; *(v4u*)(d + 8) = o1;
    }
    bf16 *XB = wsp<bf16>(F, WS_XB), *MEMB = wsp<bf16>(F, WS_MEMB); float *R1 = wsp<float>(F, WS_RSTD1), *RM = wsp<float>(F, WS_RSTDM);
    for (int m = gw; m < T + TM; m += NGW) {
        const bool isx = m < T; const int r = isx ? m : m - T;
        const f32x4* xr = (const f32x4*)((isx ? x : mem) + (size_t)r * DM) + lane;
        f32x4 v[4]; float s = 0.f;
#pragma unroll
        for (int j = 0; j < 4; ++j) { v[j] = xr[64 * j]; s += (v[j][0] * v[j][0] + v[j][1] * v[j][1]) + (v[j][2] * v[j][2] + v[j][3] * v[j][3]); }
        s = wave_sum(s);
        if (lane == 0) (isx ? R1 : RM)[r] = 1.0f / sqrtf(s * (1.0f / DM) + EPS);
        v2u* o8 = (v2u*)((isx ? XB : MEMB) + (size_t)r * DM) + lane;
#pragma unroll
        for (int j = 0; j < 4; ++j) { v2u w; w.x = pk2(v[j][0], v[j][1]); w.y = pk2(v[j][2], v[j][3]); o8[64 * j] = w; }
    }
    float *T64 = wsp<float>(F, WS_TAB64), *T32 = wsp<float>(F, WS_TAB32);
    for (int e = gw * 64 + lane; e < SEQ * 32; e += NGW * 64) {
        const int pos = e >> 5, t = e & 31;
        const float inv = exp2f(-(float)t * (13.287712379549449f / 32.0f));
        const float ang = (float)pos * inv;
        const double rev = (double)ang * 0.15915494309189535; const float fr = (float)(rev - floor(rev));
        const float c = __builtin_amdgcn_cosf(fr), s = __builtin_amdgcn_sinf(fr);
        T64[2 * e] = c; T64[2 * e + 1] = s;
        if ((t & 1) == 0) { T32[2 * (pos * 16 + (t >> 1))] = c; T32[2 * (pos * 16 + (t >> 1)) + 1] = s; }
    }
}

__device__ __forceinline__ void p2_ckv_norm(Frame& F) {
    const float* CKVF = wsp<float>(F, WS_CKVF); bf16* CKV = wsp<bf16>(F, WS_CKV); const float* g = inp(F, 4);
    const float g0 = g[2 * F.lane], g1 = g[2 * F.lane + 1];
    for (int r = F.gw; r < T; r += F.NGW) {
        const f32x2 v = *(const f32x2*)(CKVF + (size_t)r * 128 + 2 * F.lane);
        const float ss = wave_sum(v[0] * v[0] + v[1] * v[1]);
        const float rs = 1.0f / sqrtf(ss * (1.0f / 128.0f) + EPS);
        *(unsigned*)(CKV + (size_t)r * 128 + 2 * F.lane) = pk2(v[0] * rs * g0, v[1] * rs * g1);
    }
}
__device__ __forceinline__ void p2_index_select(Frame& F) {
    const bf16 *QI = wsp<bf16>(F, WS_QI), *KI = wsp<bf16>(F, WS_KI); const float* WI = wsp<float>(F, WS_WI); unsigned* MASK = wsp<unsigned>(F, WS_MASK);
    LAS float* qf = (LAS float*)(F.lds + F.wave * 16384);
    LAS unsigned* keys = (LAS unsigned*)(F.lds + F.wave * 16384 + 2048);
    const int lane = F.lane;
    for (int t = F.gw; t < T; t += F.NGW) {
        const int b = t >> 11, q = t & (SEQ - 1);
        { const v4u w = *(const v4u*)(QI + (size_t)t * 512 + 8 * lane);
          *(LAS f32x4*)(qf + 8 * lane) = (f32x4){bflo(w.x), bfhi(w.x), bflo(w.y), bfhi(w.y)}; *(LAS f32x4*)(qf + 8 * lane + 4) = (f32x4){bflo(w.z), bfhi(w.z), bflo(w.w), bfhi(w.w)}; }
        const f32x4 wa = *(const f32x4*)(WI + (size_t)t * 8), wb = *(const f32x4*)(WI + (size_t)t * 8 + 4);
        const float wh[8] = {wa[0], wa[1], wa[2], wa[3], wb[0], wb[1], wb[2], wb[3]};
        LDS_WAIT();
        const int nr = (q >> 6) + 1;
#pragma unroll 1
        for (int r = 0; r < nr; ++r) {
            asm volatile("" ::: "memory");
            const int s = r * 64 + lane;
            const v4u* kp = (const v4u*)(KI + (size_t)(b * SEQ + s) * 64);
            float dh[8];
#pragma unroll
            for (int h = 0; h < 8; ++h) dh[h] = 0.f;
#pragma unroll 1
            for (int hf = 0; hf < 2; ++hf) {
                asm volatile("" ::: "memory");
                float kf[32];
#pragma unroll
                for (int i = 0; i < 4; ++i) { const v4u w = kp[hf * 4 + i]; kf[8 * i] = bflo(w.x); kf[8 * i + 1] = bfhi(w.x); kf[8 * i + 2] = bflo(w.y); kf[8 * i + 3] = bfhi(w.y); kf[8 * i + 4] = bflo(w.z); kf[8 * i + 5] = bfhi(w.z); kf[8 * i + 6] = bflo(w.w); kf[8 * i + 7] = bfhi(w.w); }
#pragma unroll
                for (int h = 0; h < 8; ++h) {
#pragma unroll
                    for (int i = 0; i < 32; i += 4) { const f32x4 qv = *(const LAS f32x4*)(qf + h * 64 + hf * 32 + i); dh[h] += qv[0] * kf[i] + qv[1] * kf[i + 1] + qv[2] * kf[i + 2] + qv[3] * kf[i + 3]; }
                    __builtin_amdgcn_sched_barrier(0); }
            }
            float score = 0.f;
#pragma unroll
            for (int h = 0; h < 8; ++h) score += fmaxf(dh[h], 0.f) * wh[h];
            unsigned ord = __float_as_uint(score); ord ^= (ord >> 31) ? 0xFFFFFFFFu : 0x80000000u;
            keys[s] = (s <= q) ? ((ord & 0xFFFFF800u) | (unsigned)(SEQ - 1 - s)) : 0u;
        }
        LDS_WAIT();
        unsigned key[32];
#pragma unroll
        for (int r = 0; r < 32; ++r) key[r] = (r < nr) ? keys[r * 64 + lane] : 0u;
        unsigned thr = 1u;
        if (q >= 256) {
            unsigned lo = 0u;
#pragma unroll 1
            for (int bit = 31; bit >= 0; --bit) {
                const unsigned cand = lo | (1u << bit); int cnt = 0;
#pragma unroll
                for (int r = 0; r < 32; ++r) { cnt += __popcll(__ballot(key[r] >= cand)); if ((r & 3) == 3) __builtin_amdgcn_sched_barrier(0); }
                if (cnt >= 256) lo = cand;
            }
            thr = lo;
        }
        LAS unsigned long long* lm = (LAS unsigned long long*)keys;
#pragma unroll
        for (int r = 0; r < 32; ++r) { const unsigned long long bm = __ballot(key[r] >= thr && key[r] != 0u); if (lane == 0) lm[r] = bm; if ((r & 3) == 3) __builtin_amdgcn_sched_barrier(0); }
        LDS_WAIT();
        const unsigned long long mine = lm[lane & 31];
        if (lane < 32) *(unsigned long long*)(MASK + (size_t)t * 64 + 2 * lane) = mine;
        LDS_WAIT();
    }
}
__device__ __forceinline__ void p3_dsa_naive(Frame& F) {
    const bf16 *QL = wsp<bf16>(F, WS_QL), *QR = wsp<bf16>(F, WS_QR), *CKV = wsp<bf16>(F, WS_CKV), *KR = wsp<bf16>(F, WS_KR); const unsigned* MASK = wsp<unsigned>(F, WS_MASK); bf16* HX = wsp<bf16>(F, WS_HX);
    LAS float* qf = (LAS float*)(F.lds + F.wave * 16384);
    LAS int* list = (LAS int*)(F.lds + F.wave * 16384 + 5120);
    LAS float* P = (LAS float*)(F.lds + F.wave * 16384 + 6144);
    const int lane = F.lane;
    for (int t = F.gw; t < T; t += F.NGW) {
        const int b = t >> 11;
#pragma unroll
        for (int j = 0; j < 2; ++j) { const int e0 = j * 512 + 8 * lane; const v4u w = *(const v4u*)(QL + (size_t)t * 1024 + e0); const int h = e0 >> 7, c = e0 & 127; LAS float* d = qf + h * 160 + c;
            *(LAS f32x4*)d = (f32x4){bflo(w.x), bfhi(w.x), bflo(w.y), bfhi(w.y)}; *(LAS f32x4*)(d + 4) = (f32x4){bflo(w.z), bfhi(w.z), bflo(w.w), bfhi(w.w)}; }
        { const int e0 = 4 * lane; const v2u w = *(const v2u*)(QR + (size_t)t * 256 + e0); const int h = e0 >> 5, c = e0 & 31; *(LAS f32x4*)(qf + h * 160 + 128 + c) = (f32x4){bflo(w.x), bfhi(w.x), bflo(w.y), bfhi(w.y)}; }
        unsigned w = MASK[(size_t)t * 64 + lane];
        const int cl = __popc(w); int pre = cl;
#pragma unroll
        for (int o = 1; o < 64; o <<= 1) { const int v = __shfl_up(pre, o); if (lane >= o) pre += v; }
        const int cnt = __shfl(pre, 63); int pos = pre - cl;
        while (w) { const int bb = __ffs(w) - 1; list[pos++] = lane * 32 + bb; w &= w - 1; }
        LDS_WAIT();
#pragma unroll 1
        for (int ci = 0; ci * 64 < cnt; ++ci) {
            const int j = ci * 64 + lane; const bool act = j < cnt; const int s = act ? list[j] : 0; const size_t row = (size_t)b * SEQ + s;
            float a[8];
#pragma unroll
            for (int h = 0; h < 8; ++h) a[h] = 0.f;
#pragma unroll 1
            for (int cc = 0; cc < 5; ++cc) {
                asm volatile("" ::: "memory");
                const v4u* kp = (cc < 4) ? (const v4u*)(CKV + row * 128 + cc * 32) : (const v4u*)(KR + row * 32);
                float kf[32];
#pragma unroll
                for (int i = 0; i < 4; ++i) { const v4u ww = kp[i]; kf[8 * i] = bflo(ww.x); kf[8 * i + 1] = bfhi(ww.x); kf[8 * i + 2] = bflo(ww.y); kf[8 * i + 3] = bfhi(ww.y); kf[8 * i + 4] = bflo(ww.z); kf[8 * i + 5] = bfhi(ww.z); kf[8 * i + 6] = bflo(ww.w); kf[8 * i + 7] = bfhi(ww.w); }
#pragma unroll
                for (int h = 0; h < 8; ++h) {
#pragma unroll
                    for (int i = 0; i < 32; i += 4) { const f32x4 qv = *(const LAS f32x4*)(qf + h * 160 + cc * 32 + i); a[h] += qv[0] * kf[i] + qv[1] * kf[i + 1] + qv[2] * kf[i + 2] + qv[3] * kf[i + 3]; }
                    __builtin_amdgcn_sched_barrier(0); }
            }
            LAS float* d = P + j * 8; *(LAS f32x4*)d = (f32x4){a[0], a[1], a[2], a[3]}; *(LAS f32x4*)(d + 4) = (f32x4){a[4], a[5], a[6], a[7]};
        }
        LDS_WAIT();
        float sc[4][8];
#pragma unroll
        for (int ci = 0; ci < 4; ++ci) { const int j = ci * 64 + lane; const bool act = j < cnt; const f32x4 pa = *(const LAS f32x4*)(P + j * 8), pb = *(const LAS f32x4*)(P + j * 8 + 4);
            sc[ci][0] = act ? pa[0] : -INFINITY; sc[ci][1] = act ? pa[1] : -INFINITY; sc[ci][2] = act ? pa[2] : -INFINITY; sc[ci][3] = act ? pa[3] : -INFINITY;
            sc[ci][4] = act ? pb[0] : -INFINITY; sc[ci][5] = act ? pb[1] : -INFINITY; sc[ci][6] = act ? pb[2] : -INFINITY; sc[ci][7] = act ? pb[3] : -INFINITY; }
        LDS_WAIT();
#pragma unroll
        for (int h = 0; h < 8; ++h) {
            float m = fmaxf(fmaxf(sc[0][h], sc[1][h]), fmaxf(sc[2][h], sc[3][h])); m = wave_max(m);
            float l = 0.f;
#pragma unroll
            for (int ci = 0; ci < 4; ++ci) { sc[ci][h] = exp2f(sc[ci][h] - m); l += sc[ci][h]; }
            l = wave_sum(l); const float il = 1.0f / l;
#pragma unroll
            for (int ci = 0; ci < 4; ++ci) sc[ci][h] *= il;
        }
#pragma unroll
        for (int ci = 0; ci < 4; ++ci) { LAS float* d = P + (ci * 64 + lane) * 8; *(LAS f32x4*)d = (f32x4){sc[ci][0], sc[ci][1], sc[ci][2], sc[ci][3]}; *(LAS f32x4*)(d + 4) = (f32x4){sc[ci][4], sc[ci][5], sc[ci][6], sc[ci][7]}; }
        LDS_WAIT();
        float o0[8], o1[8];
#pragma unroll
        for (int h = 0; h < 8; ++h) { o0[h] = 0.f; o1[h] = 0.f; }
#pragma unroll 4
        for (int j = 0; j < cnt; ++j) {
            const int s = list[j]; const unsigned v = *(const unsigned*)(CKV + ((size_t)b * SEQ + s) * 128 + 2 * lane);
            const f32x4 pa = *(const LAS f32x4*)(P + j * 8), pb = *(const LAS f32x4*)(P + j * 8 + 4); const float v0 = bflo(v), v1 = bfhi(v);
            o0[0] += pa[0] * v0; o1[0] += pa[0] * v1; o0[1] += pa[1] * v0; o1[1] += pa[1] * v1; o0[2] += pa[2] * v0; o1[2] += pa[2] * v1; o0[3] += pa[3] * v0; o1[3] += pa[3] * v1;
            o0[4] += pb[0] * v0; o1[4] += pb[0] * v1; o0[5] += pb[1] * v0; o1[5] += pb[1] * v1; o0[6] += pb[2] * v0; o1[6] += pb[2] * v1; o0[7] += pb[3] * v0; o1[7] += pb[3] * v1;
        }
#pragma unroll
        for (int h = 0; h < 8; ++h) *(unsigned*)(HX + (size_t)t * KOUT + h * 128 + 2 * lane) = pk2(o0[h], o1[h]);
        LDS_WAIT();
    }
}
__device__ __forceinline__ void p3_dilated_naive(Frame& F) {
    const bf16 *QB = wsp<bf16>(F, WS_QB), *KB = wsp<bf16>(F, WS_KB), *VB = wsp<bf16>(F, WS_VB); bf16* HX = wsp<bf16>(F, WS_HX);
    LAS float* qf = (LAS float*)(F.lds + F.wave * 16384);
    LAS float* P = (LAS float*)(F.lds + F.wave * 16384 + 256);
    const int lane = F.lane;
    for (int it = F.gw; it < T * 8; it += F.NGW) {
        const int t = it >> 3, h = it & 7, b = t >> 11, pos = t & (SEQ - 1);
        { const unsigned w = *(const unsigned*)(QB + (size_t)t * 512 + h * 64 + 2 * lane); if (lane < 32) { qf[2 * lane] = bflo(w); qf[2 * lane + 1] = bfhi(w); } }
        LDS_WAIT();
        float sc[7];
#pragma unroll
        for (int ch = 0; ch < 7; ++ch) {
            const int e = ch * 64 + lane, p = e / 129, rel = e - p * 129, dl = (p == 0) ? 1 : (p == 1) ? 4 : 16, tk = pos - dl * rel; const bool act = (e < 387) && (tk >= 0);
            const v4u* kp = (const v4u*)(KB + ((size_t)b * SEQ + (act ? tk : 0)) * 512 + h * 64);
            float d = 0.f;
#pragma unroll
            for (int i = 0; i < 8; ++i) { const v4u w = kp[i]; const f32x4 qa = *(const LAS f32x4*)(qf + 8 * i), qb = *(const LAS f32x4*)(qf + 8 * i + 4);
                d += qa[0] * bflo(w.x) + qa[1] * bfhi(w.x) + qa[2] * bflo(w.y) + qa[3] * bfhi(w.y) + qb[0] * bflo(w.z) + qb[1] * bfhi(w.z) + qb[2] * bflo(w.w) + qb[3] * bfhi(w.w); }
            sc[ch] = act ? d : -INFINITY;
        }
        float m = sc[0];
#pragma unroll
        for (int ch = 1; ch < 7; ++ch) m = fmaxf(m, sc[ch]);
        m = wave_max(m); float l = 0.f;
#pragma unroll
        for (int ch = 0; ch < 7; ++ch) { sc[ch] = exp2f(sc[ch] - m); l += sc[ch]; P[ch * 64 + lane] = sc[ch]; }
        l = wave_sum(l);
        LDS_WAIT();
        float o = 0.f;
        const bf16* vbase = VB + (size_t)b * SEQ * 512 + h * 64 + lane;
#pragma unroll
        for (int p = 0; p < 3; ++p) { const int dl = (p == 0) ? 1 : (p == 1) ? 4 : 16; int nrel = pos / dl + 1; if (nrel > 129) nrel = 129;
#pragma unroll 8
            for (int rel = 0; rel < nrel; ++rel) { const int tk = pos - dl * rel; o += P[p * 129 + rel] * __uint_as_float((unsigned)vbase[(size_t)tk * 512] << 16); } }
        HX[(size_t)t * KOUT + 1024 + h * 64 + lane] = (bf16)f2bf(o / l);
        LDS_WAIT();
    }
}
__device__ __forceinline__ void p6_cross_naive(Frame& F) {
    const bf16 *QC = wsp<bf16>(F, WS_QC), *KVC = wsp<bf16>(F, WS_KVC); bf16* OC = wsp<bf16>(F, WS_OC);
    LAS float* qf = (LAS float*)(F.lds + F.wave * 16384);
    LAS float* P = (LAS float*)(F.lds + F.wave * 16384 + 1024);
    const int lane = F.lane;
    for (int it = F.gw; it < T * 4; it += F.NGW) {
        const int t = it >> 2, h = it & 3, b = t >> 11;
        { const v2u w = *(const v2u*)(QC + (size_t)t * 1024 + h * 256 + 4 * lane); *(LAS f32x4*)(qf + 4 * lane) = (f32x4){bflo(w.x), bfhi(w.x), bflo(w.y), bfhi(w.y)}; }
        LDS_WAIT();
        float sc[4];
#pragma unroll
        for (int ch = 0; ch < 4; ++ch) {
            const v4u* kp = (const v4u*)(KVC + ((size_t)b * MEMT + ch * 64 + lane) * 2048 + h * 256);
            float d = 0.f;
#pragma unroll 8
            for (int i = 0; i < 32; ++i) { const v4u w = kp[i]; const f32x4 qa = *(const LAS f32x4*)(qf + 8 * i), qb = *(const LAS f32x4*)(qf + 8 * i + 4);
                d += qa[0] * bflo(w.x) + qa[1] * bfhi(w.x) + qa[2] * bflo(w.y) + qa[3] * bfhi(w.y) + qb[0] * bflo(w.z) + qb[1] * bfhi(w.z) + qb[2] * bflo(w.w) + qb[3] * bfhi(w.w); }
            sc[ch] = d;
        }
        float m = wave_max(fmaxf(fmaxf(sc[0], sc[1]), fmaxf(sc[2], sc[3]))); float l = 0.f;
#pragma unroll
        for (int ch = 0; ch < 4; ++ch) { sc[ch] = exp2f(sc[ch] - m); l += sc[ch]; P[ch * 64 + lane] = sc[ch]; }
        l = wave_sum(l); const float il = 1.0f / l;
        LDS_WAIT();
        float o0 = 0.f, o1 = 0.f, o2 = 0.f, o3 = 0.f;
        const bf16* vb = KVC + (size_t)b * MEMT * 2048 + 1024 + h * 256 + 4 * lane;
#pragma unroll 8
        for (int j = 0; j < MEMT; ++j) { const v2u w = *(const v2u*)(vb + (size_t)j * 2048); const float p = P[j]; o0 += p * bflo(w.x); o1 += p * bfhi(w.x); o2 += p * bflo(w.y); o3 += p * bfhi(w.y); }
        v2u ow; ow.x = pk2(o0 * il, o1 * il); ow.y = pk2(o2 * il, o3 * il);
        *(v2u*)(OC + (size_t)t * 1024 + h * 256 + 4 * lane) = ow;
        LDS_WAIT();
    }
}
__device__ __forceinline__ void p10_final(Frame& F) {
    const float* parts = wsp<float>(F, WS_P3); const float* g = inp(F, 16);
    f32x4 gv[4];
#pragma unroll
    for (int j = 0; j < 4; ++j) gv[j] = *((const f32x4*)g + F.lane + 64 * j);
    for (int r = F.gw; r < T; r += F.NGW) {
        const float rs = rstd_from_parts(parts, r);
        f32x4* o = (f32x4*)(outp(F) + (size_t)r * DM) + F.lane;
#pragma unroll
        for (int j = 0; j < 4; ++j) o[64 * j] = o[64 * j] * rs * gv[j];
    }
}

#define RLX_AGENT __ATOMIC_RELAXED, __HIP_MEMORY_SCOPE_AGENT
#define XB_TMO      128
#define XB_XCNT(j)  (256  + 64 * (j))
#define XB_XSUB(j)  (1280 + 64 * (j))
#define XB_XGEN(j)  (2304 + 64 * (j))
#define XB_TOP      3328
#define XB_TOPGEN   3392
#define XCD_BAR_WORDS 3456
#define XB_SPIN_CAP (1u << 18)

__device__ __forceinline__ unsigned xb_ld(unsigned* p)              { return __hip_atomic_load(p, __ATOMIC_RELAXED, __HIP_MEMORY_SCOPE_AGENT); }
__device__ __forceinline__ unsigned xb_add(unsigned* p, unsigned v) { return __hip_atomic_fetch_add(p, v, __ATOMIC_RELAXED, __HIP_MEMORY_SCOPE_AGENT); }
__device__ __forceinline__ unsigned xb_xcc_id() { return (unsigned)__builtin_amdgcn_s_getreg((3 << 11) | 20) & 0xFu; }
#define XB_SPIN(cond, bar) do { unsigned _sp = 0; while (cond) { __builtin_amdgcn_s_sleep(1); \
    if ((++_sp & 255u) == 0u) { if (xb_ld(&(bar)[XB_TMO])) break; if (_sp > XB_SPIN_CAP) { atomicAdd(&(bar)[XB_TMO], 1u); break; } } } } while (0)

struct XcdBarrier {
    unsigned* bar; unsigned x;
    volatile LAS unsigned* st;
};

__device__ __forceinline__ XcdBarrier xcd_barrier_post(unsigned* bar, volatile LAS unsigned* st) {
    XcdBarrier b; b.bar = bar; b.x = xb_xcc_id(); b.st = st;
    if (threadIdx.x == 0) (void)xb_add(&bar[XB_XCNT(b.x)], 1u);
    return b;
}
__device__ __forceinline__ void xcd_barrier_complete(unsigned* bar, unsigned x, unsigned& nloc, unsigned& nx) {
    const unsigned G = gridDim.x * gridDim.y * gridDim.z;
    unsigned sum, cnt, mine, sp = 0u;
    for (;;) {
        sum = 0u; cnt = 0u; mine = 0u;
#pragma unroll
        for (unsigned j = 0; j < 16; ++j) { const unsigned c = xb_ld(&bar[XB_XCNT(j)]); sum += c; cnt += (c > 0u) ? 1u : 0u; mine = (j == x) ? c : mine; }
        if (sum == G) break;
        __builtin_amdgcn_s_sleep(1);
        if ((++sp & 255u) == 0u) { if (xb_ld(&bar[XB_TMO])) break; if (sp > XB_SPIN_CAP) { atomicAdd(&bar[XB_TMO], 1u); break; } }
    }
    nloc = mine > 0u ? mine : 1u; nx = cnt > 0u ? cnt : 1u;
}

__device__ __forceinline__ void xcd_barrier(const XcdBarrier& b) {
    asm volatile("s_waitcnt vmcnt(0)" ::: "memory");
    __syncthreads();
    if (threadIdx.x == 0) {
        unsigned* bar = b.bar;
        __builtin_amdgcn_s_waitcnt(0);
        unsigned nloc = b.st[0], nx = b.st[1];
        if (nloc == 0u) { xcd_barrier_complete(bar, b.x, nloc, nx); b.st[0] = nloc; b.st[1] = nx; }
        const unsigned old = xb_add(&bar[XB_XSUB(b.x)], 1u);
        const unsigned gen = old / nloc;
        if (old + 1u == (gen + 1u) * nloc) {
            __builtin_amdgcn_fence(__ATOMIC_RELEASE, "agent");
            asm volatile("s_waitcnt vmcnt(0)" ::: "memory");
            const unsigned og = xb_add(&bar[XB_TOP], 1u);
            const unsigned tg = og / nx;
            if (og + 1u == (tg + 1u) * nx) xb_add(&bar[XB_TOPGEN], 1u);
            else XB_SPIN(xb_ld(&bar[XB_TOPGEN]) == tg, bar);
            __builtin_amdgcn_fence(__ATOMIC_ACQUIRE, "agent");
            xb_add(&bar[XB_XGEN(b.x)], 1u);
            asm volatile("s_waitcnt vmcnt(0)" ::: "memory");
        } else {
            XB_SPIN(xb_ld(&bar[XB_XGEN(b.x)]) == gen, bar);
            __builtin_amdgcn_fence(__ATOMIC_ACQUIRE, "agent");
            asm volatile("s_waitcnt vmcnt(0)" ::: "memory");
        }
    }
    __syncthreads();
}

struct Args { const float* in[17]; float* out; unsigned char* ws; int ph_lo, ph_hi; };
__global__ void __launch_bounds__(NWAVES * 64, 2) fwd_kernel(Args args) {
    extern __shared__ __attribute__((aligned(16))) unsigned char lds[];
    cg::grid_group grid = cg::this_grid();
    Frame F;
    F.lds = (LAS unsigned char*)lds;
    F.kargs = (const __attribute__((address_space(4))) char*)__builtin_amdgcn_kernarg_segment_ptr();
    F.out = args.out; F.ws = args.ws; phase_ctx(F);
    volatile LAS unsigned* MISC = (volatile LAS unsigned*)(F.lds + 131072 + 64);
    if (threadIdx.x < 16) MISC[threadIdx.x] = 0u;
    __syncthreads();
    XcdBarrier bar = xcd_barrier_post((unsigned*)(args.ws + WS_CTL) + 1024, MISC + 8);
    const int lo = args.ph_lo, hi = args.ph_hi;
#ifndef PH_MASK
#define PH_MASK 0x7ff
#endif
#define IN(k) (((PH_MASK >> (k)) & 1) && lo <= (k) && (k) < hi)
#define SEAM(k) do { if (IN(k) && IN((k) + 1)) { if ((k) == 0) grid.sync(); else xcd_barrier(bar); } phase_ctx(F); } while (0)
    LAS unsigned char* ring = (LAS unsigned char*)lds;

    if (IN(0)) { p0_prologue(F); }
    SEAM(0);
    if (IN(1)) {
        { pg8::Gemm g{wsp<bf16>(F, WS_XB), wsp<bf16>(F, WS_WIN), T, NIN, DM}; pg8::StaticOrder S; S.init(T, NIN, F.G, (int)blockIdx.x);
          EpiInProj E{wsp<float>(F, WS_RSTD1), wsp<float>(F, WS_TAB64), wsp<float>(F, WS_TAB32), wsp<bf16>(F, WS_QL), wsp<bf16>(F, WS_QR), wsp<bf16>(F, WS_KR), wsp<bf16>(F, WS_KI), wsp<bf16>(F, WS_QI), wsp<bf16>(F, WS_QB), wsp<bf16>(F, WS_KB), wsp<bf16>(F, WS_VB), wsp<float>(F, WS_CKVF), wsp<float>(F, WS_WI)};
          pg8::gemm_phase<EpiInProj, pg8::StaticOrder, true, true>(ring, g, S, E); }
        { pg8::Gemm g{wsp<bf16>(F, WS_MEMB), wsp<bf16>(F, WS_WKV), TM, 2048, DM}; pg8::StaticOrder S; S.init(TM, 2048, F.G, (int)blockIdx.x);
          EpiRowScale<0> E{wsp<bf16>(F, WS_KVC), 2048, wsp<float>(F, WS_RSTDM), nullptr, 1.0f};
          pg8::gemm_phase<EpiRowScale<0>, pg8::StaticOrder, true, true>(ring, g, S, E); }
    }
    SEAM(1);
    if (IN(2)) { p2_ckv_norm(F); p2_index_select(F); }
    SEAM(2);
    if (IN(3)) { p3_dsa_naive(F); p3_dilated_naive(F); }
    SEAM(3);
    if (IN(4)) {
        pg8::Gemm g{wsp<bf16>(F, WS_HX), wsp<bf16>(F, WS_WOUT), T, DM, KOUT}; pg8::StaticOrder S; S.init(T, DM, F.G, (int)blockIdx.x);
        EpiResid E{inp(F, 0), outp(F), wsp<bf16>(F, WS_XB), wsp<float>(F, WS_P1)};
        pg8::gemm_phase<EpiResid, pg8::StaticOrder, true, true>(ring, g, S, E);
    }
    SEAM(4);
    if (IN(5)) {
        pg8::Gemm g{wsp<bf16>(F, WS_XB), wsp<bf16>(F, WS_WQ), T, DM, DM}; pg8::StaticOrder S; S.init(T, DM, F.G, (int)blockIdx.x);
        EpiRowScale<0> E{wsp<bf16>(F, WS_QC), DM, nullptr, wsp<float>(F, WS_P1), SCALE_C};
        pg8::gemm_phase<EpiRowScale<0>, pg8::StaticOrder, true, true>(ring, g, S, E);
    }
    SEAM(5);
    if (IN(6)) { p6_cross_naive(F); }
    SEAM(6);
    if (IN(7)) {
        pg8::Gemm g{wsp<bf16>(F, WS_OC), wsp<bf16>(F, WS_WO), T, DM, DM}; pg8::StaticOrder S; S.init(T, DM, F.G, (int)blockIdx.x);
        EpiResid E{outp(F), outp(F), wsp<bf16>(F, WS_XB), wsp<float>(F, WS_P2)};
        pg8::gemm_phase<EpiResid, pg8::StaticOrder, true, true>(ring, g, S, E);
    }
    SEAM(7);
    if (IN(8)) {
        pg8::Gemm g{wsp<bf16>(F, WS_XB), wsp<bf16>(F, WS_WUP), T, FF, DM}; pg8::StaticOrder S; S.init(T, FF, F.G, (int)blockIdx.x);
        EpiRowScale<1> E{wsp<bf16>(F, WS_HID), FF, nullptr, wsp<float>(F, WS_P2), 1.0f};
        pg8::gemm_phase<EpiRowScale<1>, pg8::StaticOrder, true, true>(ring, g, S, E);
    }
    SEAM(8);
    if (IN(9)) {
        pg8::Gemm g{wsp<bf16>(F, WS_HID), wsp<bf16>(F, WS_WDN), T, DM, FF}; pg8::StaticOrder S; S.init(T, DM, F.G, (int)blockIdx.x);
        EpiResid E{outp(F), outp(F), nullptr, wsp<float>(F, WS_P3)};
        pg8::gemm_phase<EpiResid, pg8::StaticOrder, true, true>(ring, g, S, E);
    }
    SEAM(9);
    if (IN(10)) { p10_final(F); }
#undef IN
#undef SEAM
}

#ifndef N_LAUNCH_SPLIT
#define N_LAUNCH_SPLIT 0
#endif
extern "C" void kernel_launch(void* const* d_in, const int* in_sizes, int n_in, void* d_out, int out_size, void* d_ws, size_t ws_size, hipStream_t stream) {
    static int grid = 0;
    if (grid == 0) {
        if (n_in != 17 || out_size != T * DM || ws_size < WS_END) { fprintf(stderr, "kernel_launch: unexpected shapes: n_in %d out %d ws %zu\n", n_in, out_size, ws_size); grid = -1; return; }
        int dev = 0, cus = 0, per_cu = 0;
        if (hipGetDevice(&dev) != hipSuccess || hipDeviceGetAttribute(&cus, hipDeviceAttributeMultiprocessorCount, dev) != hipSuccess) { grid = -1; return; }
        if (hipFuncSetAttribute((const void*)fwd_kernel, hipFuncAttributeMaxDynamicSharedMemorySize, LDS_BYTES) != hipSuccess) { fprintf(stderr, "hipFuncSetAttribute failed\n"); grid = -1; return; }
        if (hipOccupancyMaxActiveBlocksPerMultiprocessor(&per_cu, (const void*)fwd_kernel, NWAVES * 64, LDS_BYTES) != hipSuccess || per_cu < 1) { fprintf(stderr, "occupancy query: %d\n", per_cu); per_cu = 1; }
        (void)hipGetLastError();
        grid = cus;
        fprintf(stderr, "kernel_launch: cus %d per_cu %d grid %d ws %zu\n", cus, per_cu, grid, ws_size);
    }
    if (grid < 0) return;
    if (hipMemsetAsync((char*)d_ws + WS_CTL, 0, 65536, stream) != hipSuccess) { fprintf(stderr, "memset failed\n"); return; }
    Args a{};
    for (int i = 0; i < 17; ++i) a.in[i] = (const float*)d_in[i];
    a.out = (float*)d_out; a.ws = (unsigned char*)d_ws;
#if N_LAUNCH_SPLIT
    for (int p = 0; p < 11; ++p) { a.ph_lo = p; a.ph_hi = p + 1; void* kargs[] = {&a};
        hipError_t e = hipLaunchCooperativeKernel((const void*)fwd_kernel, dim3(grid), dim3(NWAVES * 64), kargs, LDS_BYTES, stream);
        if (e != hipSuccess) { fprintf(stderr, "launch %d failed: %s\n", p, hipGetErrorString(e)); break; } }
#else
    a.ph_lo = 0; a.ph_hi = 11; void* kargs[] = {&a};
    hipError_t e = hipLaunchCooperativeKernel((const void*)fwd_kernel, dim3(grid), dim3(NWAVES * 64), kargs, LDS_BYTES, stream);
    if (e != hipSuccess) fprintf(stderr, "cooperative launch failed: %s (grid %d)\n", hipGetErrorString(e), grid);
#endif
}
```

```cpp
#include <hip/hip_runtime.h>
#include <hip/hip_cooperative_groups.h>
#include <cstdio>
#include <cstdint>
namespace cg = cooperative_groups;
namespace pg8 {
#define PG8_LAS __attribute__((address_space(3)))
typedef unsigned short bf16_t;
typedef short bf16x8 __attribute__((ext_vector_type(8)));
typedef float f32x4 __attribute__((ext_vector_type(4)));
typedef unsigned u32x4 __attribute__((ext_vector_type(4)));
constexpr int BM = 256, BK = 64, HALF = 128, HTB = HALF * BK * 2  , STAGE_BYTES = 8 * HTB, NXCD = 8, WGM = 8;

__host__ __device__ __forceinline__ int lds_byte(int r, int c) { const int st = (r >> 4) * 2 + (c >> 5), rr = r & 15, cc = c & 31, ob = rr * 64 + cc * 2; return st * 1024 + (ob ^ (((ob >> 9) & 1) << 5)); }
__host__ __device__ __forceinline__ void stage_rc(int b, int& R, int& C) { const int st = b / 1024, sb = b % 1024, swz = sb ^ (((sb >> 9) & 1) << 5); R = (st >> 1) * 16 + swz / 64; C = (st & 1) * 32 + (swz % 64) / 2; }
__host__ __device__ __forceinline__ int perm32(int rho) { const int n = rho >> 4, i = rho & 15; return 8 * (i >> 2) + 4 * n + (i & 3); }

struct Unit { int pm, pn; const char* pa; const char* pb; };
struct Gemm { const bf16_t* A; const bf16_t* Bt; int M, N, K, lda, ldb; };

struct StaticOrder {
    int nM, nN, nwg, G, c; const char* A; const char* B; size_t ta, tb;
    __host__ __device__ void init(const Gemm& g, int G_, int c_) { nM = g.M / BM; nN = g.N / BM; nwg = nM * nN; G = G_; c = c_; A = (const char*)g.A; B = (const char*)g.Bt; ta = (size_t)BM * g.lda * 2; tb = (size_t)BM * g.ldb * 2; }
    __host__ __device__ bool next(int i, Unit& u) const {
        const long L = (long)i * G + c; if (L >= nwg) return false;
        int wgid = (int)L; { const int q = nwg / NXCD, r = nwg % NXCD, xcd = wgid % NXCD, off = wgid / NXCD; wgid = (xcd < r ? xcd * (q + 1) : r * (q + 1) + (xcd - r) * q) + off; }
        const int nig = WGM * nN, gid = wgid / nig, fm = gid * WGM, gsz = (nM - fm) < WGM ? (nM - fm) : WGM;
        u.pm = fm + ((wgid % nig) % gsz); u.pn = (wgid % nig) / gsz; u.pa = A + (size_t)u.pm * ta; u.pb = B + (size_t)u.pn * tb; return true;
    }
    __device__ __forceinline__ void a_ready(const Unit&) const {}
    __device__ __forceinline__ void done(const Unit&) const {}
};


template <class Epi, class Sched, bool ALIGN_EPI = false, bool SP2 = false>
__device__ __forceinline__ void gemm_phase(PG8_LAS unsigned char* lds, const Gemm g, const Sched& S, const Epi& E, int wave_id) {
    unsigned ones_ = ~0u; asm volatile("" : "+s"(ones_));
    int tid_ = wave_id * 64 + (int)__builtin_amdgcn_mbcnt_hi(ones_, __builtin_amdgcn_mbcnt_lo(ones_, 0u)); asm volatile("" : "+v"(tid_));
    const int tid = tid_, wid = __builtin_amdgcn_readfirstlane(tid >> 6), lane = tid & 63, wr = wid >> 2, wc = wid & 3, fr = lane & 15, fq = lane >> 4;
    const int K = g.K, nt = K / BK;
    unsigned voffA[2], voffB[2];
#pragma unroll
    for (int i = 0; i < 2; ++i) { int R, C; stage_rc(tid * 16 + i * 8192, R, C); const int Rb = Epi::PERM ? ((R & ~31) + perm32(R & 31)) : R;
        voffA[i] = (unsigned)(R * g.lda + C) * 2u; voffB[i] = (unsigned)(Rb * g.ldb + C) * 2u; }
    const size_t kstep = (size_t)(BK * 2);
    const size_t hstepA = (size_t)HALF * g.lda * 2, hstepB = (size_t)HALF * g.ldb * 2;
    const unsigned ldsw = (unsigned)wid * 1024u;
    const int aoff = lds_byte(wr * 64 + fr, fq * 8), boff = lds_byte(wc * 32 + fr, fq * 8);
#define PG8_SA(b, h) (((b) * 2 + (h)) * HTB)
#define PG8_SB(b, h) ((4 + (b) * 2 + (h)) * HTB)
#define PG8_STAGE(bufoff, gbase, voff) do { _Pragma("unroll") for (int _i = 0; _i < 2; ++_i) \
        __builtin_amdgcn_global_load_lds((const unsigned*)((const char*)(gbase) + (voff)[_i]), (PG8_LAS unsigned*)(lds + (bufoff) + ldsw + _i * 8192), 16, 0, 0); } while (0)
#define PG8_LDA(dst, b, h) do { _Pragma("unroll") for (int m = 0; m < 4; ++m) _Pragma("unroll") for (int k = 0; k < 2; ++k) dst[m][k] = *(const PG8_LAS bf16x8*)(lds + PG8_SA(b, h) + aoff + m * 2048 + k * 1024); } while (0)
#define PG8_LDB(dst, b, h) do { _Pragma("unroll") for (int n = 0; n < 2; ++n) _Pragma("unroll") for (int k = 0; k < 2; ++k) dst[n][k] = *(const PG8_LAS bf16x8*)(lds + PG8_SB(b, h) + boff + n * 2048 + k * 1024); } while (0)
#define PG8_MMA(ai, bj, At, Bt) do { __builtin_amdgcn_s_setprio(1); _Pragma("unroll") for (int m = 0; m < 4; ++m) _Pragma("unroll") for (int n = 0; n < 2; ++n) _Pragma("unroll") for (int k = 0; k < 2; ++k) \
        acc[ai][bj][m][n] = __builtin_amdgcn_mfma_f32_16x16x32_bf16(Bt[n][k], At[m][k], acc[ai][bj][m][n], 0, 0, 0); __builtin_amdgcn_s_setprio(0); } while (0)
#define PG8_WAIT_V(n) asm volatile("s_waitcnt vmcnt(" #n ")" ::: "memory")
#define PG8_WAIT_L(n) asm volatile("s_waitcnt lgkmcnt(" #n ")" ::: "memory")
#define PG8_BAR __builtin_amdgcn_s_barrier()
#define PG8_SCHED __builtin_amdgcn_sched_barrier(0)
    Unit cur, nxt; int ui = 0;
    if (!S.next(0, cur)) return;
    f32x4 acc[2][2][4][2];
#pragma unroll
    for (int a = 0; a < 2; ++a)
#pragma unroll
        for (int b = 0; b < 2; ++b)
#pragma unroll
            for (int m = 0; m < 4; ++m)
#pragma unroll
                for (int n = 0; n < 2; ++n) acc[a][b][m][n] = (f32x4){0.f, 0.f, 0.f, 0.f};
    bf16x8 At[4][2], B0[2][2], B1[2][2];
    const char* cA = cur.pa; const char* cB = cur.pb;
    S.a_ready(cur);
    if constexpr (SP2) {
        PG8_STAGE(PG8_SB(0, 0), cB, voffB); PG8_STAGE(PG8_SB(0, 1), cB + hstepB, voffB); PG8_STAGE(PG8_SA(0, 0), cA, voffA); PG8_STAGE(PG8_SA(0, 1), cA + hstepA, voffA);
        if (wr == 1) PG8_BAR;
        PG8_WAIT_V(2); PG8_BAR;
        PG8_STAGE(PG8_SB(1, 0), cB + kstep, voffB); PG8_STAGE(PG8_SA(1, 0), cA + kstep, voffA); PG8_STAGE(PG8_SB(1, 1), cB + hstepB + kstep, voffB);
        PG8_WAIT_V(6); PG8_BAR;
    } else {
        PG8_STAGE(PG8_SB(0, 0), cB, voffB); PG8_STAGE(PG8_SA(0, 0), cA, voffA); PG8_STAGE(PG8_SB(0, 1), cB + hstepB, voffB); PG8_STAGE(PG8_SA(0, 1), cA + hstepA, voffA);
        if (wr == 1) PG8_BAR;
        PG8_WAIT_V(4); PG8_BAR;
        PG8_STAGE(PG8_SB(1, 0), cB + kstep, voffB); PG8_STAGE(PG8_SA(1, 0), cA + kstep, voffA); PG8_STAGE(PG8_SB(1, 1), cB + hstepB + kstep, voffB);
        PG8_WAIT_V(6); PG8_BAR;
    }
    for (;;) {
        const bool has_next = S.next(ui + 1, nxt);
        const char* nA = has_next ? nxt.pa : cA; const char* nB = has_next ? nxt.pb : cB;
        for (int t = 0; t < nt; t += 2) {
            const bool last = (t == nt - 2);
            const char* a1 = cA + (size_t)(t + 1) * kstep;
            const char* a2 = last ? nA : cA + (size_t)(t + 2) * kstep; const char* b2 = last ? nB : cB + (size_t)(t + 2) * kstep;
            const char* a3 = a2 + kstep; const char* b3 = b2 + kstep;
            if (last && has_next) S.a_ready(nxt);
            if constexpr (SP2) {
            PG8_LDB(B0, 0, 0); PG8_LDB(B1, 0, 1); PG8_SCHED; PG8_LDA(At, 0, 0); PG8_STAGE(PG8_SA(1, 1), a1 + hstepA, voffA);
            PG8_WAIT_V(8); PG8_WAIT_L(0); PG8_BAR; PG8_MMA(0, 0, At, B0); PG8_MMA(0, 1, At, B1); PG8_BAR; PG8_SCHED;
            PG8_LDA(At, 0, 1); PG8_STAGE(PG8_SB(0, 0), b2, voffB); PG8_STAGE(PG8_SB(0, 1), b2 + hstepB, voffB); PG8_STAGE(PG8_SA(0, 0), a2, voffA);
            PG8_WAIT_V(8); PG8_WAIT_L(0); PG8_BAR; PG8_MMA(1, 0, At, B0); PG8_MMA(1, 1, At, B1); PG8_BAR; PG8_SCHED;
            PG8_LDB(B0, 1, 0); PG8_LDB(B1, 1, 1); PG8_SCHED; PG8_LDA(At, 1, 0); PG8_STAGE(PG8_SA(0, 1), a2 + hstepA, voffA);
            PG8_WAIT_V(8); PG8_WAIT_L(0); PG8_BAR; PG8_MMA(0, 0, At, B0); PG8_MMA(0, 1, At, B1); PG8_BAR; PG8_SCHED;
            PG8_LDA(At, 1, 1); PG8_STAGE(PG8_SB(1, 0), b3, voffB); PG8_STAGE(PG8_SB(1, 1), b3 + hstepB, voffB); PG8_STAGE(PG8_SA(1, 0), a3, voffA);
            PG8_WAIT_V(8); PG8_WAIT_L(0); PG8_BAR; PG8_MMA(1, 0, At, B0); PG8_MMA(1, 1, At, B1); PG8_BAR; PG8_SCHED;
            } else {
            PG8_LDB(B0, 0, 0); PG8_SCHED; PG8_LDA(At, 0, 0); PG8_STAGE(PG8_SA(1, 1), a1 + hstepA, voffA);
            PG8_WAIT_L(8); PG8_BAR; PG8_WAIT_L(0); PG8_MMA(0, 0, At, B0); PG8_BAR; PG8_SCHED;
            PG8_LDB(B1, 0, 1); PG8_STAGE(PG8_SB(0, 0), b2, voffB);
            PG8_BAR; PG8_WAIT_L(0); PG8_MMA(0, 1, At, B1); PG8_BAR;
            PG8_LDA(At, 0, 1); PG8_STAGE(PG8_SA(0, 0), a2, voffA);
            PG8_BAR; PG8_WAIT_L(0); PG8_MMA(1, 0, At, B0); PG8_BAR; PG8_SCHED;
            PG8_STAGE(PG8_SB(0, 1), b2 + hstepB, voffB);
            PG8_WAIT_V(6); PG8_BAR; PG8_MMA(1, 1, At, B1); PG8_BAR;
            PG8_LDB(B0, 1, 0); PG8_SCHED; PG8_LDA(At, 1, 0); PG8_STAGE(PG8_SA(0, 1), a2 + hstepA, voffA);
            PG8_WAIT_L(8); PG8_BAR; PG8_WAIT_L(0); PG8_MMA(0, 0, At, B0); PG8_BAR; PG8_SCHED;
            PG8_LDB(B1, 1, 1); PG8_STAGE(PG8_SB(1, 0), b3, voffB);
            PG8_BAR; PG8_WAIT_L(0); PG8_MMA(0, 1, At, B1); PG8_BAR;
            PG8_LDA(At, 1, 1); PG8_STAGE(PG8_SA(1, 0), a3, voffA);
            PG8_BAR; PG8_WAIT_L(0); PG8_MMA(1, 0, At, B0); PG8_BAR; PG8_SCHED;
            PG8_STAGE(PG8_SB(1, 1), b3 + hstepB, voffB);
            PG8_WAIT_V(6); PG8_BAR; PG8_MMA(1, 1, At, B1); PG8_BAR;
            }
        }
        if constexpr (ALIGN_EPI) { if (wr == 0) PG8_BAR; }
        if constexpr (!Epi::AFTER_DRAIN) { E(acc, cur, wr, wc, fr, fq); S.done(cur); }
        if (!has_next) break;
#pragma unroll
        for (int a = 0; a < 2; ++a)
#pragma unroll
            for (int b = 0; b < 2; ++b)
#pragma unroll
                for (int m = 0; m < 4; ++m)
#pragma unroll
                    for (int n = 0; n < 2; ++n) acc[a][b][m][n] = (f32x4){0.f, 0.f, 0.f, 0.f};
        cur = nxt; cA = nA; cB = nB; ++ui;
        if constexpr (ALIGN_EPI) { if (wr == 1) PG8_BAR; }
    }
    PG8_WAIT_V(0);
    if constexpr (!ALIGN_EPI) { if (wr == 0) PG8_BAR; }
    PG8_BAR;
    if constexpr (Epi::AFTER_DRAIN) { E.fused(acc, cur, wr, wc, fr, fq, lds, wid, lane); S.done(cur); }
#undef PG8_SA
#undef PG8_SB
#undef PG8_STAGE
#undef PG8_LDA
#undef PG8_LDB
#undef PG8_MMA
#undef PG8_WAIT_V
#undef PG8_WAIT_L
#undef PG8_BAR
#undef PG8_SCHED
}
}


constexpr int NB = 32, SEQ = 2048, DM = 1024, T = NB * SEQ, MEMT = 256, TM = NB * MEMT, FF = 4096;
constexpr int NIN = 3584;
constexpr int KOUT = 1536;
constexpr int W_IN_COLS = 3048;
constexpr float EPS = 1e-6f, LOG2E = 1.4426950408889634f;
constexpr float SCALE_A = 0.10206207261596577f * LOG2E;
constexpr float SCALE_B = 0.125f * LOG2E;
constexpr float SCALE_C = 0.0625f * LOG2E;
constexpr float IDX_W = 0.044194173824159216f;
constexpr int NWAVES = 8;

constexpr size_t MiB = 1u << 20;
constexpr size_t WS_CTL = 0, WS_TAB64 = 1 * MiB, WS_TAB32 = 1 * MiB + 512 * 1024, WS_RSTD1 = 2 * MiB, WS_RSTDM = 2 * MiB + 512 * 1024;
constexpr size_t WS_P1 = 4 * MiB, WS_P2 = 8 * MiB, WS_P3 = 12 * MiB;
constexpr size_t WS_WIN = 16 * MiB, WS_WOUT = 24 * MiB, WS_WQ = 28 * MiB, WS_WKV = 30 * MiB, WS_WO = 34 * MiB, WS_WUP = 36 * MiB, WS_WDN = 44 * MiB;
constexpr size_t WS_XB = 52 * MiB, WS_MEMB = 180 * MiB, WS_KVC = 196 * MiB, WS_MASK = 228 * MiB, WS_HX = 244 * MiB;
constexpr size_t WS_QL = 436 * MiB, WS_QR = 564 * MiB, WS_CKVF = 596 * MiB, WS_CKV = 628 * MiB, WS_KR = 644 * MiB, WS_KI = 648 * MiB, WS_WI = 656 * MiB, WS_QI = 658 * MiB;
constexpr size_t WS_QB = 722 * MiB, WS_KB = 786 * MiB, WS_VB = 850 * MiB;
constexpr size_t WS_QC = 436 * MiB, WS_OC = 564 * MiB, WS_HID = 436 * MiB, WS_END = 948 * MiB;

constexpr int LDS_BYTES = 147456;

#define GAS __attribute__((address_space(1)))
#define LAS __attribute__((address_space(3)))
typedef unsigned short bf16;
typedef unsigned v4u __attribute__((ext_vector_type(4)));
typedef unsigned v2u __attribute__((ext_vector_type(2)));
typedef float f32x4 __attribute__((ext_vector_type(4)));
typedef float f32x2 __attribute__((ext_vector_type(2)));
#define LDS_WAIT() asm volatile("s_waitcnt lgkmcnt(0)" ::: "memory")

__device__ __forceinline__ unsigned f2bf(float f) { unsigned u = __builtin_bit_cast(unsigned, f); return (u + 0x7fffu + ((u >> 16) & 1u)) >> 16; }
__device__ __forceinline__ unsigned pk2(float lo, float hi) { return f2bf(lo) | (f2bf(hi) << 16); }
__device__ __forceinline__ float bflo(unsigned w) { return __uint_as_float(w << 16); }
__device__ __forceinline__ float bfhi(unsigned w) { return __uint_as_float(w & 0xffff0000u); }
__device__ __forceinline__ float wave_sum(float v) {
#pragma unroll
    for (int o = 1; o < 64; o <<= 1) v += __shfl_xor(v, o);
    return v;
}
__device__ __forceinline__ float wave_max(float v) {
#pragma unroll
    for (int o = 1; o < 64; o <<= 1) v = fmaxf(v, __shfl_xor(v, o));
    return v;
}

struct Frame {
    LAS unsigned char* lds;
    int tid, lane, wave, G, gw, NGW;
    int wave_s;
    const __attribute__((address_space(4))) char* kargs;
    float* out;
    unsigned char* ws;
    size_t z;
};
__device__ __forceinline__ const float* inp(const Frame& F, int i) {
    const __attribute__((address_space(4))) char* p = F.kargs; asm volatile("" : "+s"(p));
    return *(const float* const __attribute__((address_space(4)))*)(p + 8 * i);
}
template <class TT> __device__ __forceinline__ TT* wsp(const Frame& F, size_t off) { return (TT*)(F.ws + F.z + off); }
__device__ __forceinline__ float* outp(const Frame& F) { return (float*)((unsigned char*)F.out + F.z); }
__device__ __forceinline__ void phase_ctx(Frame& F) {
    size_t z = 0; asm volatile("" : "+s"(z)); F.z = z;
    int ws_ = F.wave_s; asm volatile("" : "+s"(ws_));
    unsigned ones_ = ~0u; asm volatile("" : "+s"(ones_));
    const int lane_ = (int)__builtin_amdgcn_mbcnt_hi(ones_, __builtin_amdgcn_mbcnt_lo(ones_, 0u));
    F.tid = ws_ * 64 + lane_; F.lane = lane_; F.wave = ws_; F.G = gridDim.x; F.gw = blockIdx.x * NWAVES + F.wave; F.NGW = F.G * NWAVES;
}

__device__ __forceinline__ float rstd_from_parts(const float* part, int row) {
    const f32x4* p = (const f32x4*)(part + (size_t)row * 16);
    const f32x4 a = p[0], b = p[1], c = p[2], d = p[3];
    const float s = ((a[0] + a[1]) + (a[2] + a[3])) + ((b[0] + b[1]) + (b[2] + b[3])) + ((c[0] + c[1]) + (c[2] + c[3])) + ((d[0] + d[1]) + (d[2] + d[3]));
    return 1.0f / sqrtf(s * (1.0f / DM) + EPS);
}
__device__ __forceinline__ f32x4 rope4(f32x4 v, f32x4 cs) { return (f32x4){v[0] * cs[0] - v[1] * cs[1], v[1] * cs[0] + v[0] * cs[1], v[2] * cs[2] - v[3] * cs[3], v[3] * cs[2] + v[2] * cs[3]}; }
__device__ __forceinline__ v4u pack8(f32x4 a, f32x4 b) { v4u w; w.x = pk2(a[0], a[1]); w.y = pk2(a[2], a[3]); w.z = pk2(b[0], b[1]); w.w = pk2(b[2], b[3]); return w; }

struct EpiInProj {
    static constexpr bool PERM = true, AFTER_DRAIN = false;
    const float* rstd; const float* tab64; const float* tab32;
    bf16 *QL, *QR, *KR, *KI, *QI, *QB, *KB, *VB; float *CKVF, *WI;
    __device__ __forceinline__ void operator()(const pg8::f32x4 (&acc)[2][2][4][2], const pg8::Unit& u, int wr, int wc, int fr, int fq) const {
        const int pn = u.pn;
#pragma unroll
        for (int ai = 0; ai < 2; ++ai)
#pragma unroll
            for (int m = 0; m < 4; ++m) {
                const int row = u.pm * 256 + ai * 128 + wr * 64 + m * 16 + fr, pos = row & (SEQ - 1);
                const float rs = rstd[row];
                if (pn < 4) {
#pragma unroll
                    for (int bj = 0; bj < 2; ++bj) { const f32x4 a = acc[ai][bj][m][0] * (rs * SCALE_A), b = acc[ai][bj][m][1] * (rs * SCALE_A);
                        *(v4u*)(QL + (size_t)row * 1024 + pn * 256 + bj * 128 + wc * 32 + 8 * fq) = pack8(a, b); }
                } else if (pn == 4) {
                    const f32x4 cs0 = *(const f32x4*)(tab32 + ((size_t)pos * 16 + 4 * fq) * 2), cs1 = *(const f32x4*)(tab32 + ((size_t)pos * 16 + 4 * fq + 2) * 2);
#pragma unroll
                    for (int bj = 0; bj < 2; ++bj) { const f32x4 a = rope4(acc[ai][bj][m][0] * (rs * SCALE_A), cs0), b = rope4(acc[ai][bj][m][1] * (rs * SCALE_A), cs1);
                        *(v4u*)(QR + (size_t)row * 256 + bj * 128 + wc * 32 + 8 * fq) = pack8(a, b); }
                } else if (pn == 5) {
                    { const f32x4 a = acc[ai][0][m][0] * rs, b = acc[ai][0][m][1] * rs; float* o = CKVF + (size_t)row * 128 + wc * 32 + 8 * fq; *(f32x4*)o = a; *(f32x4*)(o + 4) = b; }
                    if (wc == 0) {
                        const f32x4 cs0 = *(const f32x4*)(tab32 + ((size_t)pos * 16 + 4 * fq) * 2), cs1 = *(const f32x4*)(tab32 + ((size_t)pos * 16 + 4 * fq + 2) * 2);
                        const f32x4 a = rope4(acc[ai][1][m][0] * rs, cs0), b = rope4(acc[ai][1][m][1] * rs, cs1);
                        *(v4u*)(KR + (size_t)row * 32 + 8 * fq) = pack8(a, b);
                    } else if (wc < 3) {
                        const int tb = 16 * (wc - 1) + 4 * fq;
                        const f32x4 cs0 = *(const f32x4*)(tab64 + ((size_t)pos * 32 + tb) * 2), cs1 = *(const f32x4*)(tab64 + ((size_t)pos * 32 + tb + 2) * 2);
                        const f32x4 a = rope4(acc[ai][1][m][0] * rs, cs0), b = rope4(acc[ai][1][m][1] * rs, cs1);
                        *(v4u*)(KI + (size_t)row * 64 + 32 * (wc - 1) + 8 * fq) = pack8(a, b);
                    } else if (fq == 0) {
                        const f32x4 a = acc[ai][1][m][0] * (rs * IDX_W), b = acc[ai][1][m][1] * (rs * IDX_W); float* o = WI + (size_t)row * 8; *(f32x4*)o = a; *(f32x4*)(o + 4) = b;
                    }
                } else if (pn < 12) {
                    const int tb = 16 * (wc & 1) + 4 * fq;
                    const f32x4 cs0 = *(const f32x4*)(tab64 + ((size_t)pos * 32 + tb) * 2), cs1 = *(const f32x4*)(tab64 + ((size_t)pos * 32 + tb + 2) * 2);
                    const float sc = (pn == 8 || pn == 9) ? rs * SCALE_B : rs;
                    const size_t eoff = (size_t)row * 512 + (pn & 1) * 256 + wc * 32 + 8 * fq;
#pragma unroll
                    for (int bj = 0; bj < 2; ++bj) { const f32x4 a = rope4(acc[ai][bj][m][0] * sc, cs0), b = rope4(acc[ai][bj][m][1] * sc, cs1); const v4u w = pack8(a, b);
                        if (pn < 8) *(v4u*)(QI + eoff + bj * 128) = w; else if (pn < 10) *(v4u*)(QB + eoff + bj * 128) = w; else *(v4u*)(KB + eoff + bj * 128) = w; }
                } else {
#pragma unroll
                    for (int bj = 0; bj < 2; ++bj) { const f32x4 a = acc[ai][bj][m][0] * rs, b = acc[ai][bj][m][1] * rs;
                        *(v4u*)(VB + (size_t)row * 512 + (pn & 1) * 256 + bj * 128 + wc * 32 + 8 * fq) = pack8(a, b); }
                }
            }
    }
};
template <int ACT  > struct EpiRowScale {
    static constexpr bool PERM = true, AFTER_DRAIN = false;
    bf16* O; int ldc; const float* rstd_direct; const float* parts; float cs;
    __device__ __forceinline__ void operator()(const pg8::f32x4 (&acc)[2][2][4][2], const pg8::Unit& u, int wr, int wc, int fr, int fq) const {
#pragma unroll
        for (int ai = 0; ai < 2; ++ai)
#pragma unroll
            for (int m = 0; m < 4; ++m) {
                const int row = u.pm * 256 + ai * 128 + wr * 64 + m * 16 + fr;
                const float rs = (ACT == 2) ? 1.0f : (parts ? rstd_from_parts(parts, row) : rstd_direct[row]) * cs;
#pragma unroll
                for (int bj = 0; bj < 2; ++bj) { f32x4 a = acc[ai][bj][m][0] * rs, b = acc[ai][bj][m][1] * rs;
                    if (ACT == 1) {
#pragma unroll
                        for (int e = 0; e < 4; ++e) { const float x = fmaxf(a[e], 0.f), y = fmaxf(b[e], 0.f); a[e] = x * x; b[e] = y * y; } }
                    *(v4u*)(O + (size_t)row * ldc + u.pn * 256 + bj * 128 + wc * 32 + 8 * fq) = pack8(a, b); }
            }
    }
};
struct EpiResid {
    static constexpr bool PERM = true, AFTER_DRAIN = false;
    const float* resid; float* OUT; bf16* XBo; float* parts;
    __device__ __forceinline__ void operator()(const pg8::f32x4 (&acc)[2][2][4][2], const pg8::Unit& u, int wr, int wc, int fr, int fq) const {
#pragma unroll
        for (int ai = 0; ai < 2; ++ai)
#pragma unroll
            for (int m = 0; m < 4; ++m) {
                const int row = u.pm * 256 + ai * 128 + wr * 64 + m * 16 + fr;
                float ss = 0.f;
#pragma unroll
                for (int bj = 0; bj < 2; ++bj) { const size_t off = (size_t)row * DM + u.pn * 256 + bj * 128 + wc * 32 + 8 * fq;
                    const f32x4 a = *(const f32x4*)(resid + off) + acc[ai][bj][m][0], b = *(const f32x4*)(resid + off + 4) + acc[ai][bj][m][1];
                    *(f32x4*)(OUT + off) = a; *(f32x4*)(OUT + off + 4) = b;
                    if (XBo) *(v4u*)(XBo + off) = pack8(a, b);
                    ss += (a[0] * a[0] + a[1] * a[1]) + (a[2] * a[2] + a[3] * a[3]) + (b[0] * b[0] + b[1] * b[1]) + (b[2] * b[2] + b[3] * b[3]); }
                ss += __shfl_xor(ss, 16); ss += __shfl_xor(ss, 32);
                if (fq == 0) parts[(size_t)row * 16 + u.pn * 4 + wc] = ss;
            }
    }
};

struct KvOrder {
    int G, c; const char* memb; const char* wkv;
    __device__ __forceinline__ bool next(int i, pg8::Unit& u) const {
        const int L = i * G + c; if (L >= 256) return false;
        if (L < 128) { u.pm = L >> 2; u.pn = L & 3; u.pa = memb + (size_t)u.pm * 256 * DM * 2; u.pb = wkv + (size_t)u.pn * 256 * DM * 2; }
        else { const int l2 = L - 128; u.pm = 64 + (l2 & 3); u.pn = l2 >> 2; u.pa = wkv + (size_t)(1024 + (l2 & 3) * 256) * DM * 2; u.pb = memb + (size_t)u.pn * 256 * DM * 2; }
        return true;
    }
    __device__ __forceinline__ void a_ready(const pg8::Unit&) const {}
    __device__ __forceinline__ void done(const pg8::Unit&) const {}
};
struct EpiKv {
    static constexpr bool PERM = true, AFTER_DRAIN = false;
    bf16* KC; bf16* VT; const float* rstd;
    __device__ __forceinline__ void operator()(const pg8::f32x4 (&acc)[2][2][4][2], const pg8::Unit& u, int wr, int wc, int fr, int fq) const {
        const bool isv = u.pm >= 64; const int pm = isv ? u.pm - 64 : u.pm;
#pragma unroll
        for (int ai = 0; ai < 2; ++ai)
#pragma unroll
            for (int m = 0; m < 4; ++m) {
                const int row = pm * 256 + ai * 128 + wr * 64 + m * 16 + fr;
#pragma unroll
                for (int bj = 0; bj < 2; ++bj) { const int col = u.pn * 256 + bj * 128 + wc * 32 + 8 * fq;
                    if (!isv) { const float rs = rstd[row]; *(v4u*)(KC + (size_t)row * DM + col) = pack8(acc[ai][bj][m][0] * rs, acc[ai][bj][m][1] * rs); }
                    else { const f32x4 r0 = *(const f32x4*)(rstd + col), r1 = *(const f32x4*)(rstd + col + 4); *(v4u*)(VT + (size_t)row * TM + col) = pack8(acc[ai][bj][m][0] * r0, acc[ai][bj][m][1] * r1); } }
            }
    }
};
struct CrossOrder {
    int G, c; const char* A; const char* B; size_t bstride, hstride;
    __device__ __forceinline__ bool next(int i, pg8::Unit& u) const {
        if (i >= 4) return false;
        const int xcd = c & 7, slot = c >> 3, e = i * 32 + slot, pair = xcd * 16 + (e >> 3), qt = e & 7, b = pair >> 2, h = pair & 3;
        u.pm = b * 8 + qt; u.pn = h; u.pa = A + ((size_t)u.pm * 256 * DM + h * 256) * 2; u.pb = B + (size_t)b * bstride + (size_t)h * hstride; return true;
    }
    __device__ __forceinline__ void a_ready(const pg8::Unit&) const {}
    __device__ __forceinline__ void done(const pg8::Unit&) const {}
};
struct EpiSoftmaxP {
    static constexpr bool PERM = true, AFTER_DRAIN = false;
    bf16* P; LAS float* xch;
    __device__ __forceinline__ void operator()(const pg8::f32x4 (&acc_)[2][2][4][2], const pg8::Unit& u, int wr, int wc, int fr, int fq) const {
        pg8::f32x4 (&acc)[2][2][4][2] = const_cast<pg8::f32x4 (&)[2][2][4][2]>(acc_);
        LAS float* xb = xch + (wr * 64 + fr) * 8; asm volatile("" : "+v"(xb));
#pragma unroll
        for (int ai = 0; ai < 2; ++ai)
#pragma unroll
            for (int m = 0; m < 4; ++m) {
                float v = -INFINITY;
#pragma unroll
                for (int bj = 0; bj < 2; ++bj)
#pragma unroll
                    for (int n = 0; n < 2; ++n) { const f32x4 x = acc[ai][bj][m][n]; v = fmaxf(v, fmaxf(fmaxf(x[0], x[1]), fmaxf(x[2], x[3]))); }
                v = fmaxf(v, __shfl_xor(v, 16)); v = fmaxf(v, __shfl_xor(v, 32));
                float s = 0.f;
#pragma unroll
                for (int bj = 0; bj < 2; ++bj)
#pragma unroll
                    for (int n = 0; n < 2; ++n) { f32x4 x = acc[ai][bj][m][n];
#pragma unroll
                        for (int e = 0; e < 4; ++e) { x[e] = __builtin_amdgcn_exp2f(x[e] - v); s += x[e]; }
                        acc[ai][bj][m][n] = x; }
                s += __shfl_xor(s, 16); s += __shfl_xor(s, 32);
                if (fq == 0) *(LAS f32x2*)(xb + (ai * 128 + m * 16) * 8 + wc * 2) = (f32x2){v, s};
            }
        asm volatile("s_waitcnt lgkmcnt(0)" ::: "memory"); __builtin_amdgcn_s_barrier(); asm volatile("" ::: "memory");
#pragma unroll
        for (int ai = 0; ai < 2; ++ai)
#pragma unroll
            for (int m = 0; m < 4; ++m) {
                const int rl = ai * 128 + wr * 64 + m * 16 + fr, row = u.pm * 256 + rl;
                const f32x4 a = *(const LAS f32x4*)(xb + (ai * 128 + m * 16) * 8), b = *(const LAS f32x4*)(xb + (ai * 128 + m * 16) * 8 + 4);
                const float M = fmaxf(fmaxf(a[0], a[2]), fmaxf(b[0], b[2]));
                const float L = a[1] * __builtin_amdgcn_exp2f(a[0] - M) + a[3] * __builtin_amdgcn_exp2f(a[2] - M) + b[1] * __builtin_amdgcn_exp2f(b[0] - M) + b[3] * __builtin_amdgcn_exp2f(b[2] - M);
                const float mown = (wc == 0) ? a[0] : (wc == 1) ? a[2] : (wc == 2) ? b[0] : b[2];
                const float sc = __builtin_amdgcn_exp2f(mown - M) / L;
#pragma unroll
                for (int bj = 0; bj < 2; ++bj) *(v4u*)(P + (size_t)row * DM + u.pn * 256 + bj * 128 + wc * 32 + 8 * fq) = pack8(acc[ai][bj][m][0] * sc, acc[ai][bj][m][1] * sc);
                __builtin_amdgcn_sched_barrier(0);
            }
        asm volatile("s_waitcnt lgkmcnt(0)" ::: "memory"); __builtin_amdgcn_s_barrier(); asm volatile("" ::: "memory");
    }
};

template <class Map>
__device__ __forceinline__ void transpose_item(const float* W, int srcN, const float* g, bf16* WT, int ldk, int koff, LAS float* scr, int k0, int n0, int lane, const Map& map) {
    const int sc = map(n0 + (lane & 31));
#pragma unroll 8
    for (int i = 0; i < 32; ++i) { const int kk = 2 * i + (lane >> 5); float v = (sc >= 0) ? W[(size_t)(k0 + kk) * srcN + sc] : 0.f; if (g) v *= g[k0 + kk]; scr[kk * 33 + (lane & 31)] = v; }
    LDS_WAIT(); asm volatile("" ::: "memory");
    const int c = lane & 7;
#pragma unroll
    for (int j = 0; j < 4; ++j) { const int n = (lane >> 3) + 8 * j; const LAS float* s = scr + (8 * c) * 33 + n;
        v4u o; o.x = pk2(s[0 * 33], s[1 * 33]); o.y = pk2(s[2 * 33], s[3 * 33]); o.z = pk2(s[4 * 33], s[5 * 33]); o.w = pk2(s[6 * 33], s[7 * 33]);
        *(v4u*)(WT + (size_t)(n0 + n) * ldk + koff + k0 + 8 * c) = o; }
    LDS_WAIT(); asm volatile("" ::: "memory");
}
struct MapId { __device__ __forceinline__ int operator()(int n) const { return n; } };
__device__ __forceinline__ int il64(int p) { return (p >> 1) + 32 * (p & 1); }
__device__ __forceinline__ int il32(int p) { return (p >> 1) + 16 * (p & 1); }
struct MapIn {
    __device__ __forceinline__ int operator()(int nn) const {
        int n = nn - 1024;
        if (n < 256) return 512 + (n >> 5) * 32 + il32(n & 31);
        n -= 256;
        if (n < 256) { if (n < 128) return 768 + n; if (n < 160) return 896 + il32(n - 128); if (n < 224) return 1440 + il64(n - 160); if (n < 232) return 1504 + (n - 224); return -1; }
        n -= 256;
        if (n < 512) return 928 + (n >> 6) * 64 + il64(n & 63);
        n -= 512;
        if (n < 512) return 1512 + (n >> 6) * 64 + il64(n & 63);
        n -= 512;
        if (n < 512) return 2024 + (n >> 6) * 64 + il64(n & 63);
        n -= 512;
        return 2536 + n;
    }
};

__device__ __forceinline__ void p0_prologue(Frame& F) {
    LAS float* scr = (LAS float*)(F.lds + F.wave * 16384);
    const int gw = F.gw, NGW = F.NGW, lane = F.lane;
    const float *x = inp(F, 0), *mem = inp(F, 1), *g_mix = inp(F, 2), *w_in = inp(F, 3), *w_uk = inp(F, 5), *w_uv = inp(F, 6), *w_out = inp(F, 7), *g_cross = inp(F, 8), *g_mem = inp(F, 9);
    const float *w_q = inp(F, 10), *w_kv = inp(F, 11), *w_o = inp(F, 12), *g_mlp = inp(F, 13), *w_up = inp(F, 14), *w_dn = inp(F, 15);
    bf16 *WIN = wsp<bf16>(F, WS_WIN), *WOUT = wsp<bf16>(F, WS_WOUT), *WQ = wsp<bf16>(F, WS_WQ), *WKV = wsp<bf16>(F, WS_WKV), *WO = wsp<bf16>(F, WS_WO), *WUP = wsp<bf16>(F, WS_WUP), *WDN = wsp<bf16>(F, WS_WDN);
    constexpr int I_IN = 16 * (2560 / 32), I_OUT2 = 8 * 32, I_Q = 16 * 32, I_KV = 16 * 64, I_O = 16 * 32, I_UP = 16 * 128, I_DN = 64 * 32;
    constexpr int NIT = I_IN + I_OUT2 + I_Q + I_KV + I_O + I_UP + I_DN;
    for (int it = gw; it < NIT; it += NGW) {
        int r = it;
        if (r < I_IN) { const int nb = r % 80, kb = r / 80; transpose_item(w_in, W_IN_COLS, g_mix, WIN, DM, 0, scr, 64 * kb, 1024 + 32 * nb, lane, MapIn()); continue; } r -= I_IN;
        if (r < I_OUT2) { const int nb = r % 32, kb = r / 32; transpose_item(w_out + (size_t)512 * DM, DM, nullptr, WOUT, KOUT, 1024, scr, 64 * kb, 32 * nb, lane, MapId()); continue; } r -= I_OUT2;
        if (r < I_Q) { const int nb = r % 32, kb = r / 32; transpose_item(w_q, DM, g_cross, WQ, DM, 0, scr, 64 * kb, 32 * nb, lane, MapId()); continue; } r -= I_Q;
        if (r < I_KV) { const int nb = r % 64, kb = r / 64; transpose_item(w_kv, 2048, g_mem, WKV, DM, 0, scr, 64 * kb, 32 * nb, lane, MapId()); continue; } r -= I_KV;
        if (r < I_O) { const int nb = r % 32, kb = r / 32; transpose_item(w_o, DM, nullptr, WO, DM, 0, scr, 64 * kb, 32 * nb, lane, MapId()); continue; } r -= I_O;
        if (r < I_UP) { const int nb = r % 128, kb = r / 128; transpose_item(w_up, FF, g_mlp, WUP, DM, 0, scr, 64 * kb, 32 * nb, lane, MapId()); continue; } r -= I_UP;
        { const int nb = r % 32, kb = r / 32; transpose_item(w_dn, DM, nullptr, WDN, FF, 0, scr, 64 * kb, 32 * nb, lane, MapId()); }
    }
    for (int it = gw; it < 8 * 16 * 8; it += NGW) {
        const int cg8 = it & 7, kb = (it >> 3) & 15, h = it >> 7, k = kb * 64 + lane;
        float a[16];
#pragma unroll
        for (int c = 0; c < 16; ++c) a[c] = 0.f;
        const float* wrow = w_in + (size_t)k * W_IN_COLS + h * 64;
        const float* uk = w_uk + (size_t)h * 64 * 128 + cg8 * 16 + (lane & 15);
#pragma unroll 2
        for (int j = 0; j < 64; ++j) {
            const float wv = wrow[j]; const float u = uk[(size_t)j * 128];
#pragma unroll
            for (int c = 0; c < 16; ++c) a[c] += wv * __shfl(u, c);
        }
        const float gk = g_mix[k];
#pragma unroll
        for (int c = 0; c < 16; ++c) WIN[(size_t)(h * 128 + cg8 * 16 + c) * DM + k] = (bf16)f2bf(a[c] * gk);
    }
    for (int it = gw; it < 8 * 16 * 8; it += NGW) {
        const int cg8 = it & 7, nb = (it >> 3) & 15, h = it >> 7, n = nb * 64 + lane;
        float a[16];
#pragma unroll
        for (int c = 0; c < 16; ++c) a[c] = 0.f;
        const float* uv = w_uv + (size_t)(h * 128 + cg8 * 16 + (lane & 15)) * 64;
#pragma unroll 2
        for (int v = 0; v < 64; ++v) {
            const float wv = w_out[(size_t)(h * 64 + v) * DM + n]; const float u = uv[v];
#pragma unroll
            for (int c = 0; c < 16; ++c) a[c] += wv * __shfl(u, c);
        }
        v4u o0, o1; o0.x = pk2(a[0], a[1]); o0.y = pk2(a[2], a[3]); o0.z = pk2(a[4], a[5]); o0.w = pk2(a[6], a[7]); o1.x = pk2(a[8], a[9]); o1.y = pk2(a[10], a[11]); o1.z = pk2(a[12], a[13]); o1.w = pk2(a[14], a[15]);
        bf16* d = WOUT + (size_t)n * KOUT + h * 128 + cg8 * 16; *(v4u*)d = o0; *(v4u*)(d + 8) = o1;
    }
    bf16 *XB = wsp<bf16>(F, WS_XB), *MEMB = wsp<bf16>(F, WS_MEMB); float *R1 = wsp<float>(F, WS_RSTD1), *RM = wsp<float>(F, WS_RSTDM);
    for (int m = gw; m < T + TM; m += NGW) {
        const bool isx = m < T; const int r = isx ? m : m - T;
        const f32x4* xr = (const f32x4*)((isx ? x : mem) + (size_t)r * DM) + lane;
        f32x4 v[4]; float s = 0.f;
#pragma unroll
        for (int j = 0; j < 4; ++j) { v[j] = xr[64 * j]; s += (v[j][0] * v[j][0] + v[j][1] * v[j][1]) + (v[j][2] * v[j][2] + v[j][3] * v[j][3]); }
        s = wave_sum(s);
        if (lane == 0) (isx ? R1 : RM)[r] = 1.0f / sqrtf(s * (1.0f / DM) + EPS);
        v2u* o8 = (v2u*)((isx ? XB : MEMB) + (size_t)r * DM) + lane;
#pragma unroll
        for (int j = 0; j < 4; ++j) { v2u w; w.x = pk2(v[j][0], v[j][1]); w.y = pk2(v[j][2], v[j][3]); o8[64 * j] = w; }
    }
    float *T64 = wsp<float>(F, WS_TAB64), *T32 = wsp<float>(F, WS_TAB32);
    for (int e = gw * 64 + lane; e < SEQ * 32; e += NGW * 64) {
        const int pos = e >> 5, t = e & 31;
        const float inv = exp2f(-(float)t * (13.287712379549449f / 32.0f));
        const float ang = (float)pos * inv;
        const double rev = (double)ang * 0.15915494309189535; const float fr = (float)(rev - floor(rev));
        const float c = __builtin_amdgcn_cosf(fr), s = __builtin_amdgcn_sinf(fr);
        T64[2 * e] = c; T64[2 * e + 1] = s;
        if ((t & 1) == 0) { T32[2 * (pos * 16 + (t >> 1))] = c; T32[2 * (pos * 16 + (t >> 1)) + 1] = s; }
    }
}

__device__ __forceinline__ void p2_ckv_norm(Frame& F) {
    const float* CKVF = wsp<float>(F, WS_CKVF); bf16* CKV = wsp<bf16>(F, WS_CKV); const float* g = inp(F, 4);
    const float g0 = g[2 * F.lane], g1 = g[2 * F.lane + 1];
    for (int r = F.gw; r < T; r += F.NGW) {
        const f32x2 v = *(const f32x2*)(CKVF + (size_t)r * 128 + 2 * F.lane);
        const float ss = wave_sum(v[0] * v[0] + v[1] * v[1]);
        const float rs = 1.0f / sqrtf(ss * (1.0f / 128.0f) + EPS);
        *(unsigned*)(CKV + (size_t)r * 128 + 2 * F.lane) = pk2(v[0] * rs * g0, v[1] * rs * g1);
    }
}
__device__ __forceinline__ void p2_index_select(Frame& F) {
    const bf16 *QI = wsp<bf16>(F, WS_QI), *KI = wsp<bf16>(F, WS_KI); const float* WI = wsp<float>(F, WS_WI); unsigned* MASK = wsp<unsigned>(F, WS_MASK);
    LAS float* qf = (LAS float*)(F.lds + F.wave * 16384);
    LAS unsigned* keys = (LAS unsigned*)(F.lds + F.wave * 16384 + 2048);
    const int lane = F.lane;
    for (int t = F.gw; t < T; t += F.NGW) {
        const int b = t >> 11, q = t & (SEQ - 1);
        { const v4u w = *(const v4u*)(QI + (size_t)t * 512 + 8 * lane);
          *(LAS f32x4*)(qf + 8 * lane) = (f32x4){bflo(w.x), bfhi(w.x), bflo(w.y), bfhi(w.y)}; *(LAS f32x4*)(qf + 8 * lane + 4) = (f32x4){bflo(w.z), bfhi(w.z), bflo(w.w), bfhi(w.w)}; }
        const f32x4 wa = *(const f32x4*)(WI + (size_t)t * 8), wb = *(const f32x4*)(WI + (size_t)t * 8 + 4);
        const float wh[8] = {wa[0], wa[1], wa[2], wa[3], wb[0], wb[1], wb[2], wb[3]};
        LDS_WAIT();
        const int nr = (q >> 6) + 1;
#pragma unroll 1
        for (int r = 0; r < nr; ++r) {
            asm volatile("" ::: "memory");
            const int s = r * 64 + lane;
            const v4u* kp = (const v4u*)(KI + (size_t)(b * SEQ + s) * 64);
            float dh[8];
#pragma unroll
            for (int h = 0; h < 8; ++h) dh[h] = 0.f;
#pragma unroll 1
            for (int hf = 0; hf < 2; ++hf) {
                asm volatile("" ::: "memory");
                float kf[32];
#pragma unroll
                for (int i = 0; i < 4; ++i) { const v4u w = kp[hf * 4 + i]; kf[8 * i] = bflo(w.x); kf[8 * i + 1] = bfhi(w.x); kf[8 * i + 2] = bflo(w.y); kf[8 * i + 3] = bfhi(w.y); kf[8 * i + 4] = bflo(w.z); kf[8 * i + 5] = bfhi(w.z); kf[8 * i + 6] = bflo(w.w); kf[8 * i + 7] = bfhi(w.w); }
#pragma unroll
                for (int h = 0; h < 8; ++h) {
#pragma unroll
                    for (int i = 0; i < 32; i += 4) { const f32x4 qv = *(const LAS f32x4*)(qf + h * 64 + hf * 32 + i); dh[h] += qv[0] * kf[i] + qv[1] * kf[i + 1] + qv[2] * kf[i + 2] + qv[3] * kf[i + 3]; }
                    __builtin_amdgcn_sched_barrier(0); }
            }
            float score = 0.f;
#pragma unroll
            for (int h = 0; h < 8; ++h) score += fmaxf(dh[h], 0.f) * wh[h];
            unsigned ord = __float_as_uint(score); ord ^= (ord >> 31) ? 0xFFFFFFFFu : 0x80000000u;
            keys[s] = (s <= q) ? ((ord & 0xFFFFF800u) | (unsigned)(SEQ - 1 - s)) : 0u;
        }
        LDS_WAIT();
        unsigned key[32];
#pragma unroll
        for (int r = 0; r < 32; ++r) key[r] = (r < nr) ? keys[r * 64 + lane] : 0u;
        unsigned thr = 1u;
        if (q >= 256) {
            unsigned lo = 0u;
#pragma unroll 1
            for (int bit = 31; bit >= 0; --bit) {
                const unsigned cand = lo | (1u << bit); int cnt = 0;
#pragma unroll
                for (int r = 0; r < 32; ++r) { cnt += __popcll(__ballot(key[r] >= cand)); if ((r & 3) == 3) __builtin_amdgcn_sched_barrier(0); }
                if (cnt >= 256) lo = cand;
            }
            thr = lo;
        }
        LAS unsigned long long* lm = (LAS unsigned long long*)keys;
#pragma unroll
        for (int r = 0; r < 32; ++r) { const unsigned long long bm = __ballot(key[r] >= thr && key[r] != 0u); if (lane == 0) lm[r] = bm; if ((r & 3) == 3) __builtin_amdgcn_sched_barrier(0); }
        LDS_WAIT();
        const unsigned long long mine = lm[lane & 31];
        if (lane < 32) *(unsigned long long*)(MASK + (size_t)t * 64 + 2 * lane) = mine;
        LDS_WAIT();
    }
}
__device__ __forceinline__ void p3_dsa_naive(Frame& F) {
    const bf16 *QL = wsp<bf16>(F, WS_QL), *QR = wsp<bf16>(F, WS_QR), *CKV = wsp<bf16>(F, WS_CKV), *KR = wsp<bf16>(F, WS_KR); const unsigned* MASK = wsp<unsigned>(F, WS_MASK); bf16* HX = wsp<bf16>(F, WS_HX);
    LAS float* qf = (LAS float*)(F.lds + F.wave * 16384);
    LAS int* list = (LAS int*)(F.lds + F.wave * 16384 + 5120);
    LAS float* P = (LAS float*)(F.lds + F.wave * 16384 + 6144);
    const int lane = F.lane;
    for (int t = F.gw; t < T; t += F.NGW) {
        const int b = t >> 11;
#pragma unroll
        for (int j = 0; j < 2; ++j) { const int e0 = j * 512 + 8 * lane; const v4u w = *(const v4u*)(QL + (size_t)t * 1024 + e0); const int h = e0 >> 7, c = e0 & 127; LAS float* d = qf + h * 160 + c;
            *(LAS f32x4*)d = (f32x4){bflo(w.x), bfhi(w.x), bflo(w.y), bfhi(w.y)}; *(LAS f32x4*)(d + 4) = (f32x4){bflo(w.z), bfhi(w.z), bflo(w.w), bfhi(w.w)}; }
        { const int e0 = 4 * lane; const v2u w = *(const v2u*)(QR + (size_t)t * 256 + e0); const int h = e0 >> 5, c = e0 & 31; *(LAS f32x4*)(qf + h * 160 + 128 + c) = (f32x4){bflo(w.x), bfhi(w.x), bflo(w.y), bfhi(w.y)}; }
        unsigned w = MASK[(size_t)t * 64 + lane];
        const int cl = __popc(w); int pre = cl;
#pragma unroll
        for (int o = 1; o < 64; o <<= 1) { const int v = __shfl_up(pre, o); if (lane >= o) pre += v; }
        const int cnt = __shfl(pre, 63); int pos = pre - cl;
        while (w) { const int bb = __ffs(w) - 1; list[pos++] = lane * 32 + bb; w &= w - 1; }
        LDS_WAIT();
#pragma unroll 1
        for (int ci = 0; ci * 64 < cnt; ++ci) {
            const int j = ci * 64 + lane; const bool act = j < cnt; const int s = act ? list[j] : 0; const size_t row = (size_t)b * SEQ + s;
            float a[8];
#pragma unroll
            for (int h = 0; h < 8; ++h) a[h] = 0.f;
#pragma unroll 1
            for (int cc = 0; cc < 5; ++cc) {
                asm volatile("" ::: "memory");
                const v4u* kp = (cc < 4) ? (const v4u*)(CKV + row * 128 + cc * 32) : (const v4u*)(KR + row * 32);
                float kf[32];
#pragma unroll
                for (int i = 0; i < 4; ++i) { const v4u ww = kp[i]; kf[8 * i] = bflo(ww.x); kf[8 * i + 1] = bfhi(ww.x); kf[8 * i + 2] = bflo(ww.y); kf[8 * i + 3] = bfhi(ww.y); kf[8 * i + 4] = bflo(ww.z); kf[8 * i + 5] = bfhi(ww.z); kf[8 * i + 6] = bflo(ww.w); kf[8 * i + 7] = bfhi(ww.w); }
#pragma unroll
                for (int h = 0; h < 8; ++h) {
#pragma unroll
                    for (int i = 0; i < 32; i += 4) { const f32x4 qv = *(const LAS f32x4*)(qf + h * 160 + cc * 32 + i); a[h] += qv[0] * kf[i] + qv[1] * kf[i + 1] + qv[2] * kf[i + 2] + qv[3] * kf[i + 3]; }
                    __builtin_amdgcn_sched_barrier(0); }
            }
            LAS float* d = P + j * 8; *(LAS f32x4*)d = (f32x4){a[0], a[1], a[2], a[3]}; *(LAS f32x4*)(d + 4) = (f32x4){a[4], a[5], a[6], a[7]};
        }
        LDS_WAIT();
        float sc[4][8];
#pragma unroll
        for (int ci = 0; ci < 4; ++ci) { const int j = ci * 64 + lane; const bool act = j < cnt; const f32x4 pa = *(const LAS f32x4*)(P + j * 8), pb = *(const LAS f32x4*)(P + j * 8 + 4);
            sc[ci][0] = act ? pa[0] : -INFINITY; sc[ci][1] = act ? pa[1] : -INFINITY; sc[ci][2] = act ? pa[2] : -INFINITY; sc[ci][3] = act ? pa[3] : -INFINITY;
            sc[ci][4] = act ? pb[0] : -INFINITY; sc[ci][5] = act ? pb[1] : -INFINITY; sc[ci][6] = act ? pb[2] : -INFINITY; sc[ci][7] = act ? pb[3] : -INFINITY; }
        LDS_WAIT();
#pragma unroll
        for (int h = 0; h < 8; ++h) {
            float m = fmaxf(fmaxf(sc[0][h], sc[1][h]), fmaxf(sc[2][h], sc[3][h])); m = wave_max(m);
            float l = 0.f;
#pragma unroll
            for (int ci = 0; ci < 4; ++ci) { sc[ci][h] = exp2f(sc[ci][h] - m); l += sc[ci][h]; }
            l = wave_sum(l); const float il = 1.0f / l;
#pragma unroll
            for (int ci = 0; ci < 4; ++ci) sc[ci][h] *= il;
        }
#pragma unroll
        for (int ci = 0; ci < 4; ++ci) { LAS float* d = P + (ci * 64 + lane) * 8; *(LAS f32x4*)d = (f32x4){sc[ci][0], sc[ci][1], sc[ci][2], sc[ci][3]}; *(LAS f32x4*)(d + 4) = (f32x4){sc[ci][4], sc[ci][5], sc[ci][6], sc[ci][7]}; }
        LDS_WAIT();
        float o0[8], o1[8];
#pragma unroll
        for (int h = 0; h < 8; ++h) { o0[h] = 0.f; o1[h] = 0.f; }
#pragma unroll 4
        for (int j = 0; j < cnt; ++j) {
            const int s = list[j]; const unsigned v = *(const unsigned*)(CKV + ((size_t)b * SEQ + s) * 128 + 2 * lane);
            const f32x4 pa = *(const LAS f32x4*)(P + j * 8), pb = *(const LAS f32x4*)(P + j * 8 + 4); const float v0 = bflo(v), v1 = bfhi(v);
            o0[0] += pa[0] * v0; o1[0] += pa[0] * v1; o0[1] += pa[1] * v0; o1[1] += pa[1] * v1; o0[2] += pa[2] * v0; o1[2] += pa[2] * v1; o0[3] += pa[3] * v0; o1[3] += pa[3] * v1;
            o0[4] += pb[0] * v0; o1[4] += pb[0] * v1; o0[5] += pb[1] * v0; o1[5] += pb[1] * v1; o0[6] += pb[2] * v0; o1[6] += pb[2] * v1; o0[7] += pb[3] * v0; o1[7] += pb[3] * v1;
        }
#pragma unroll
        for (int h = 0; h < 8; ++h) *(unsigned*)(HX + (size_t)t * KOUT + h * 128 + 2 * lane) = pk2(o0[h], o1[h]);
        LDS_WAIT();
    }
}
__device__ __forceinline__ void p3_dilated_naive(Frame& F) {
    const bf16 *QB = wsp<bf16>(F, WS_QB), *KB = wsp<bf16>(F, WS_KB), *VB = wsp<bf16>(F, WS_VB); bf16* HX = wsp<bf16>(F, WS_HX);
    LAS float* qf = (LAS float*)(F.lds + F.wave * 16384);
    LAS float* P = (LAS float*)(F.lds + F.wave * 16384 + 256);
    const int lane = F.lane;
    for (int it = F.gw; it < T * 8; it += F.NGW) {
        const int t = it >> 3, h = it & 7, b = t >> 11, pos = t & (SEQ - 1);
        { const unsigned w = *(const unsigned*)(QB + (size_t)t * 512 + h * 64 + 2 * lane); if (lane < 32) { qf[2 * lane] = bflo(w); qf[2 * lane + 1] = bfhi(w); } }
        LDS_WAIT();
        float sc[7];
#pragma unroll
        for (int ch = 0; ch < 7; ++ch) {
            const int e = ch * 64 + lane, p = e / 129, rel = e - p * 129, dl = (p == 0) ? 1 : (p == 1) ? 4 : 16, tk = pos - dl * rel; const bool act = (e < 387) && (tk >= 0);
            const v4u* kp = (const v4u*)(KB + ((size_t)b * SEQ + (act ? tk : 0)) * 512 + h * 64);
            float d = 0.f;
#pragma unroll
            for (int i = 0; i < 8; ++i) { const v4u w = kp[i]; const f32x4 qa = *(const LAS f32x4*)(qf + 8 * i), qb = *(const LAS f32x4*)(qf + 8 * i + 4);
                d += qa[0] * bflo(w.x) + qa[1] * bfhi(w.x) + qa[2] * bflo(w.y) + qa[3] * bfhi(w.y) + qb[0] * bflo(w.z) + qb[1] * bfhi(w.z) + qb[2] * bflo(w.w) + qb[3] * bfhi(w.w); }
            sc[ch] = act ? d : -INFINITY;
        }
        float m = sc[0];
#pragma unroll
        for (int ch = 1; ch < 7; ++ch) m = fmaxf(m, sc[ch]);
        m = wave_max(m); float l = 0.f;
#pragma unroll
        for (int ch = 0; ch < 7; ++ch) { sc[ch] = exp2f(sc[ch] - m); l += sc[ch]; P[ch * 64 + lane] = sc[ch]; }
        l = wave_sum(l);
        LDS_WAIT();
        float o = 0.f;
        const bf16* vbase = VB + (size_t)b * SEQ * 512 + h * 64 + lane;
#pragma unroll
        for (int p = 0; p < 3; ++p) { const int dl = (p == 0) ? 1 : (p == 1) ? 4 : 16; int nrel = pos / dl + 1; if (nrel > 129) nrel = 129;
#pragma unroll 8
            for (int rel = 0; rel < nrel; ++rel) { const int tk = pos - dl * rel; o += P[p * 129 + rel] * __uint_as_float((unsigned)vbase[(size_t)tk * 512] << 16); } }
        HX[(size_t)t * KOUT + 1024 + h * 64 + lane] = (bf16)f2bf(o / l);
        LDS_WAIT();
    }
}
typedef short bf16x8 __attribute__((ext_vector_type(8)));
typedef float f32x16 __attribute__((ext_vector_type(16)));
typedef short v4i16_t __attribute__((ext_vector_type(4)));
typedef float f32x2_t __attribute__((ext_vector_type(2)));
typedef __bf16 bf16x2_t __attribute__((ext_vector_type(2)));
__device__ __forceinline__ unsigned cvtpk(float lo, float hi) { f32x2_t v = {lo, hi}; bf16x2_t b = __builtin_convertvector(v, bf16x2_t); return __builtin_bit_cast(unsigned, b); }
__device__ __forceinline__ int crow(int r, int hi) { return (r & 3) + 8 * (r >> 2) + 4 * hi; }
template <int NCH> __device__ __forceinline__ unsigned off_img(unsigned row, unsigned ch) { return (NCH * 128u) * (row >> 3) + 512u * (ch >> 2) + 64u * (row & 7) + 16u * ((ch & 3) ^ ((row >> 2) & 3)); }
template <int NCH> __device__ __forceinline__ unsigned rowread_addr(unsigned lane, unsigned s) { return off_img<NCH>(lane & 31, 2 * s + (lane >> 5)); }
template <int NCH> __device__ __forceinline__ unsigned trread_addr(unsigned lane, unsigned c, unsigned ks, unsigned t) {
    const unsigned h = lane >> 5, blk = (lane >> 4) & 1, q = (lane & 15) >> 2, p = lane & 3;
    return off_img<NCH>(16 * ks + 8 * t + 4 * h + q, 4 * c + 2 * blk + (p >> 1)) + 8 * (p & 1);
}
__device__ __forceinline__ bf16x8 trfrag(LAS unsigned char* p0, LAS unsigned char* p1) {
    const v4i16_t lo = __builtin_amdgcn_ds_read_tr16_b64_v4i16((LAS v4i16_t*)p0), hi = __builtin_amdgcn_ds_read_tr16_b64_v4i16((LAS v4i16_t*)p1);
    return (bf16x8){lo[0], lo[1], lo[2], lo[3], hi[0], hi[1], hi[2], hi[3]};
}
#define MFMA32(a, b, c) __builtin_amdgcn_mfma_f32_32x32x16_bf16((a), (b), (c), 0, 0, 0)
template <int NDT> __device__ __forceinline__ void softmax_tile(f32x16& S, float& m, float& l, f32x16 (&o)[NDT], bf16x8 (&pf)[2]) {
    float mt = fmaxf(fmaxf(fmaxf(S[0], S[1]), fmaxf(S[2], S[3])), fmaxf(fmaxf(S[4], S[5]), fmaxf(S[6], S[7])));
    mt = fmaxf(mt, fmaxf(fmaxf(fmaxf(S[8], S[9]), fmaxf(S[10], S[11])), fmaxf(fmaxf(S[12], S[13]), fmaxf(S[14], S[15]))));
    mt = fmaxf(mt, __shfl_xor(mt, 32));
    if (__any(mt > m)) {
        const float mn = fmaxf(m, mt), al = __builtin_amdgcn_exp2f(m - mn);
        l *= al; m = mn;
#pragma unroll
        for (int d = 0; d < NDT; ++d) o[d] = o[d] * al;
    }
    float s = 0.f;
#pragma unroll
    for (int r = 0; r < 16; ++r) { S[r] = __builtin_amdgcn_exp2f(S[r] - m); s += S[r]; }
    l += s;
    typedef unsigned u32x4_t __attribute__((ext_vector_type(4)));
    u32x4_t w0, w1;
    w0.x = cvtpk(S[0], S[1]); w0.y = cvtpk(S[2], S[3]); w0.z = cvtpk(S[4], S[5]); w0.w = cvtpk(S[6], S[7]);
    w1.x = cvtpk(S[8], S[9]); w1.y = cvtpk(S[10], S[11]); w1.z = cvtpk(S[12], S[13]); w1.w = cvtpk(S[14], S[15]);
    pf[0] = __builtin_bit_cast(bf16x8, w0); pf[1] = __builtin_bit_cast(bf16x8, w1);
}
__device__ __forceinline__ int unit_qtile(int c, int ui) { const int k = c & 7; return 16 * (ui >> 1) + ((ui & 1) ? 15 - k : k); }

__device__ __forceinline__ void p3_dilated_mfma(Frame& F) {
    const bf16 *QB = wsp<bf16>(F, WS_QB), *KB = wsp<bf16>(F, WS_KB), *VB = wsp<bf16>(F, WS_VB); bf16* HX = wsp<bf16>(F, WS_HX);
    const int lane = F.lane, q = lane & 31, hi = lane >> 5, h = F.wave;
    LAS unsigned char* kimg = F.lds + F.wave * 16384; LAS unsigned char* vimg = kimg + 4096;
    const unsigned ra0 = rowread_addr<8>(lane, 0), ra1 = rowread_addr<8>(lane, 1);
    const unsigned ta0 = trread_addr<8>(lane, 0, 0, 0), ta1 = trread_addr<8>(lane, 0, 0, 1);
    unsigned wa[4]; int grow[4];
#pragma unroll
    for (int p = 0; p < 4; ++p) { const int e = lane + 64 * p; wa[p] = off_img<8>(e >> 3, e & 7); grow[p] = (e >> 3) * 512 + (e & 7) * 8; }
    float bfar[16], bmid[16];
#pragma unroll
    for (int r = 0; r < 16; ++r) { const int d0 = q - crow(r, hi); const bool m16 = (d0 & 15) == 0, m4 = (d0 & 3) == 0; bfar[r] = m16 ? 0.f : -INFINITY; bmid[r] = m16 ? 1.f : (m4 ? 0.f : -INFINITY); }
    for (int c = blockIdx.x; c < 256; c += gridDim.x) {
        const int b = c >> 3;
        for (int ui = 0; ui < 8; ++ui) {
            const int j = unit_qtile(c, ui); const size_t tok0 = (size_t)b * SEQ + 32 * j;
            bf16x8 qf[4];
#pragma unroll
            for (int ks = 0; ks < 4; ++ks) qf[ks] = *(const bf16x8*)(QB + (tok0 + q) * 512 + h * 64 + 16 * ks + 8 * hi);
            f32x16 o[2]; o[0] = (f32x16){}; o[1] = (f32x16){};
            float m = -1e30f, l = 0.f;
            const bf16* kb = KB + (size_t)b * SEQ * 512 + h * 64; const bf16* vb = VB + (size_t)b * SEQ * 512 + h * 64;
            v4u kr[4], vr[4];
#pragma unroll
            for (int p = 0; p < 4; ++p) { kr[p] = *(const v4u*)(kb + grow[p]); vr[p] = *(const v4u*)(vb + grow[p]); }
            for (int i = 0; i <= j; ++i) {
#pragma unroll
                for (int p = 0; p < 4; ++p) { *(LAS v4u*)(kimg + wa[p]) = kr[p]; *(LAS v4u*)(vimg + wa[p]) = vr[p]; }
                if (i < j) {
#pragma unroll
                    for (int p = 0; p < 4; ++p) { kr[p] = *(const v4u*)(kb + (size_t)(i + 1) * 32 * 512 + grow[p]); vr[p] = *(const v4u*)(vb + (size_t)(i + 1) * 32 * 512 + grow[p]); }
                }
                f32x16 S = (f32x16){};
#pragma unroll
                for (int ks = 0; ks < 4; ++ks) { const bf16x8 kf = *(const LAS bf16x8*)(kimg + ((ks & 1) ? ra1 : ra0) + 512 * (ks >> 1)); S = MFMA32(kf, qf[ks], S); }
                const int dlt = 32 * (j - i);
                if (dlt > 512) {
#pragma unroll
                    for (int r = 0; r < 16; ++r) S[r] += bfar[r];
                } else if (dlt >= 192 && dlt < 512) {
#pragma unroll
                    for (int r = 0; r < 16; ++r) S[r] += bmid[r];
                } else {
#pragma unroll
                    for (int r = 0; r < 16; ++r) { const int df = dlt + q - crow(r, hi);
                        int w = (df <= 128 ? 1 : 0) + ((((df & 3) == 0) && df <= 512) ? 1 : 0) + (((df & 15) == 0) ? 1 : 0); if (df < 0) w = 0;
                        S[r] += (w == 0) ? -INFINITY : (w == 1) ? 0.f : (w == 2) ? 1.f : 1.5849625007211562f; }
                }
                bf16x8 pf[2];
                softmax_tile<2>(S, m, l, o, pf);
#pragma unroll
                for (int dt = 0; dt < 2; ++dt)
#pragma unroll
                    for (int ks = 0; ks < 2; ++ks) { const bf16x8 vf = trfrag(vimg + ta0 + 2048 * ks + 512 * dt, vimg + ta1 + 2048 * ks + 512 * dt); o[dt] = MFMA32(vf, pf[ks], o[dt]); }
            }
            l += __shfl_xor(l, 32); const float il = 1.0f / l;
            bf16* orow = HX + (tok0 + q) * KOUT + 1024 + h * 64 + 4 * hi;
#pragma unroll
            for (int dt = 0; dt < 2; ++dt)
#pragma unroll
                for (int g = 0; g < 4; ++g) { v2u w; w.x = cvtpk(o[dt][4 * g] * il, o[dt][4 * g + 1] * il); w.y = cvtpk(o[dt][4 * g + 2] * il, o[dt][4 * g + 3] * il); *(v2u*)(orow + 32 * dt + 8 * g) = w; }
        }
    }
}

__device__ __forceinline__ void p3_dsa_mfma(Frame& F) {
    const bf16 *QL = wsp<bf16>(F, WS_QL), *QR = wsp<bf16>(F, WS_QR), *CKV = wsp<bf16>(F, WS_CKV), *KR = wsp<bf16>(F, WS_KR); const unsigned* MASK = wsp<unsigned>(F, WS_MASK); bf16* HX = wsp<bf16>(F, WS_HX);
    const int lane = F.lane, q = lane & 31, hi = lane >> 5, h = F.wave;
    LAS unsigned char* cimg = F.lds + F.wave * 16384; LAS unsigned char* rimg = cimg + 8192;
    const unsigned ra0 = rowread_addr<16>(lane, 0), ra1 = rowread_addr<16>(lane, 1);
    const unsigned ta0 = trread_addr<16>(lane, 0, 0, 0), ta1 = trread_addr<16>(lane, 0, 0, 1);
    const unsigned rra = hi * 528 + q * 16;
    unsigned wc[8], wr[2];
#pragma unroll
    for (int p = 0; p < 8; ++p) { const int e = lane + 64 * p; wc[p] = off_img<16>(e >> 4, e & 15); }
#pragma unroll
    for (int p = 0; p < 2; ++p) { const int e = lane + 64 * p; wr[p] = (e & 3) * 528 + (e >> 2) * 16; }
    for (int c = blockIdx.x; c < 256; c += gridDim.x) {
        const int b = c >> 3;
        for (int ui = 0; ui < 8; ++ui) {
            const int j = unit_qtile(c, ui); const size_t tok0 = (size_t)b * SEQ + 32 * j;
            bf16x8 qf[10];
#pragma unroll
            for (int ks = 0; ks < 8; ++ks) qf[ks] = *(const bf16x8*)(QL + (tok0 + q) * 1024 + h * 128 + 16 * ks + 8 * hi);
#pragma unroll
            for (int ks = 0; ks < 2; ++ks) qf[8 + ks] = *(const bf16x8*)(QR + (tok0 + q) * 256 + h * 32 + 16 * ks + 8 * hi);
            f32x16 o[4];
#pragma unroll
            for (int d = 0; d < 4; ++d) o[d] = (f32x16){};
            float m = -1e30f, l = 0.f;
            const bf16* cb = CKV + (size_t)b * SEQ * 128 + 8 * lane; const bf16* rb = KR + (size_t)b * SEQ * 32 + 8 * lane; const unsigned* mrow = MASK + (tok0 + q) * 64;
            v4u cr[8], rr[2]; unsigned mw = mrow[0];
#pragma unroll
            for (int p = 0; p < 8; ++p) cr[p] = *(const v4u*)(cb + 512 * p);
#pragma unroll
            for (int p = 0; p < 2; ++p) rr[p] = *(const v4u*)(rb + 512 * p);
            for (int i = 0; i <= j; ++i) {
#pragma unroll
                for (int p = 0; p < 8; ++p) *(LAS v4u*)(cimg + wc[p]) = cr[p];
#pragma unroll
                for (int p = 0; p < 2; ++p) *(LAS v4u*)(rimg + wr[p]) = rr[p];
                const unsigned mcur = mw >> (4 * hi);
                if (i < j) {
#pragma unroll
                    for (int p = 0; p < 8; ++p) cr[p] = *(const v4u*)(cb + (size_t)(i + 1) * 32 * 128 + 512 * p);
#pragma unroll
                    for (int p = 0; p < 2; ++p) rr[p] = *(const v4u*)(rb + (size_t)(i + 1) * 32 * 32 + 512 * p);
                    mw = mrow[i + 1];
                }
                f32x16 S = (f32x16){};
#pragma unroll
                for (int ks = 0; ks < 8; ++ks) { const bf16x8 kf = *(const LAS bf16x8*)(cimg + ((ks & 1) ? ra1 : ra0) + 512 * (ks >> 1)); S = MFMA32(kf, qf[ks], S); }
#pragma unroll
                for (int ks = 0; ks < 2; ++ks) { const bf16x8 kf = *(const LAS bf16x8*)(rimg + rra + 1056 * ks); S = MFMA32(kf, qf[8 + ks], S); }
#pragma unroll
                for (int r = 0; r < 16; ++r) S[r] = ((mcur >> ((r & 3) + 8 * (r >> 2))) & 1u) ? S[r] : -INFINITY;
                bf16x8 pf[2];
                softmax_tile<4>(S, m, l, o, pf);
#pragma unroll
                for (int dt = 0; dt < 4; ++dt)
#pragma unroll
                    for (int ks = 0; ks < 2; ++ks) { const bf16x8 vf = trfrag(cimg + ta0 + 4096 * ks + 512 * dt, cimg + ta1 + 4096 * ks + 512 * dt); o[dt] = MFMA32(vf, pf[ks], o[dt]); }
            }
            l += __shfl_xor(l, 32); const float il = 1.0f / l;
            bf16* orow = HX + (tok0 + q) * KOUT + h * 128 + 4 * hi;
#pragma unroll
            for (int dt = 0; dt < 4; ++dt)
#pragma unroll
                for (int g = 0; g < 4; ++g) { v2u w; w.x = cvtpk(o[dt][4 * g] * il, o[dt][4 * g + 1] * il); w.y = cvtpk(o[dt][4 * g + 2] * il, o[dt][4 * g + 3] * il); *(v2u*)(orow + 32 * dt + 8 * g) = w; }
        }
    }
}

__device__ __forceinline__ void p2_index_mfma(Frame& F) {
    const bf16 *QI = wsp<bf16>(F, WS_QI), *KI = wsp<bf16>(F, WS_KI); const float* WI = wsp<float>(F, WS_WI); unsigned* MASK = wsp<unsigned>(F, WS_MASK);
    unsigned* SC = wsp<unsigned>(F, WS_XB) + (size_t)blockIdx.x * (32 * 2048);
    const int lane = F.lane, q = lane & 31, hi = lane >> 5, w = F.wave;
    LAS unsigned char* kimg = F.lds + F.wave * 16384;
    LAS unsigned long long* lm = (LAS unsigned long long*)(kimg + 8192);
    const unsigned rra = hi * 528 + q * 16;
    unsigned wa[4];
#pragma unroll
    for (int p = 0; p < 4; ++p) { const int e = lane + 64 * p; wa[p] = (e & 7) * 528 + (e >> 3) * 16; }
    for (int c = blockIdx.x; c < 256; c += gridDim.x) {
        const int b = c >> 3;
        for (int ui = 0; ui < 8; ++ui) {
            const int j = unit_qtile(c, ui); const size_t tok0 = (size_t)b * SEQ + 32 * j; const int qpos = 32 * j + q;
            if (w <= j) {
                const f32x4 wva = *(const f32x4*)(WI + (tok0 + q) * 8), wvb = *(const f32x4*)(WI + (tok0 + q) * 8 + 4);
                const float wq[8] = {wva[0], wva[1], wva[2], wva[3], wvb[0], wvb[1], wvb[2], wvb[3]};
                const bf16* kb = KI + (size_t)b * SEQ * 64 + 8 * lane;
#pragma unroll
                for (int hp = 0; hp < 2; ++hp) {
                    bf16x8 qf[4][4];
#pragma unroll
                    for (int hh = 0; hh < 4; ++hh)
#pragma unroll
                        for (int ks = 0; ks < 4; ++ks) qf[hh][ks] = *(const bf16x8*)(QI + (tok0 + q) * 512 + (4 * hp + hh) * 64 + 16 * ks + 8 * hi);
                    v4u kr[4];
#pragma unroll
                    for (int p = 0; p < 4; ++p) kr[p] = *(const v4u*)(kb + (size_t)w * 32 * 64 + 512 * p);
                    for (int i = w; i <= j; i += 8) {
#pragma unroll
                        for (int p = 0; p < 4; ++p) *(LAS v4u*)(kimg + wa[p]) = kr[p];
                        if (i + 8 <= j) {
#pragma unroll
                            for (int p = 0; p < 4; ++p) kr[p] = *(const v4u*)(kb + (size_t)(i + 8) * 32 * 64 + 512 * p);
                        }
                        unsigned* srow = SC + (size_t)q * 2048 + 32 * i + 4 * hi;
                        f32x16 idx = (f32x16){};
                        if (hp == 1) {
#pragma unroll
                            for (int g = 0; g < 4; ++g) { const f32x4 pv = *(const f32x4*)(srow + 8 * g); idx[4 * g] = pv[0]; idx[4 * g + 1] = pv[1]; idx[4 * g + 2] = pv[2]; idx[4 * g + 3] = pv[3]; }
                        }
#pragma unroll
                        for (int hh = 0; hh < 4; ++hh) {
                            f32x16 S = (f32x16){};
#pragma unroll
                            for (int ks = 0; ks < 4; ++ks) { const bf16x8 kf = *(const LAS bf16x8*)(kimg + rra + 1056 * ks); S = MFMA32(kf, qf[hh][ks], S); }
#pragma unroll
                            for (int r = 0; r < 16; ++r) idx[r] = fmaf(fmaxf(S[r], 0.f), wq[4 * hp + hh], idx[r]);
                            __builtin_amdgcn_sched_barrier(0);
                        }
                        if (hp == 0) {
#pragma unroll
                            for (int g = 0; g < 4; ++g) *(f32x4*)(srow + 8 * g) = (f32x4){idx[4 * g], idx[4 * g + 1], idx[4 * g + 2], idx[4 * g + 3]};
                        } else {
#pragma unroll
                            for (int g = 0; g < 4; ++g) { v4u kv;
#pragma unroll
                                for (int e = 0; e < 4; ++e) { const int s = 32 * i + 8 * g + 4 * hi + e; unsigned ord = __float_as_uint(idx[4 * g + e]); ord ^= (ord >> 31) ? 0xFFFFFFFFu : 0x80000000u;
                                    kv[e] = (s <= qpos) ? ((ord & 0xFFFFF800u) | (unsigned)(SEQ - 1 - s)) : 0u; }
                                *(v4u*)(srow + 8 * g) = kv; }
                        }
                    }
                }
            }
            __syncthreads();
#pragma unroll 1
            for (int n = 0; n < 4; ++n) {
                const int qq = 4 * w + n, qp = 32 * j + qq, nr = (qp >> 6) + 1; const size_t t = tok0 + qq;
                unsigned key[32];
#pragma unroll
                for (int r = 0; r < 32; ++r) { key[r] = 0u; if (r < nr) { const unsigned v = SC[(size_t)qq * 2048 + r * 64 + lane]; key[r] = (r * 64 + lane <= qp) ? v : 0u; } }
                unsigned thr = 1u;
                if (qp >= 256) {
                    unsigned lo = 0u;
#pragma unroll 1
                    for (int bit = 31; bit >= 0; --bit) {
                        const unsigned cand = lo | (1u << bit); int cnt = 0;
#pragma unroll
                        for (int r = 0; r < 32; ++r) { cnt += __popcll(__ballot(key[r] >= cand)); if ((r & 3) == 3) __builtin_amdgcn_sched_barrier(0); }
                        if (cnt >= 256) lo = cand;
                        if (cnt == 256) break;
                    }
                    thr = lo;
                }
#pragma unroll
                for (int r = 0; r < 32; ++r) { const unsigned long long bm = __ballot(key[r] >= thr && key[r] != 0u); if (lane == 0) lm[r] = bm; if ((r & 3) == 3) __builtin_amdgcn_sched_barrier(0); }
                LDS_WAIT();
                const unsigned long long mine = lm[lane & 31];
                if (lane < 32) *(unsigned long long*)(MASK + t * 64 + 2 * lane) = mine;
                LDS_WAIT();
            }
            __syncthreads();
        }
    }
}

__device__ __forceinline__ void p6_cross_naive(Frame& F) {
    const bf16 *QC = wsp<bf16>(F, WS_QC), *KVC = wsp<bf16>(F, WS_KVC); bf16* OC = wsp<bf16>(F, WS_OC);
    LAS float* qf = (LAS float*)(F.lds + F.wave * 16384);
    LAS float* P = (LAS float*)(F.lds + F.wave * 16384 + 1024);
    const int lane = F.lane;
    for (int it = F.gw; it < T * 4; it += F.NGW) {
        const int t = it >> 2, h = it & 3, b = t >> 11;
        { const v2u w = *(const v2u*)(QC + (size_t)t * 1024 + h * 256 + 4 * lane); *(LAS f32x4*)(qf + 4 * lane) = (f32x4){bflo(w.x), bfhi(w.x), bflo(w.y), bfhi(w.y)}; }
        LDS_WAIT();
        float sc[4];
#pragma unroll
        for (int ch = 0; ch < 4; ++ch) {
            const v4u* kp = (const v4u*)(KVC + ((size_t)b * MEMT + ch * 64 + lane) * 2048 + h * 256);
            float d = 0.f;
#pragma unroll 8
            for (int i = 0; i < 32; ++i) { const v4u w = kp[i]; const f32x4 qa = *(const LAS f32x4*)(qf + 8 * i), qb = *(const LAS f32x4*)(qf + 8 * i + 4);
                d += qa[0] * bflo(w.x) + qa[1] * bfhi(w.x) + qa[2] * bflo(w.y) + qa[3] * bfhi(w.y) + qb[0] * bflo(w.z) + qb[1] * bfhi(w.z) + qb[2] * bflo(w.w) + qb[3] * bfhi(w.w); }
            sc[ch] = d;
        }
        float m = wave_max(fmaxf(fmaxf(sc[0], sc[1]), fmaxf(sc[2], sc[3]))); float l = 0.f;
#pragma unroll
        for (int ch = 0; ch < 4; ++ch) { sc[ch] = exp2f(sc[ch] - m); l += sc[ch]; P[ch * 64 + lane] = sc[ch]; }
        l = wave_sum(l); const float il = 1.0f / l;
        LDS_WAIT();
        float o0 = 0.f, o1 = 0.f, o2 = 0.f, o3 = 0.f;
        const bf16* vb = KVC + (size_t)b * MEMT * 2048 + 1024 + h * 256 + 4 * lane;
#pragma unroll 8
        for (int j = 0; j < MEMT; ++j) { const v2u w = *(const v2u*)(vb + (size_t)j * 2048); const float p = P[j]; o0 += p * bflo(w.x); o1 += p * bfhi(w.x); o2 += p * bflo(w.y); o3 += p * bfhi(w.y); }
        v2u ow; ow.x = pk2(o0 * il, o1 * il); ow.y = pk2(o2 * il, o3 * il);
        *(v2u*)(OC + (size_t)t * 1024 + h * 256 + 4 * lane) = ow;
        LDS_WAIT();
    }
}
__device__ __forceinline__ void p10_final(Frame& F) {
    const float* parts = wsp<float>(F, WS_P3); const float* g = inp(F, 16);
    f32x4 gv[4];
#pragma unroll
    for (int j = 0; j < 4; ++j) gv[j] = *((const f32x4*)g + F.lane + 64 * j);
    for (int r = F.gw; r < T; r += F.NGW) {
        const float rs = rstd_from_parts(parts, r);
        f32x4* o = (f32x4*)(outp(F) + (size_t)r * DM) + F.lane;
#pragma unroll
        for (int j = 0; j < 4; ++j) o[64 * j] = o[64 * j] * rs * gv[j];
    }
}

#define RLX_AGENT __ATOMIC_RELAXED, __HIP_MEMORY_SCOPE_AGENT
#define XB_TMO      128
#define XB_XCNT(j)  (256  + 64 * (j))
#define XB_XSUB(j)  (1280 + 64 * (j))
#define XB_XGEN(j)  (2304 + 64 * (j))
#define XB_TOP      3328
#define XB_TOPGEN   3392
#define XCD_BAR_WORDS 3456
#define XB_SPIN_CAP (1u << 18)

__device__ __forceinline__ unsigned xb_ld(unsigned* p)              { return __hip_atomic_load(p, __ATOMIC_RELAXED, __HIP_MEMORY_SCOPE_AGENT); }
__device__ __forceinline__ unsigned xb_add(unsigned* p, unsigned v) { return __hip_atomic_fetch_add(p, v, __ATOMIC_RELAXED, __HIP_MEMORY_SCOPE_AGENT); }
__device__ __forceinline__ unsigned xb_xcc_id() { return (unsigned)__builtin_amdgcn_s_getreg((3 << 11) | 20) & 0xFu; }
#define XB_SPIN(cond, bar) do { unsigned _sp = 0; while (cond) { __builtin_amdgcn_s_sleep(1); \
    if ((++_sp & 255u) == 0u) { if (xb_ld(&(bar)[XB_TMO])) break; if (_sp > XB_SPIN_CAP) { atomicAdd(&(bar)[XB_TMO], 1u); break; } } } } while (0)

struct XcdBarrier {
    unsigned* bar; unsigned x;
    volatile LAS unsigned* st;
};

__device__ __forceinline__ XcdBarrier xcd_barrier_post(unsigned* bar, volatile LAS unsigned* st) {
    XcdBarrier b; b.bar = bar; b.x = xb_xcc_id(); b.st = st;
    if (threadIdx.x == 0) (void)xb_add(&bar[XB_XCNT(b.x)], 1u);
    return b;
}
__device__ __forceinline__ void xcd_barrier_complete(unsigned* bar, unsigned x, unsigned& nloc, unsigned& nx) {
    const unsigned G = gridDim.x * gridDim.y * gridDim.z;
    unsigned sum, cnt, mine, sp = 0u;
    for (;;) {
        sum = 0u; cnt = 0u; mine = 0u;
#pragma unroll
        for (unsigned j = 0; j < 16; ++j) { const unsigned c = xb_ld(&bar[XB_XCNT(j)]); sum += c; cnt += (c > 0u) ? 1u : 0u; mine = (j == x) ? c : mine; }
        if (sum == G) break;
        __builtin_amdgcn_s_sleep(1);
        if ((++sp & 255u) == 0u) { if (xb_ld(&bar[XB_TMO])) break; if (sp > XB_SPIN_CAP) { atomicAdd(&bar[XB_TMO], 1u); break; } }
    }
    nloc = mine > 0u ? mine : 1u; nx = cnt > 0u ? cnt : 1u;
}

__device__ __forceinline__ void xcd_barrier(const XcdBarrier& b, const bool t0) {
    asm volatile("s_waitcnt vmcnt(0)" ::: "memory");
    __syncthreads();
    if (t0) {
        unsigned* bar = b.bar;
        __builtin_amdgcn_s_waitcnt(0);
        unsigned nloc = b.st[0], nx = b.st[1];
        if (nloc == 0u) { xcd_barrier_complete(bar, b.x, nloc, nx); b.st[0] = nloc; b.st[1] = nx; }
        const unsigned old = xb_add(&bar[XB_XSUB(b.x)], 1u);
        const unsigned gen = old / nloc;
        if (old + 1u == (gen + 1u) * nloc) {
            __builtin_amdgcn_fence(__ATOMIC_RELEASE, "agent");
            asm volatile("s_waitcnt vmcnt(0)" ::: "memory");
            const unsigned og = xb_add(&bar[XB_TOP], 1u);
            const unsigned tg = og / nx;
            if (og + 1u == (tg + 1u) * nx) xb_add(&bar[XB_TOPGEN], 1u);
            else XB_SPIN(xb_ld(&bar[XB_TOPGEN]) == tg, bar);
            __builtin_amdgcn_fence(__ATOMIC_ACQUIRE, "agent");
            xb_add(&bar[XB_XGEN(b.x)], 1u);
            asm volatile("s_waitcnt vmcnt(0)" ::: "memory");
        } else {
            XB_SPIN(xb_ld(&bar[XB_XGEN(b.x)]) == gen, bar);
            __builtin_amdgcn_fence(__ATOMIC_ACQUIRE, "agent");
            asm volatile("s_waitcnt vmcnt(0)" ::: "memory");
        }
    }
    __syncthreads();
}

struct Args { const float* in[17]; float* out; unsigned char* ws; int ph_lo, ph_hi; };
__global__ void __launch_bounds__(NWAVES * 64, 2) fwd_kernel(Args args) {
    extern __shared__ __attribute__((aligned(16))) unsigned char lds[];
    cg::grid_group grid = cg::this_grid();
    Frame F;
    F.lds = (LAS unsigned char*)lds;
    F.kargs = (const __attribute__((address_space(4))) char*)__builtin_amdgcn_kernarg_segment_ptr();
    F.out = args.out; F.ws = args.ws; F.wave_s = __builtin_amdgcn_readfirstlane((int)threadIdx.x >> 6); phase_ctx(F);
    volatile LAS unsigned* MISC = (volatile LAS unsigned*)(F.lds + 131072 + 64);
    if (threadIdx.x < 16) MISC[threadIdx.x] = 0u;
    __syncthreads();
    XcdBarrier bar = xcd_barrier_post((unsigned*)(args.ws + WS_CTL) + 1024, MISC + 8);
    const int lo = args.ph_lo, hi = args.ph_hi;
#ifndef PH_MASK
#define PH_MASK 0x7ff
#endif
#define IN(k) (((PH_MASK >> (k)) & 1) && lo <= (k) && (k) < hi)
#define SEAM(k) do { if (IN(k) && IN((k) + 1)) { if ((k) == 0) grid.sync(); else { phase_ctx(F); xcd_barrier(bar, F.tid == 0); } } phase_ctx(F); } while (0)
    LAS unsigned char* ring = (LAS unsigned char*)lds;

    if (IN(0)) { p0_prologue(F); }
    SEAM(0);
    if (IN(1)) {
        { pg8::Gemm g{wsp<bf16>(F, WS_XB), wsp<bf16>(F, WS_WIN), T, NIN, DM, DM, DM}; pg8::StaticOrder S; S.init(g, F.G, (int)blockIdx.x);
          EpiInProj E{wsp<float>(F, WS_RSTD1), wsp<float>(F, WS_TAB64), wsp<float>(F, WS_TAB32), wsp<bf16>(F, WS_QL), wsp<bf16>(F, WS_QR), wsp<bf16>(F, WS_KR), wsp<bf16>(F, WS_KI), wsp<bf16>(F, WS_QI), wsp<bf16>(F, WS_QB), wsp<bf16>(F, WS_KB), wsp<bf16>(F, WS_VB), wsp<float>(F, WS_CKVF), wsp<float>(F, WS_WI)};
          pg8::gemm_phase<EpiInProj, pg8::StaticOrder, true, true>(ring, g, S, E, F.wave); }
        { pg8::Gemm g{wsp<bf16>(F, WS_MEMB), wsp<bf16>(F, WS_WKV), TM, 2048, DM, DM, DM};
          KvOrder S{F.G, (int)blockIdx.x, (const char*)wsp<bf16>(F, WS_MEMB), (const char*)wsp<bf16>(F, WS_WKV)};
          EpiKv E{wsp<bf16>(F, WS_KVC), wsp<bf16>(F, WS_KVC) + (size_t)TM * DM, wsp<float>(F, WS_RSTDM)};
          pg8::gemm_phase<EpiKv, KvOrder, true, true>(ring, g, S, E, F.wave); }
    }
    SEAM(1);
    if (IN(2)) { p2_ckv_norm(F); p2_index_mfma(F); }
    SEAM(2);
    if (IN(3)) { p3_dsa_mfma(F); p3_dilated_mfma(F); }
    SEAM(3);
    if (IN(4)) {
        pg8::Gemm g{wsp<bf16>(F, WS_HX), wsp<bf16>(F, WS_WOUT), T, DM, KOUT, KOUT, KOUT}; pg8::StaticOrder S; S.init(g, F.G, (int)blockIdx.x);
        EpiResid E{inp(F, 0), outp(F), wsp<bf16>(F, WS_XB), wsp<float>(F, WS_P1)};
        pg8::gemm_phase<EpiResid, pg8::StaticOrder, true, true>(ring, g, S, E, F.wave);
    }
    SEAM(4);
    if (IN(5)) {
        pg8::Gemm g{wsp<bf16>(F, WS_XB), wsp<bf16>(F, WS_WQ), T, DM, DM, DM, DM}; pg8::StaticOrder S; S.init(g, F.G, (int)blockIdx.x);
        EpiRowScale<0> E{wsp<bf16>(F, WS_QC), DM, nullptr, wsp<float>(F, WS_P1), SCALE_C};
        pg8::gemm_phase<EpiRowScale<0>, pg8::StaticOrder, true, true>(ring, g, S, E, F.wave);
    }
    SEAM(5);
    if (IN(6)) {
        { pg8::Gemm g{wsp<bf16>(F, WS_QC), wsp<bf16>(F, WS_KVC), T, 256, 256, DM, DM};
          CrossOrder S{F.G, (int)blockIdx.x, (const char*)wsp<bf16>(F, WS_QC), (const char*)wsp<bf16>(F, WS_KVC), (size_t)MEMT * DM * 2, (size_t)256 * 2};
          EpiSoftmaxP E{wsp<bf16>(F, WS_QC), (LAS float*)(F.lds + 131072 + 1024)};
          pg8::gemm_phase<EpiSoftmaxP, CrossOrder, true, true>(ring, g, S, E, F.wave); }
        phase_ctx(F); xcd_barrier(bar, F.tid == 0); phase_ctx(F);
        { pg8::Gemm g{wsp<bf16>(F, WS_QC), wsp<bf16>(F, WS_KVC) + (size_t)TM * DM, T, 256, 256, DM, TM};
          CrossOrder S{F.G, (int)blockIdx.x, (const char*)wsp<bf16>(F, WS_QC), (const char*)(wsp<bf16>(F, WS_KVC) + (size_t)TM * DM), (size_t)MEMT * 2, (size_t)256 * TM * 2};
          EpiRowScale<2> E{wsp<bf16>(F, WS_OC), DM, nullptr, nullptr, 1.0f};
          pg8::gemm_phase<EpiRowScale<2>, CrossOrder, true, true>(ring, g, S, E, F.wave); }
    }
    SEAM(6);
    if (IN(7)) {
        pg8::Gemm g{wsp<bf16>(F, WS_OC), wsp<bf16>(F, WS_WO), T, DM, DM, DM, DM}; pg8::StaticOrder S; S.init(g, F.G, (int)blockIdx.x);
        EpiResid E{outp(F), outp(F), wsp<bf16>(F, WS_XB), wsp<float>(F, WS_P2)};
        pg8::gemm_phase<EpiResid, pg8::StaticOrder, true, true>(ring, g, S, E, F.wave);
    }
    SEAM(7);
    if (IN(8)) {
        pg8::Gemm g{wsp<bf16>(F, WS_XB), wsp<bf16>(F, WS_WUP), T, FF, DM, DM, DM}; pg8::StaticOrder S; S.init(g, F.G, (int)blockIdx.x);
        EpiRowScale<1> E{wsp<bf16>(F, WS_HID), FF, nullptr, wsp<float>(F, WS_P2), 1.0f};
        pg8::gemm_phase<EpiRowScale<1>, pg8::StaticOrder, true, true>(ring, g, S, E, F.wave);
    }
    SEAM(8);
    if (IN(9)) {
        pg8::Gemm g{wsp<bf16>(F, WS_HID), wsp<bf16>(F, WS_WDN), T, DM, FF, FF, FF}; pg8::StaticOrder S; S.init(g, F.G, (int)blockIdx.x);
        EpiResid E{outp(F), outp(F), nullptr, wsp<float>(F, WS_P3)};
        pg8::gemm_phase<EpiResid, pg8::StaticOrder, true, true>(ring, g, S, E, F.wave);
    }
    SEAM(9);
    if (IN(10)) { p10_final(F); }
#undef IN
#undef SEAM
}

#ifndef N_LAUNCH_SPLIT
#define N_LAUNCH_SPLIT 0
#endif
extern "C" void kernel_launch(void* const* d_in, const int* in_sizes, int n_in, void* d_out, int out_size, void* d_ws, size_t ws_size, hipStream_t stream) {
    static int grid = 0;
    if (grid == 0) {
        if (n_in != 17 || out_size != T * DM || ws_size < WS_END) { fprintf(stderr, "kernel_launch: unexpected shapes: n_in %d out %d ws %zu\n", n_in, out_size, ws_size); grid = -1; return; }
        int dev = 0, cus = 0, per_cu = 0;
        if (hipGetDevice(&dev) != hipSuccess || hipDeviceGetAttribute(&cus, hipDeviceAttributeMultiprocessorCount, dev) != hipSuccess) { grid = -1; return; }
        if (hipFuncSetAttribute((const void*)fwd_kernel, hipFuncAttributeMaxDynamicSharedMemorySize, LDS_BYTES) != hipSuccess) { fprintf(stderr, "hipFuncSetAttribute failed\n"); grid = -1; return; }
        if (hipOccupancyMaxActiveBlocksPerMultiprocessor(&per_cu, (const void*)fwd_kernel, NWAVES * 64, LDS_BYTES) != hipSuccess || per_cu < 1) { fprintf(stderr, "occupancy query: %d\n", per_cu); per_cu = 1; }
        (void)hipGetLastError();
        grid = cus;
        fprintf(stderr, "kernel_launch: cus %d per_cu %d grid %d ws %zu\n", cus, per_cu, grid, ws_size);
    }
    if (grid < 0) return;
    if (hipMemsetAsync((char*)d_ws + WS_CTL, 0, 65536, stream) != hipSuccess) { fprintf(stderr, "memset failed\n"); return; }
    Args a{};
    for (int i = 0; i < 17; ++i) a.in[i] = (const float*)d_in[i];
    a.out = (float*)d_out; a.ws = (unsigned char*)d_ws;
#if N_LAUNCH_SPLIT
    for (int p = 0; p < 11; ++p) { a.ph_lo = p; a.ph_hi = p + 1; void* kargs[] = {&a};
        hipError_t e = hipLaunchCooperativeKernel((const void*)fwd_kernel, dim3(grid), dim3(NWAVES * 64), kargs, LDS_BYTES, stream);
        if (e != hipSuccess) { fprintf(stderr, "launch %d failed: %s\n", p, hipGetErrorString(e)); break; } }
#else
    a.ph_lo = 0; a.ph_hi = 11; void* kargs[] = {&a};
    hipError_t e = hipLaunchCooperativeKernel((const void*)fwd_kernel, dim3(grid), dim3(NWAVES * 64), kargs, LDS_BYTES, stream);
    if (e != hipSuccess) fprintf(stderr, "cooperative launch failed: %s (grid %d)\n", hipGetErrorString(e), grid);
#endif
}
```

```cpp
#include <hip/hip_runtime.h>
#include <hip/hip_cooperative_groups.h>
#include <cstdio>
#include <cstdint>
namespace cg = cooperative_groups;
namespace pg8 {
#define PG8_LAS __attribute__((address_space(3)))
typedef unsigned short bf16_t;
typedef short bf16x8 __attribute__((ext_vector_type(8)));
typedef float f32x4 __attribute__((ext_vector_type(4)));
typedef unsigned u32x4 __attribute__((ext_vector_type(4)));
constexpr int BM = 256, BK = 64, HALF = 128, HTB = HALF * BK * 2  , STAGE_BYTES = 8 * HTB, NXCD = 8, WGM = 8;

__host__ __device__ __forceinline__ int lds_byte(int r, int c) { const int st = (r >> 4) * 2 + (c >> 5), rr = r & 15, cc = c & 31, ob = rr * 64 + cc * 2; return st * 1024 + (ob ^ (((ob >> 9) & 1) << 5)); }
__host__ __device__ __forceinline__ void stage_rc(int b, int& R, int& C) { const int st = b / 1024, sb = b % 1024, swz = sb ^ (((sb >> 9) & 1) << 5); R = (st >> 1) * 16 + swz / 64; C = (st & 1) * 32 + (swz % 64) / 2; }
__host__ __device__ __forceinline__ int perm32(int rho) { const int n = rho >> 4, i = rho & 15; return 8 * (i >> 2) + 4 * n + (i & 3); }

struct Unit { int pm, pn; const char* pa; const char* pb; };
struct Gemm { const bf16_t* A; const bf16_t* Bt; int M, N, K, lda, ldb; };

struct StaticOrder {
    int nM, nN, nwg, G, c; const char* A; const char* B; size_t ta, tb;
    __host__ __device__ void init(const Gemm& g, int G_, int c_) { nM = g.M / BM; nN = g.N / BM; nwg = nM * nN; G = G_; c = c_; A = (const char*)g.A; B = (const char*)g.Bt; ta = (size_t)BM * g.lda * 2; tb = (size_t)BM * g.ldb * 2; }
    __host__ __device__ bool next(int i, Unit& u) const {
        const long L = (long)i * G + c; if (L >= nwg) return false;
        int wgid = (int)L; { const int q = nwg / NXCD, r = nwg % NXCD, xcd = wgid % NXCD, off = wgid / NXCD; wgid = (xcd < r ? xcd * (q + 1) : r * (q + 1) + (xcd - r) * q) + off; }
        const int nig = WGM * nN, gid = wgid / nig, fm = gid * WGM, gsz = (nM - fm) < WGM ? (nM - fm) : WGM;
        u.pm = fm + ((wgid % nig) % gsz); u.pn = (wgid % nig) / gsz; u.pa = A + (size_t)u.pm * ta; u.pb = B + (size_t)u.pn * tb; return true;
    }
    __device__ __forceinline__ void a_ready(const Unit&) const {}
    __device__ __forceinline__ void done(const Unit&) const {}
};


template <class Epi, class Sched, bool ALIGN_EPI = false, bool SP2 = false>
__device__ __forceinline__ void gemm_phase(PG8_LAS unsigned char* lds, const Gemm g, const Sched& S, const Epi& E, int wave_id) {
    unsigned ones_ = ~0u; asm volatile("" : "+s"(ones_));
    int tid_ = wave_id * 64 + (int)__builtin_amdgcn_mbcnt_hi(ones_, __builtin_amdgcn_mbcnt_lo(ones_, 0u)); asm volatile("" : "+v"(tid_));
    const int tid = tid_, wid = __builtin_amdgcn_readfirstlane(tid >> 6), lane = tid & 63, wr = wid >> 2, wc = wid & 3, fr = lane & 15, fq = lane >> 4;
    const int K = g.K, nt = K / BK;
    unsigned voffA[2], voffB[2];
#pragma unroll
    for (int i = 0; i < 2; ++i) { int R, C; stage_rc(tid * 16 + i * 8192, R, C); const int Rb = Epi::PERM ? ((R & ~31) + perm32(R & 31)) : R;
        voffA[i] = (unsigned)(R * g.lda + C) * 2u; voffB[i] = (unsigned)(Rb * g.ldb + C) * 2u; }
    const size_t kstep = (size_t)(BK * 2);
    const size_t hstepA = (size_t)HALF * g.lda * 2, hstepB = (size_t)HALF * g.ldb * 2;
    const unsigned ldsw = (unsigned)wid * 1024u;
    const int aoff = lds_byte(wr * 64 + fr, fq * 8), boff = lds_byte(wc * 32 + fr, fq * 8);
#define PG8_SA(b, h) (((b) * 2 + (h)) * HTB)
#define PG8_SB(b, h) ((4 + (b) * 2 + (h)) * HTB)
#define PG8_STAGE(bufoff, gbase, voff) do { _Pragma("unroll") for (int _i = 0; _i < 2; ++_i) \
        __builtin_amdgcn_global_load_lds((const unsigned*)((const char*)(gbase) + (voff)[_i]), (PG8_LAS unsigned*)(lds + (bufoff) + ldsw + _i * 8192), 16, 0, 0); } while (0)
#define PG8_LDA(dst, b, h) do { _Pragma("unroll") for (int m = 0; m < 4; ++m) _Pragma("unroll") for (int k = 0; k < 2; ++k) dst[m][k] = *(const PG8_LAS bf16x8*)(lds + PG8_SA(b, h) + aoff + m * 2048 + k * 1024); } while (0)
#define PG8_LDB(dst, b, h) do { _Pragma("unroll") for (int n = 0; n < 2; ++n) _Pragma("unroll") for (int k = 0; k < 2; ++k) dst[n][k] = *(const PG8_LAS bf16x8*)(lds + PG8_SB(b, h) + boff + n * 2048 + k * 1024); } while (0)
#define PG8_MMA(ai, bj, At, Bt) do { __builtin_amdgcn_s_setprio(1); _Pragma("unroll") for (int m = 0; m < 4; ++m) _Pragma("unroll") for (int n = 0; n < 2; ++n) _Pragma("unroll") for (int k = 0; k < 2; ++k) \
        acc[ai][bj][m][n] = __builtin_amdgcn_mfma_f32_16x16x32_bf16(Bt[n][k], At[m][k], acc[ai][bj][m][n], 0, 0, 0); __builtin_amdgcn_s_setprio(0); } while (0)
#define PG8_WAIT_V(n) asm volatile("s_waitcnt vmcnt(" #n ")" ::: "memory")
#define PG8_WAIT_L(n) asm volatile("s_waitcnt lgkmcnt(" #n ")" ::: "memory")
#define PG8_BAR __builtin_amdgcn_s_barrier()
#define PG8_SCHED __builtin_amdgcn_sched_barrier(0)
    Unit cur, nxt; int ui = 0;
    if (!S.next(0, cur)) return;
    f32x4 acc[2][2][4][2];
#pragma unroll
    for (int a = 0; a < 2; ++a)
#pragma unroll
        for (int b = 0; b < 2; ++b)
#pragma unroll
            for (int m = 0; m < 4; ++m)
#pragma unroll
                for (int n = 0; n < 2; ++n) acc[a][b][m][n] = (f32x4){0.f, 0.f, 0.f, 0.f};
    bf16x8 At[4][2], B0[2][2], B1[2][2];
    const char* cA = cur.pa; const char* cB = cur.pb;
    S.a_ready(cur);
    if constexpr (SP2) {
        PG8_STAGE(PG8_SB(0, 0), cB, voffB); PG8_STAGE(PG8_SB(0, 1), cB + hstepB, voffB); PG8_STAGE(PG8_SA(0, 0), cA, voffA); PG8_STAGE(PG8_SA(0, 1), cA + hstepA, voffA);
        if (wr == 1) PG8_BAR;
        PG8_WAIT_V(2); PG8_BAR;
        PG8_STAGE(PG8_SB(1, 0), cB + kstep, voffB); PG8_STAGE(PG8_SA(1, 0), cA + kstep, voffA); PG8_STAGE(PG8_SB(1, 1), cB + hstepB + kstep, voffB);
        PG8_WAIT_V(6); PG8_BAR;
    } else {
        PG8_STAGE(PG8_SB(0, 0), cB, voffB); PG8_STAGE(PG8_SA(0, 0), cA, voffA); PG8_STAGE(PG8_SB(0, 1), cB + hstepB, voffB); PG8_STAGE(PG8_SA(0, 1), cA + hstepA, voffA);
        if (wr == 1) PG8_BAR;
        PG8_WAIT_V(4); PG8_BAR;
        PG8_STAGE(PG8_SB(1, 0), cB + kstep, voffB); PG8_STAGE(PG8_SA(1, 0), cA + kstep, voffA); PG8_STAGE(PG8_SB(1, 1), cB + hstepB + kstep, voffB);
        PG8_WAIT_V(6); PG8_BAR;
    }
    for (;;) {
        const bool has_next = S.next(ui + 1, nxt);
        const char* nA = has_next ? nxt.pa : cA; const char* nB = has_next ? nxt.pb : cB;
        for (int t = 0; t < nt; t += 2) {
            const bool last = (t == nt - 2);
            const char* a1 = cA + (size_t)(t + 1) * kstep;
            const char* a2 = last ? nA : cA + (size_t)(t + 2) * kstep; const char* b2 = last ? nB : cB + (size_t)(t + 2) * kstep;
            const char* a3 = a2 + kstep; const char* b3 = b2 + kstep;
            if (last && has_next) S.a_ready(nxt);
            if constexpr (SP2) {
            PG8_LDB(B0, 0, 0); PG8_LDB(B1, 0, 1); PG8_SCHED; PG8_LDA(At, 0, 0); PG8_STAGE(PG8_SA(1, 1), a1 + hstepA, voffA);
            PG8_WAIT_V(8); PG8_WAIT_L(0); PG8_BAR; PG8_MMA(0, 0, At, B0); PG8_MMA(0, 1, At, B1); PG8_BAR; PG8_SCHED;
            PG8_LDA(At, 0, 1); PG8_STAGE(PG8_SB(0, 0), b2, voffB); PG8_STAGE(PG8_SB(0, 1), b2 + hstepB, voffB); PG8_STAGE(PG8_SA(0, 0), a2, voffA);
            PG8_WAIT_V(8); PG8_WAIT_L(0); PG8_BAR; PG8_MMA(1, 0, At, B0); PG8_MMA(1, 1, At, B1); PG8_BAR; PG8_SCHED;
            PG8_LDB(B0, 1, 0); PG8_LDB(B1, 1, 1); PG8_SCHED; PG8_LDA(At, 1, 0); PG8_STAGE(PG8_SA(0, 1), a2 + hstepA, voffA);
            PG8_WAIT_V(8); PG8_WAIT_L(0); PG8_BAR; PG8_MMA(0, 0, At, B0); PG8_MMA(0, 1, At, B1); PG8_BAR; PG8_SCHED;
            PG8_LDA(At, 1, 1); PG8_STAGE(PG8_SB(1, 0), b3, voffB); PG8_STAGE(PG8_SB(1, 1), b3 + hstepB, voffB); PG8_STAGE(PG8_SA(1, 0), a3, voffA);
            PG8_WAIT_V(8); PG8_WAIT_L(0); PG8_BAR; PG8_MMA(1, 0, At, B0); PG8_MMA(1, 1, At, B1); PG8_BAR; PG8_SCHED;
            } else {
            PG8_LDB(B0, 0, 0); PG8_SCHED; PG8_LDA(At, 0, 0); PG8_STAGE(PG8_SA(1, 1), a1 + hstepA, voffA);
            PG8_WAIT_L(8); PG8_BAR; PG8_WAIT_L(0); PG8_MMA(0, 0, At, B0); PG8_BAR; PG8_SCHED;
            PG8_LDB(B1, 0, 1); PG8_STAGE(PG8_SB(0, 0), b2, voffB);
            PG8_BAR; PG8_WAIT_L(0); PG8_MMA(0, 1, At, B1); PG8_BAR;
            PG8_LDA(At, 0, 1); PG8_STAGE(PG8_SA(0, 0), a2, voffA);
            PG8_BAR; PG8_WAIT_L(0); PG8_MMA(1, 0, At, B0); PG8_BAR; PG8_SCHED;
            PG8_STAGE(PG8_SB(0, 1), b2 + hstepB, voffB);
            PG8_WAIT_V(6); PG8_BAR; PG8_MMA(1, 1, At, B1); PG8_BAR;
            PG8_LDB(B0, 1, 0); PG8_SCHED; PG8_LDA(At, 1, 0); PG8_STAGE(PG8_SA(0, 1), a2 + hstepA, voffA);
            PG8_WAIT_L(8); PG8_BAR; PG8_WAIT_L(0); PG8_MMA(0, 0, At, B0); PG8_BAR; PG8_SCHED;
            PG8_LDB(B1, 1, 1); PG8_STAGE(PG8_SB(1, 0), b3, voffB);
            PG8_BAR; PG8_WAIT_L(0); PG8_MMA(0, 1, At, B1); PG8_BAR;
            PG8_LDA(At, 1, 1); PG8_STAGE(PG8_SA(1, 0), a3, voffA);
            PG8_BAR; PG8_WAIT_L(0); PG8_MMA(1, 0, At, B0); PG8_BAR; PG8_SCHED;
            PG8_STAGE(PG8_SB(1, 1), b3 + hstepB, voffB);
            PG8_WAIT_V(6); PG8_BAR; PG8_MMA(1, 1, At, B1); PG8_BAR;
            }
        }
        if constexpr (ALIGN_EPI) { if (wr == 0) PG8_BAR; }
        if constexpr (!Epi::AFTER_DRAIN) { E(acc, cur, wr, wc, fr, fq); S.done(cur); }
        if (!has_next) break;
#pragma unroll
        for (int a = 0; a < 2; ++a)
#pragma unroll
            for (int b = 0; b < 2; ++b)
#pragma unroll
                for (int m = 0; m < 4; ++m)
#pragma unroll
                    for (int n = 0; n < 2; ++n) acc[a][b][m][n] = (f32x4){0.f, 0.f, 0.f, 0.f};
        cur = nxt; cA = nA; cB = nB; ++ui;
        if constexpr (ALIGN_EPI) { if (wr == 1) PG8_BAR; }
    }
    PG8_WAIT_V(0);
    if constexpr (!ALIGN_EPI) { if (wr == 0) PG8_BAR; }
    PG8_BAR;
    if constexpr (Epi::AFTER_DRAIN) { E.fused(acc, cur, wr, wc, fr, fq, lds, wid, lane); S.done(cur); }
#undef PG8_SA
#undef PG8_SB
#undef PG8_STAGE
#undef PG8_LDA
#undef PG8_LDB
#undef PG8_MMA
#undef PG8_WAIT_V
#undef PG8_WAIT_L
#undef PG8_BAR
#undef PG8_SCHED
}
}


#ifndef PH_MASK
#define PH_MASK 0x7ff
#endif
#ifndef DUP_MASK
#define DUP_MASK 0
#endif

constexpr int NB = 32, SEQ = 2048, DM = 1024, T = NB * SEQ, MEMT = 256, TM = NB * MEMT, FF = 4096;
constexpr int NIN = 3584;
constexpr int KOUT = 1536;
constexpr int W_IN_COLS = 3048;
constexpr float EPS = 1e-6f, LOG2E = 1.4426950408889634f;
constexpr float SCALE_A = 0.10206207261596577f * LOG2E;
constexpr float SCALE_B = 0.125f * LOG2E;
constexpr float SCALE_C = 0.0625f * LOG2E;
constexpr float IDX_W = 0.044194173824159216f;
constexpr int NWAVES = 8;

constexpr size_t MiB = 1u << 20;
constexpr size_t WS_CTL = 0, WS_TAB64 = 1 * MiB, WS_TAB32 = 1 * MiB + 512 * 1024, WS_RSTD1 = 2 * MiB, WS_RSTDM = 2 * MiB + 512 * 1024;
constexpr size_t WS_P1 = 4 * MiB, WS_P2 = 8 * MiB, WS_P3 = 12 * MiB;
constexpr size_t WS_WIN = 16 * MiB, WS_WOUT = 24 * MiB, WS_WQ = 28 * MiB, WS_WKV = 30 * MiB, WS_WO = 34 * MiB, WS_WUP = 36 * MiB, WS_WDN = 44 * MiB;
constexpr size_t WS_XB = 52 * MiB, WS_MEMB = 180 * MiB, WS_KVC = 196 * MiB, WS_MASK = 228 * MiB, WS_HX = 244 * MiB;
constexpr size_t WS_QL = 436 * MiB, WS_QR = 564 * MiB, WS_CKVF = 596 * MiB, WS_CKV = 628 * MiB, WS_KR = 644 * MiB, WS_KI = 648 * MiB, WS_WI = 656 * MiB, WS_QI = 658 * MiB;
constexpr size_t WS_QB = 722 * MiB, WS_KB = 786 * MiB, WS_VB = 850 * MiB;
constexpr size_t WS_QC = 436 * MiB, WS_OC = 564 * MiB, WS_HID = 436 * MiB, WS_END = 948 * MiB;

constexpr int LDS_BYTES = 147456;

#define GAS __attribute__((address_space(1)))
#define LAS __attribute__((address_space(3)))
typedef unsigned short bf16;
typedef unsigned v4u __attribute__((ext_vector_type(4)));
typedef unsigned v2u __attribute__((ext_vector_type(2)));
typedef float f32x4 __attribute__((ext_vector_type(4)));
typedef float f32x2 __attribute__((ext_vector_type(2)));
#define LDS_WAIT() asm volatile("s_waitcnt lgkmcnt(0)" ::: "memory")

__device__ __forceinline__ unsigned f2bf(float f) { unsigned u = __builtin_bit_cast(unsigned, f); return (u + 0x7fffu + ((u >> 16) & 1u)) >> 16; }
__device__ __forceinline__ unsigned pk2(float lo, float hi) { return f2bf(lo) | (f2bf(hi) << 16); }
__device__ __forceinline__ float bflo(unsigned w) { return __uint_as_float(w << 16); }
__device__ __forceinline__ float bfhi(unsigned w) { return __uint_as_float(w & 0xffff0000u); }
__device__ __forceinline__ float wave_sum(float v) {
#pragma unroll
    for (int o = 1; o < 64; o <<= 1) v += __shfl_xor(v, o);
    return v;
}
__device__ __forceinline__ float wave_max(float v) {
#pragma unroll
    for (int o = 1; o < 64; o <<= 1) v = fmaxf(v, __shfl_xor(v, o));
    return v;
}

struct Frame {
    LAS unsigned char* lds;
    int tid, lane, wave, G, gw, NGW;
    int wave_s;
    const __attribute__((address_space(4))) char* kargs;
    float* out;
    unsigned char* ws;
    size_t z;
};
__device__ __forceinline__ const float* inp(const Frame& F, int i) {
    const __attribute__((address_space(4))) char* p = F.kargs; asm volatile("" : "+s"(p));
    return *(const float* const __attribute__((address_space(4)))*)(p + 8 * i);
}
template <class TT> __device__ __forceinline__ TT* wsp(const Frame& F, size_t off) { return (TT*)(F.ws + F.z + off); }
__device__ __forceinline__ float* outp(const Frame& F) { return (float*)((unsigned char*)F.out + F.z); }
__device__ __forceinline__ void phase_ctx(Frame& F) {
    size_t z = 0; asm volatile("" : "+s"(z)); F.z = z;
    int ws_ = F.wave_s; asm volatile("" : "+s"(ws_));
    unsigned ones_ = ~0u; asm volatile("" : "+s"(ones_));
    const int lane_ = (int)__builtin_amdgcn_mbcnt_hi(ones_, __builtin_amdgcn_mbcnt_lo(ones_, 0u));
    F.tid = ws_ * 64 + lane_; F.lane = lane_; F.wave = ws_; F.G = gridDim.x; F.gw = blockIdx.x * NWAVES + F.wave; F.NGW = F.G * NWAVES;
}

__device__ __forceinline__ float rstd_from_parts(const float* part, int row) {
    const f32x4* p = (const f32x4*)(part + (size_t)row * 16);
    const f32x4 a = p[0], b = p[1], c = p[2], d = p[3];
    const float s = ((a[0] + a[1]) + (a[2] + a[3])) + ((b[0] + b[1]) + (b[2] + b[3])) + ((c[0] + c[1]) + (c[2] + c[3])) + ((d[0] + d[1]) + (d[2] + d[3]));
    return 1.0f / sqrtf(s * (1.0f / DM) + EPS);
}
__device__ __forceinline__ f32x4 rope4(f32x4 v, f32x4 cs) { return (f32x4){v[0] * cs[0] - v[1] * cs[1], v[1] * cs[0] + v[0] * cs[1], v[2] * cs[2] - v[3] * cs[3], v[3] * cs[2] + v[2] * cs[3]}; }
__device__ __forceinline__ v4u pack8(f32x4 a, f32x4 b) { v4u w; w.x = pk2(a[0], a[1]); w.y = pk2(a[2], a[3]); w.z = pk2(b[0], b[1]); w.w = pk2(b[2], b[3]); return w; }

struct EpiInProj {
    static constexpr bool PERM = true, AFTER_DRAIN = false;
    const float* rstd; const float* tab64; const float* tab32;
    bf16 *QL, *QR, *KR, *KI, *QI, *QB, *KB, *VB; float *CKVF, *WI;
    __device__ __forceinline__ void operator()(const pg8::f32x4 (&acc)[2][2][4][2], const pg8::Unit& u, int wr, int wc, int fr, int fq) const {
        const int pn = u.pn;
#pragma unroll
        for (int ai = 0; ai < 2; ++ai)
#pragma unroll
            for (int m = 0; m < 4; ++m) {
                const int row = u.pm * 256 + ai * 128 + wr * 64 + m * 16 + fr, pos = row & (SEQ - 1);
                const float rs = rstd[row];
                if (pn < 4) {
#pragma unroll
                    for (int bj = 0; bj < 2; ++bj) { const f32x4 a = acc[ai][bj][m][0] * (rs * SCALE_A), b = acc[ai][bj][m][1] * (rs * SCALE_A);
                        *(v4u*)(QL + (size_t)row * 1024 + pn * 256 + bj * 128 + wc * 32 + 8 * fq) = pack8(a, b); }
                } else if (pn == 4) {
                    const f32x4 cs0 = *(const f32x4*)(tab32 + ((size_t)pos * 16 + 4 * fq) * 2), cs1 = *(const f32x4*)(tab32 + ((size_t)pos * 16 + 4 * fq + 2) * 2);
#pragma unroll
                    for (int bj = 0; bj < 2; ++bj) { const f32x4 a = rope4(acc[ai][bj][m][0] * (rs * SCALE_A), cs0), b = rope4(acc[ai][bj][m][1] * (rs * SCALE_A), cs1);
                        *(v4u*)(QR + (size_t)row * 256 + bj * 128 + wc * 32 + 8 * fq) = pack8(a, b); }
                } else if (pn == 5) {
                    { const f32x4 a = acc[ai][0][m][0] * rs, b = acc[ai][0][m][1] * rs; float* o = CKVF + (size_t)row * 128 + wc * 32 + 8 * fq; *(f32x4*)o = a; *(f32x4*)(o + 4) = b; }
                    if (wc == 0) {
                        const f32x4 cs0 = *(const f32x4*)(tab32 + ((size_t)pos * 16 + 4 * fq) * 2), cs1 = *(const f32x4*)(tab32 + ((size_t)pos * 16 + 4 * fq + 2) * 2);
                        const f32x4 a = rope4(acc[ai][1][m][0] * rs, cs0), b = rope4(acc[ai][1][m][1] * rs, cs1);
                        *(v4u*)(KR + (size_t)row * 32 + 8 * fq) = pack8(a, b);
                    } else if (wc < 3) {
                        const int tb = 16 * (wc - 1) + 4 * fq;
                        const f32x4 cs0 = *(const f32x4*)(tab64 + ((size_t)pos * 32 + tb) * 2), cs1 = *(const f32x4*)(tab64 + ((size_t)pos * 32 + tb + 2) * 2);
                        const f32x4 a = rope4(acc[ai][1][m][0] * rs, cs0), b = rope4(acc[ai][1][m][1] * rs, cs1);
                        *(v4u*)(KI + (size_t)row * 64 + 32 * (wc - 1) + 8 * fq) = pack8(a, b);
                    } else if (fq == 0) {
                        const f32x4 a = acc[ai][1][m][0] * (rs * IDX_W), b = acc[ai][1][m][1] * (rs * IDX_W); float* o = WI + (size_t)row * 8; *(f32x4*)o = a; *(f32x4*)(o + 4) = b;
                    }
                } else if (pn < 12) {
                    const int tb = 16 * (wc & 1) + 4 * fq;
                    const f32x4 cs0 = *(const f32x4*)(tab64 + ((size_t)pos * 32 + tb) * 2), cs1 = *(const f32x4*)(tab64 + ((size_t)pos * 32 + tb + 2) * 2);
                    const float sc = (pn == 8 || pn == 9) ? rs * SCALE_B : rs;
                    const size_t eoff = (size_t)row * 512 + (pn & 1) * 256 + wc * 32 + 8 * fq;
#pragma unroll
                    for (int bj = 0; bj < 2; ++bj) { const f32x4 a = rope4(acc[ai][bj][m][0] * sc, cs0), b = rope4(acc[ai][bj][m][1] * sc, cs1); const v4u w = pack8(a, b);
                        if (pn < 8) *(v4u*)(QI + eoff + bj * 128) = w; else if (pn < 10) *(v4u*)(QB + eoff + bj * 128) = w; else *(v4u*)(KB + eoff + bj * 128) = w; }
                } else {
#pragma unroll
                    for (int bj = 0; bj < 2; ++bj) { const f32x4 a = acc[ai][bj][m][0] * rs, b = acc[ai][bj][m][1] * rs;
                        *(v4u*)(VB + (size_t)row * 512 + (pn & 1) * 256 + bj * 128 + wc * 32 + 8 * fq) = pack8(a, b); }
                }
            }
    }
};
template <int ACT  > struct EpiRowScale {
    static constexpr bool PERM = true, AFTER_DRAIN = false;
    bf16* O; int ldc; const float* rstd_direct; const float* parts; float cs;
    __device__ __forceinline__ void operator()(const pg8::f32x4 (&acc)[2][2][4][2], const pg8::Unit& u, int wr, int wc, int fr, int fq) const {
#pragma unroll
        for (int ai = 0; ai < 2; ++ai)
#pragma unroll
            for (int m = 0; m < 4; ++m) {
                const int row = u.pm * 256 + ai * 128 + wr * 64 + m * 16 + fr;
                const float rs = (ACT == 2) ? 1.0f : (parts ? rstd_from_parts(parts, row) : rstd_direct[row]) * cs;
#pragma unroll
                for (int bj = 0; bj < 2; ++bj) { f32x4 a = acc[ai][bj][m][0] * rs, b = acc[ai][bj][m][1] * rs;
                    if (ACT == 1) {
#pragma unroll
                        for (int e = 0; e < 4; ++e) { const float x = fmaxf(a[e], 0.f), y = fmaxf(b[e], 0.f); a[e] = x * x; b[e] = y * y; } }
                    *(v4u*)(O + (size_t)row * ldc + u.pn * 256 + bj * 128 + wc * 32 + 8 * fq) = pack8(a, b); }
            }
    }
};
struct EpiResid {
    static constexpr bool PERM = true, AFTER_DRAIN = false;
    bf16* XBio; float* parts;
    __device__ __forceinline__ void operator()(const pg8::f32x4 (&acc)[2][2][4][2], const pg8::Unit& u, int wr, int wc, int fr, int fq) const {
#pragma unroll
        for (int ai = 0; ai < 2; ++ai)
#pragma unroll
            for (int m = 0; m < 4; ++m) {
                const int row = u.pm * 256 + ai * 128 + wr * 64 + m * 16 + fr;
                float ss = 0.f;
#pragma unroll
                for (int bj = 0; bj < 2; ++bj) { const size_t off = (size_t)row * DM + u.pn * 256 + bj * 128 + wc * 32 + 8 * fq;
                    const v4u rw = *(const v4u*)(XBio + off);
                    const f32x4 a = (f32x4){bflo(rw.x), bfhi(rw.x), bflo(rw.y), bfhi(rw.y)} + acc[ai][bj][m][0], b = (f32x4){bflo(rw.z), bfhi(rw.z), bflo(rw.w), bfhi(rw.w)} + acc[ai][bj][m][1];
                    *(v4u*)(XBio + off) = pack8(a, b);
                    ss += (a[0] * a[0] + a[1] * a[1]) + (a[2] * a[2] + a[3] * a[3]) + (b[0] * b[0] + b[1] * b[1]) + (b[2] * b[2] + b[3] * b[3]); }
                ss += __shfl_xor(ss, 16); ss += __shfl_xor(ss, 32);
                if (fq == 0) parts[(size_t)row * 16 + u.pn * 4 + wc] = ss;
            }
    }
};

struct KvOrder {
    int G, c; const char* memb; const char* wkv;
    __device__ __forceinline__ bool next(int i, pg8::Unit& u) const {
        const int L = i * G + c; if (L >= 256) return false;
        if (L < 128) { u.pm = L >> 2; u.pn = L & 3; u.pa = memb + (size_t)u.pm * 256 * DM * 2; u.pb = wkv + (size_t)u.pn * 256 * DM * 2; }
        else { const int l2 = L - 128; u.pm = 64 + (l2 & 3); u.pn = l2 >> 2; u.pa = wkv + (size_t)(1024 + (l2 & 3) * 256) * DM * 2; u.pb = memb + (size_t)u.pn * 256 * DM * 2; }
        return true;
    }
    __device__ __forceinline__ void a_ready(const pg8::Unit&) const {}
    __device__ __forceinline__ void done(const pg8::Unit&) const {}
};
struct EpiKv {
    static constexpr bool PERM = true, AFTER_DRAIN = false;
    bf16* KC; bf16* VT; const float* rstd;
    __device__ __forceinline__ void operator()(const pg8::f32x4 (&acc)[2][2][4][2], const pg8::Unit& u, int wr, int wc, int fr, int fq) const {
        const bool isv = u.pm >= 64; const int pm = isv ? u.pm - 64 : u.pm;
#pragma unroll
        for (int ai = 0; ai < 2; ++ai)
#pragma unroll
            for (int m = 0; m < 4; ++m) {
                const int row = pm * 256 + ai * 128 + wr * 64 + m * 16 + fr;
#pragma unroll
                for (int bj = 0; bj < 2; ++bj) { const int col = u.pn * 256 + bj * 128 + wc * 32 + 8 * fq;
                    if (!isv) { const float rs = rstd[row]; *(v4u*)(KC + (size_t)row * DM + col) = pack8(acc[ai][bj][m][0] * rs, acc[ai][bj][m][1] * rs); }
                    else { const f32x4 r0 = *(const f32x4*)(rstd + col), r1 = *(const f32x4*)(rstd + col + 4); *(v4u*)(VT + (size_t)row * TM + col) = pack8(acc[ai][bj][m][0] * r0, acc[ai][bj][m][1] * r1); } }
            }
    }
};
struct CrossOrder {
    int G, c; const char* A; const char* B; size_t bstride, hstride;
    __device__ __forceinline__ bool next(int i, pg8::Unit& u) const {
        if (i >= 4) return false;
        const int xcd = c & 7, slot = c >> 3, e = i * 32 + slot, pair = xcd * 16 + (e >> 3), qt = e & 7, b = pair >> 2, h = pair & 3;
        u.pm = b * 8 + qt; u.pn = h; u.pa = A + ((size_t)u.pm * 256 * DM + h * 256) * 2; u.pb = B + (size_t)b * bstride + (size_t)h * hstride; return true;
    }
    __device__ __forceinline__ void a_ready(const pg8::Unit&) const {}
    __device__ __forceinline__ void done(const pg8::Unit&) const {}
};
struct EpiSoftmaxP {
    static constexpr bool PERM = true, AFTER_DRAIN = false;
    bf16* P; LAS float* xch;
    __device__ __forceinline__ void operator()(const pg8::f32x4 (&acc_)[2][2][4][2], const pg8::Unit& u, int wr, int wc, int fr, int fq) const {
        pg8::f32x4 (&acc)[2][2][4][2] = const_cast<pg8::f32x4 (&)[2][2][4][2]>(acc_);
        LAS float* xb = xch + (wr * 64 + fr) * 8; asm volatile("" : "+v"(xb));
#pragma unroll
        for (int ai = 0; ai < 2; ++ai)
#pragma unroll
            for (int m = 0; m < 4; ++m) {
                float v = -INFINITY;
#pragma unroll
                for (int bj = 0; bj < 2; ++bj)
#pragma unroll
                    for (int n = 0; n < 2; ++n) { const f32x4 x = acc[ai][bj][m][n]; v = fmaxf(v, fmaxf(fmaxf(x[0], x[1]), fmaxf(x[2], x[3]))); }
                v = fmaxf(v, __shfl_xor(v, 16)); v = fmaxf(v, __shfl_xor(v, 32));
                float s = 0.f;
#pragma unroll
                for (int bj = 0; bj < 2; ++bj)
#pragma unroll
                    for (int n = 0; n < 2; ++n) { f32x4 x = acc[ai][bj][m][n];
#pragma unroll
                        for (int e = 0; e < 4; ++e) { x[e] = __builtin_amdgcn_exp2f(x[e] - v); s += x[e]; }
                        acc[ai][bj][m][n] = x; }
                s += __shfl_xor(s, 16); s += __shfl_xor(s, 32);
                if (fq == 0) *(LAS f32x2*)(xb + (ai * 128 + m * 16) * 8 + wc * 2) = (f32x2){v, s};
            }
        asm volatile("s_waitcnt lgkmcnt(0)" ::: "memory"); __builtin_amdgcn_s_barrier(); asm volatile("" ::: "memory");
#pragma unroll
        for (int ai = 0; ai < 2; ++ai)
#pragma unroll
            for (int m = 0; m < 4; ++m) {
                const int rl = ai * 128 + wr * 64 + m * 16 + fr, row = u.pm * 256 + rl;
                const f32x4 a = *(const LAS f32x4*)(xb + (ai * 128 + m * 16) * 8), b = *(const LAS f32x4*)(xb + (ai * 128 + m * 16) * 8 + 4);
                const float M = fmaxf(fmaxf(a[0], a[2]), fmaxf(b[0], b[2]));
                const float L = a[1] * __builtin_amdgcn_exp2f(a[0] - M) + a[3] * __builtin_amdgcn_exp2f(a[2] - M) + b[1] * __builtin_amdgcn_exp2f(b[0] - M) + b[3] * __builtin_amdgcn_exp2f(b[2] - M);
                const float mown = (wc == 0) ? a[0] : (wc == 1) ? a[2] : (wc == 2) ? b[0] : b[2];
                const float sc = __builtin_amdgcn_exp2f(mown - M) / L;
#pragma unroll
                for (int bj = 0; bj < 2; ++bj) *(v4u*)(P + (size_t)row * DM + u.pn * 256 + bj * 128 + wc * 32 + 8 * fq) = pack8(acc[ai][bj][m][0] * sc, acc[ai][bj][m][1] * sc);
                __builtin_amdgcn_sched_barrier(0);
            }
        asm volatile("s_waitcnt lgkmcnt(0)" ::: "memory"); __builtin_amdgcn_s_barrier(); asm volatile("" ::: "memory");
    }
};

template <class Map>
__device__ __forceinline__ void transpose_item(const float* W, int srcN, const float* g, bf16* WT, int ldk, int koff, LAS float* scr, int k0, int n0, int lane, const Map& map) {
    const int sc = map(n0 + (lane & 31));
#pragma unroll 8
    for (int i = 0; i < 32; ++i) { const int kk = 2 * i + (lane >> 5); float v = (sc >= 0) ? W[(size_t)(k0 + kk) * srcN + sc] : 0.f; if (g) v *= g[k0 + kk]; scr[kk * 33 + (lane & 31)] = v; }
    LDS_WAIT(); asm volatile("" ::: "memory");
    const int c = lane & 7;
#pragma unroll
    for (int j = 0; j < 4; ++j) { const int n = (lane >> 3) + 8 * j; const LAS float* s = scr + (8 * c) * 33 + n;
        v4u o; o.x = pk2(s[0 * 33], s[1 * 33]); o.y = pk2(s[2 * 33], s[3 * 33]); o.z = pk2(s[4 * 33], s[5 * 33]); o.w = pk2(s[6 * 33], s[7 * 33]);
        *(v4u*)(WT + (size_t)(n0 + n) * ldk + koff + k0 + 8 * c) = o; }
    LDS_WAIT(); asm volatile("" ::: "memory");
}
struct MapId { __device__ __forceinline__ int operator()(int n) const { return n; } };
__device__ __forceinline__ int il64(int p) { return (p >> 1) + 32 * (p & 1); }
__device__ __forceinline__ int il32(int p) { return (p >> 1) + 16 * (p & 1); }
struct MapIn {
    __device__ __forceinline__ int operator()(int nn) const {
        int n = nn - 1024;
        if (n < 256) return 512 + (n >> 5) * 32 + il32(n & 31);
        n -= 256;
        if (n < 256) { if (n < 128) return 768 + n; if (n < 160) return 896 + il32(n - 128); if (n < 224) return 1440 + il64(n - 160); if (n < 232) return 1504 + (n - 224); return -1; }
        n -= 256;
        if (n < 512) return 928 + (n >> 6) * 64 + il64(n & 63);
        n -= 512;
        if (n < 512) return 1512 + (n >> 6) * 64 + il64(n & 63);
        n -= 512;
        if (n < 512) return 2024 + (n >> 6) * 64 + il64(n & 63);
        n -= 512;
        return 2536 + n;
    }
};

__device__ __forceinline__ void p0_prologue(Frame& F) {
    LAS float* scr = (LAS float*)(F.lds + F.wave * 16384);
    const int gw = F.gw, NGW = F.NGW, lane = F.lane;
    const float *x = inp(F, 0), *mem = inp(F, 1), *g_mix = inp(F, 2), *w_in = inp(F, 3), *w_uk = inp(F, 5), *w_uv = inp(F, 6), *w_out = inp(F, 7), *g_cross = inp(F, 8), *g_mem = inp(F, 9);
    const float *w_q = inp(F, 10), *w_kv = inp(F, 11), *w_o = inp(F, 12), *g_mlp = inp(F, 13), *w_up = inp(F, 14), *w_dn = inp(F, 15);
    bf16 *WIN = wsp<bf16>(F, WS_WIN), *WOUT = wsp<bf16>(F, WS_WOUT), *WQ = wsp<bf16>(F, WS_WQ), *WKV = wsp<bf16>(F, WS_WKV), *WO = wsp<bf16>(F, WS_WO), *WUP = wsp<bf16>(F, WS_WUP), *WDN = wsp<bf16>(F, WS_WDN);
    constexpr int I_IN = 16 * (2560 / 32), I_OUT2 = 8 * 32, I_Q = 16 * 32, I_KV = 16 * 64, I_O = 16 * 32, I_UP = 16 * 128, I_DN = 64 * 32;
    constexpr int NIT = I_IN + I_OUT2 + I_Q + I_KV + I_O + I_UP + I_DN;
    for (int it = gw; it < NIT; it += NGW) {
        int r = it;
        if (r < I_IN) { const int nb = r % 80, kb = r / 80; transpose_item(w_in, W_IN_COLS, g_mix, WIN, DM, 0, scr, 64 * kb, 1024 + 32 * nb, lane, MapIn()); continue; } r -= I_IN;
        if (r < I_OUT2) { const int nb = r % 32, kb = r / 32; transpose_item(w_out + (size_t)512 * DM, DM, nullptr, WOUT, KOUT, 1024, scr, 64 * kb, 32 * nb, lane, MapId()); continue; } r -= I_OUT2;
        if (r < I_Q) { const int nb = r % 32, kb = r / 32; transpose_item(w_q, DM, g_cross, WQ, DM, 0, scr, 64 * kb, 32 * nb, lane, MapId()); continue; } r -= I_Q;
        if (r < I_KV) { const int nb = r % 64, kb = r / 64; transpose_item(w_kv, 2048, g_mem, WKV, DM, 0, scr, 64 * kb, 32 * nb, lane, MapId()); continue; } r -= I_KV;
        if (r < I_O) { const int nb = r % 32, kb = r / 32; transpose_item(w_o, DM, nullptr, WO, DM, 0, scr, 64 * kb, 32 * nb, lane, MapId()); continue; } r -= I_O;
        if (r < I_UP) { const int nb = r % 128, kb = r / 128; transpose_item(w_up, FF, g_mlp, WUP, DM, 0, scr, 64 * kb, 32 * nb, lane, MapId()); continue; } r -= I_UP;
        { const int nb = r % 32, kb = r / 32; transpose_item(w_dn, DM, nullptr, WDN, FF, 0, scr, 64 * kb, 32 * nb, lane, MapId()); }
    }
    for (int it = gw; it < 8 * 16 * 8; it += NGW) {
        const int cg8 = it & 7, kb = (it >> 3) & 15, h = it >> 7, k = kb * 64 + lane;
        float a[16];
#pragma unroll
        for (int c = 0; c < 16; ++c) a[c] = 0.f;
        const float* wrow = w_in + (size_t)k * W_IN_COLS + h * 64;
        const float* uk = w_uk + (size_t)h * 64 * 128 + cg8 * 16 + (lane & 15);
#pragma unroll 2
        for (int j = 0; j < 64; ++j) {
            const float wv = wrow[j]; const float u = uk[(size_t)j * 128];
#pragma unroll
            for (int c = 0; c < 16; ++c) a[c] += wv * __shfl(u, c);
        }
        const float gk = g_mix[k];
#pragma unroll
        for (int c = 0; c < 16; ++c) WIN[(size_t)(h * 128 + cg8 * 16 + c) * DM + k] = (bf16)f2bf(a[c] * gk);
    }
    for (int it = gw; it < 8 * 16 * 8; it += NGW) {
        const int cg8 = it & 7, nb = (it >> 3) & 15, h = it >> 7, n = nb * 64 + lane;
        float a[16];
#pragma unroll
        for (int c = 0; c < 16; ++c) a[c] = 0.f;
        const float* uv = w_uv + (size_t)(h * 128 + cg8 * 16 + (lane & 15)) * 64;
#pragma unroll 2
        for (int v = 0; v < 64; ++v) {
            const float wv = w_out[(size_t)(h * 64 + v) * DM + n]; const float u = uv[v];
#pragma unroll
            for (int c = 0; c < 16; ++c) a[c] += wv * __shfl(u, c);
        }
        v4u o0, o1; o0.x = pk2(a[0], a[1]); o0.y = pk2(a[2], a[3]); o0.z = pk2(a[4], a[5]); o0.w = pk2(a[6], a[7]); o1.x = pk2(a[8], a[9]); o1.y = pk2(a[10], a[11]); o1.z = pk2(a[12], a[13]); o1.w = pk2(a[14], a[15]);
        bf16* d = WOUT + (size_t)n * KOUT + h * 128 + cg8 * 16; *(v4u*)d = o0; *(v4u*)(d + 8) = o1;
    }
    bf16 *XB = wsp<bf16>(F, WS_XB), *MEMB = wsp<bf16>(F, WS_MEMB); float *R1 = wsp<float>(F, WS_RSTD1), *RM = wsp<float>(F, WS_RSTDM);
    for (int m0 = gw; m0 < T + TM; m0 += 4 * NGW) {
        f32x4 v[4][4]; float ssq[4];
#pragma unroll
        for (int u = 0; u < 4; ++u) { const int m = m0 + u * NGW; const bool ok = m < T + TM; const bool isx = m < T; const int r = isx ? m : m - T;
            const f32x4* xr = (const f32x4*)((isx ? x : mem) + (size_t)(ok ? r : 0) * DM) + lane;
#pragma unroll
            for (int j = 0; j < 4; ++j) v[u][j] = xr[64 * j]; }
#pragma unroll
        for (int u = 0; u < 4; ++u) { float s = 0.f;
#pragma unroll
            for (int j = 0; j < 4; ++j) s += (v[u][j][0] * v[u][j][0] + v[u][j][1] * v[u][j][1]) + (v[u][j][2] * v[u][j][2] + v[u][j][3] * v[u][j][3]);
            ssq[u] = wave_sum(s); }
#pragma unroll
        for (int u = 0; u < 4; ++u) { const int m = m0 + u * NGW; if (m < T + TM) { const bool isx = m < T; const int r = isx ? m : m - T;
            if (lane == 0) (isx ? R1 : RM)[r] = 1.0f / sqrtf(ssq[u] * (1.0f / DM) + EPS);
            v2u* o8 = (v2u*)((isx ? XB : MEMB) + (size_t)r * DM) + lane;
#pragma unroll
            for (int j = 0; j < 4; ++j) { v2u w; w.x = pk2(v[u][j][0], v[u][j][1]); w.y = pk2(v[u][j][2], v[u][j][3]); o8[64 * j] = w; } } }
    }
    float *T64 = wsp<float>(F, WS_TAB64), *T32 = wsp<float>(F, WS_TAB32);
    for (int e = gw * 64 + lane; e < SEQ * 32; e += NGW * 64) {
        const int pos = e >> 5, t = e & 31;
        const float inv = exp2f(-(float)t * (13.287712379549449f / 32.0f));
        const float ang = (float)pos * inv;
        const double rev = (double)ang * 0.15915494309189535; const float fr = (float)(rev - floor(rev));
        const float c = __builtin_amdgcn_cosf(fr), s = __builtin_amdgcn_sinf(fr);
        T64[2 * e] = c; T64[2 * e + 1] = s;
        if ((t & 1) == 0) { T32[2 * (pos * 16 + (t >> 1))] = c; T32[2 * (pos * 16 + (t >> 1)) + 1] = s; }
    }
}

__device__ __forceinline__ void p2_ckv_norm(Frame& F) {
    const float* CKVF = wsp<float>(F, WS_CKVF); bf16* CKV = wsp<bf16>(F, WS_CKV); const float* g = inp(F, 4);
    const float g0 = g[2 * F.lane], g1 = g[2 * F.lane + 1];
    for (int r0 = F.gw; r0 < T; r0 += 4 * F.NGW) {
        f32x2 v[4]; float ss[4];
#pragma unroll
        for (int u = 0; u < 4; ++u) v[u] = *(const f32x2*)(CKVF + (size_t)(r0 + u * F.NGW) * 128 + 2 * F.lane);
#pragma unroll
        for (int u = 0; u < 4; ++u) ss[u] = wave_sum(v[u][0] * v[u][0] + v[u][1] * v[u][1]);
#pragma unroll
        for (int u = 0; u < 4; ++u) { const float rs = 1.0f / sqrtf(ss[u] * (1.0f / 128.0f) + EPS);
            *(unsigned*)(CKV + (size_t)(r0 + u * F.NGW) * 128 + 2 * F.lane) = pk2(v[u][0] * rs * g0, v[u][1] * rs * g1); }
    }
}
__device__ __forceinline__ void p2_index_select(Frame& F) {
    const bf16 *QI = wsp<bf16>(F, WS_QI), *KI = wsp<bf16>(F, WS_KI); const float* WI = wsp<float>(F, WS_WI); unsigned* MASK = wsp<unsigned>(F, WS_MASK);
    LAS float* qf = (LAS float*)(F.lds + F.wave * 16384);
    LAS unsigned* keys = (LAS unsigned*)(F.lds + F.wave * 16384 + 2048);
    const int lane = F.lane;
    for (int t = F.gw; t < T; t += F.NGW) {
        const int b = t >> 11, q = t & (SEQ - 1);
        { const v4u w = *(const v4u*)(QI + (size_t)t * 512 + 8 * lane);
          *(LAS f32x4*)(qf + 8 * lane) = (f32x4){bflo(w.x), bfhi(w.x), bflo(w.y), bfhi(w.y)}; *(LAS f32x4*)(qf + 8 * lane + 4) = (f32x4){bflo(w.z), bfhi(w.z), bflo(w.w), bfhi(w.w)}; }
        const f32x4 wa = *(const f32x4*)(WI + (size_t)t * 8), wb = *(const f32x4*)(WI + (size_t)t * 8 + 4);
        const float wh[8] = {wa[0], wa[1], wa[2], wa[3], wb[0], wb[1], wb[2], wb[3]};
        LDS_WAIT();
        const int nr = (q >> 6) + 1;
#pragma unroll 1
        for (int r = 0; r < nr; ++r) {
            asm volatile("" ::: "memory");
            const int s = r * 64 + lane;
            const v4u* kp = (const v4u*)(KI + (size_t)(b * SEQ + s) * 64);
            float dh[8];
#pragma unroll
            for (int h = 0; h < 8; ++h) dh[h] = 0.f;
#pragma unroll 1
            for (int hf = 0; hf < 2; ++hf) {
                asm volatile("" ::: "memory");
                float kf[32];
#pragma unroll
                for (int i = 0; i < 4; ++i) { const v4u w = kp[hf * 4 + i]; kf[8 * i] = bflo(w.x); kf[8 * i + 1] = bfhi(w.x); kf[8 * i + 2] = bflo(w.y); kf[8 * i + 3] = bfhi(w.y); kf[8 * i + 4] = bflo(w.z); kf[8 * i + 5] = bfhi(w.z); kf[8 * i + 6] = bflo(w.w); kf[8 * i + 7] = bfhi(w.w); }
#pragma unroll
                for (int h = 0; h < 8; ++h) {
#pragma unroll
                    for (int i = 0; i < 32; i += 4) { const f32x4 qv = *(const LAS f32x4*)(qf + h * 64 + hf * 32 + i); dh[h] += qv[0] * kf[i] + qv[1] * kf[i + 1] + qv[2] * kf[i + 2] + qv[3] * kf[i + 3]; }
                    __builtin_amdgcn_sched_barrier(0); }
            }
            float score = 0.f;
#pragma unroll
            for (int h = 0; h < 8; ++h) score += fmaxf(dh[h], 0.f) * wh[h];
            unsigned ord = __float_as_uint(score); ord ^= (ord >> 31) ? 0xFFFFFFFFu : 0x80000000u;
            keys[s] = (s <= q) ? ((ord & 0xFFFFF800u) | (unsigned)(SEQ - 1 - s)) : 0u;
        }
        LDS_WAIT();
        unsigned key[32];
#pragma unroll
        for (int r = 0; r < 32; ++r) key[r] = (r < nr) ? keys[r * 64 + lane] : 0u;
        unsigned thr = 1u;
        if (q >= 256) {
            unsigned lo = 0u;
#pragma unroll 1
            for (int bit = 31; bit >= 0; --bit) {
                const unsigned cand = lo | (1u << bit); int cnt = 0;
#pragma unroll
                for (int r = 0; r < 32; ++r) { cnt += __popcll(__ballot(key[r] >= cand)); if ((r & 3) == 3) __builtin_amdgcn_sched_barrier(0); }
                if (cnt >= 256) lo = cand;
            }
            thr = lo;
        }
        LAS unsigned long long* lm = (LAS unsigned long long*)keys;
#pragma unroll
        for (int r = 0; r < 32; ++r) { const unsigned long long bm = __ballot(key[r] >= thr && key[r] != 0u); if (lane == 0) lm[r] = bm; if ((r & 3) == 3) __builtin_amdgcn_sched_barrier(0); }
        LDS_WAIT();
        const unsigned long long mine = lm[lane & 31];
        if (lane < 32) *(unsigned long long*)(MASK + (size_t)t * 64 + 2 * lane) = mine;
        LDS_WAIT();
    }
}
__device__ __forceinline__ void p3_dsa_naive(Frame& F) {
    const bf16 *QL = wsp<bf16>(F, WS_QL), *QR = wsp<bf16>(F, WS_QR), *CKV = wsp<bf16>(F, WS_CKV), *KR = wsp<bf16>(F, WS_KR); const unsigned* MASK = wsp<unsigned>(F, WS_MASK); bf16* HX = wsp<bf16>(F, WS_HX);
    LAS float* qf = (LAS float*)(F.lds + F.wave * 16384);
    LAS int* list = (LAS int*)(F.lds + F.wave * 16384 + 5120);
    LAS float* P = (LAS float*)(F.lds + F.wave * 16384 + 6144);
    const int lane = F.lane;
    for (int t = F.gw; t < T; t += F.NGW) {
        const int b = t >> 11;
#pragma unroll
        for (int j = 0; j < 2; ++j) { const int e0 = j * 512 + 8 * lane; const v4u w = *(const v4u*)(QL + (size_t)t * 1024 + e0); const int h = e0 >> 7, c = e0 & 127; LAS float* d = qf + h * 160 + c;
            *(LAS f32x4*)d = (f32x4){bflo(w.x), bfhi(w.x), bflo(w.y), bfhi(w.y)}; *(LAS f32x4*)(d + 4) = (f32x4){bflo(w.z), bfhi(w.z), bflo(w.w), bfhi(w.w)}; }
        { const int e0 = 4 * lane; const v2u w = *(const v2u*)(QR + (size_t)t * 256 + e0); const int h = e0 >> 5, c = e0 & 31; *(LAS f32x4*)(qf + h * 160 + 128 + c) = (f32x4){bflo(w.x), bfhi(w.x), bflo(w.y), bfhi(w.y)}; }
        unsigned w = MASK[(size_t)t * 64 + lane];
        const int cl = __popc(w); int pre = cl;
#pragma unroll
        for (int o = 1; o < 64; o <<= 1) { const int v = __shfl_up(pre, o); if (lane >= o) pre += v; }
        const int cnt = __shfl(pre, 63); int pos = pre - cl;
        while (w) { const int bb = __ffs(w) - 1; list[pos++] = lane * 32 + bb; w &= w - 1; }
        LDS_WAIT();
#pragma unroll 1
        for (int ci = 0; ci * 64 < cnt; ++ci) {
            const int j = ci * 64 + lane; const bool act = j < cnt; const int s = act ? list[j] : 0; const size_t row = (size_t)b * SEQ + s;
            float a[8];
#pragma unroll
            for (int h = 0; h < 8; ++h) a[h] = 0.f;
#pragma unroll 1
            for (int cc = 0; cc < 5; ++cc) {
                asm volatile("" ::: "memory");
                const v4u* kp = (cc < 4) ? (const v4u*)(CKV + row * 128 + cc * 32) : (const v4u*)(KR + row * 32);
                float kf[32];
#pragma unroll
                for (int i = 0; i < 4; ++i) { const v4u ww = kp[i]; kf[8 * i] = bflo(ww.x); kf[8 * i + 1] = bfhi(ww.x); kf[8 * i + 2] = bflo(ww.y); kf[8 * i + 3] = bfhi(ww.y); kf[8 * i + 4] = bflo(ww.z); kf[8 * i + 5] = bfhi(ww.z); kf[8 * i + 6] = bflo(ww.w); kf[8 * i + 7] = bfhi(ww.w); }
#pragma unroll
                for (int h = 0; h < 8; ++h) {
#pragma unroll
                    for (int i = 0; i < 32; i += 4) { const f32x4 qv = *(const LAS f32x4*)(qf + h * 160 + cc * 32 + i); a[h] += qv[0] * kf[i] + qv[1] * kf[i + 1] + qv[2] * kf[i + 2] + qv[3] * kf[i + 3]; }
                    __builtin_amdgcn_sched_barrier(0); }
            }
            LAS float* d = P + j * 8; *(LAS f32x4*)d = (f32x4){a[0], a[1], a[2], a[3]}; *(LAS f32x4*)(d + 4) = (f32x4){a[4], a[5], a[6], a[7]};
        }
        LDS_WAIT();
        float sc[4][8];
#pragma unroll
        for (int ci = 0; ci < 4; ++ci) { const int j = ci * 64 + lane; const bool act = j < cnt; const f32x4 pa = *(const LAS f32x4*)(P + j * 8), pb = *(const LAS f32x4*)(P + j * 8 + 4);
            sc[ci][0] = act ? pa[0] : -INFINITY; sc[ci][1] = act ? pa[1] : -INFINITY; sc[ci][2] = act ? pa[2] : -INFINITY; sc[ci][3] = act ? pa[3] : -INFINITY;
            sc[ci][4] = act ? pb[0] : -INFINITY; sc[ci][5] = act ? pb[1] : -INFINITY; sc[ci][6] = act ? pb[2] : -INFINITY; sc[ci][7] = act ? pb[3] : -INFINITY; }
        LDS_WAIT();
#pragma unroll
        for (int h = 0; h < 8; ++h) {
            float m = fmaxf(fmaxf(sc[0][h], sc[1][h]), fmaxf(sc[2][h], sc[3][h])); m = wave_max(m);
            float l = 0.f;
#pragma unroll
            for (int ci = 0; ci < 4; ++ci) { sc[ci][h] = exp2f(sc[ci][h] - m); l += sc[ci][h]; }
            l = wave_sum(l); const float il = 1.0f / l;
#pragma unroll
            for (int ci = 0; ci < 4; ++ci) sc[ci][h] *= il;
        }
#pragma unroll
        for (int ci = 0; ci < 4; ++ci) { LAS float* d = P + (ci * 64 + lane) * 8; *(LAS f32x4*)d = (f32x4){sc[ci][0], sc[ci][1], sc[ci][2], sc[ci][3]}; *(LAS f32x4*)(d + 4) = (f32x4){sc[ci][4], sc[ci][5], sc[ci][6], sc[ci][7]}; }
        LDS_WAIT();
        float o0[8], o1[8];
#pragma unroll
        for (int h = 0; h < 8; ++h) { o0[h] = 0.f; o1[h] = 0.f; }
#pragma unroll 4
        for (int j = 0; j < cnt; ++j) {
            const int s = list[j]; const unsigned v = *(const unsigned*)(CKV + ((size_t)b * SEQ + s) * 128 + 2 * lane);
            const f32x4 pa = *(const LAS f32x4*)(P + j * 8), pb = *(const LAS f32x4*)(P + j * 8 + 4); const float v0 = bflo(v), v1 = bfhi(v);
            o0[0] += pa[0] * v0; o1[0] += pa[0] * v1; o0[1] += pa[1] * v0; o1[1] += pa[1] * v1; o0[2] += pa[2] * v0; o1[2] += pa[2] * v1; o0[3] += pa[3] * v0; o1[3] += pa[3] * v1;
            o0[4] += pb[0] * v0; o1[4] += pb[0] * v1; o0[5] += pb[1] * v0; o1[5] += pb[1] * v1; o0[6] += pb[2] * v0; o1[6] += pb[2] * v1; o0[7] += pb[3] * v0; o1[7] += pb[3] * v1;
        }
#pragma unroll
        for (int h = 0; h < 8; ++h) *(unsigned*)(HX + (size_t)t * KOUT + h * 128 + 2 * lane) = pk2(o0[h], o1[h]);
        LDS_WAIT();
    }
}
__device__ __forceinline__ void p3_dilated_naive(Frame& F) {
    const bf16 *QB = wsp<bf16>(F, WS_QB), *KB = wsp<bf16>(F, WS_KB), *VB = wsp<bf16>(F, WS_VB); bf16* HX = wsp<bf16>(F, WS_HX);
    LAS float* qf = (LAS float*)(F.lds + F.wave * 16384);
    LAS float* P = (LAS float*)(F.lds + F.wave * 16384 + 256);
    const int lane = F.lane;
    for (int it = F.gw; it < T * 8; it += F.NGW) {
        const int t = it >> 3, h = it & 7, b = t >> 11, pos = t & (SEQ - 1);
        { const unsigned w = *(const unsigned*)(QB + (size_t)t * 512 + h * 64 + 2 * lane); if (lane < 32) { qf[2 * lane] = bflo(w); qf[2 * lane + 1] = bfhi(w); } }
        LDS_WAIT();
        float sc[7];
#pragma unroll
        for (int ch = 0; ch < 7; ++ch) {
            const int e = ch * 64 + lane, p = e / 129, rel = e - p * 129, dl = (p == 0) ? 1 : (p == 1) ? 4 : 16, tk = pos - dl * rel; const bool act = (e < 387) && (tk >= 0);
            const v4u* kp = (const v4u*)(KB + ((size_t)b * SEQ + (act ? tk : 0)) * 512 + h * 64);
            float d = 0.f;
#pragma unroll
            for (int i = 0; i < 8; ++i) { const v4u w = kp[i]; const f32x4 qa = *(const LAS f32x4*)(qf + 8 * i), qb = *(const LAS f32x4*)(qf + 8 * i + 4);
                d += qa[0] * bflo(w.x) + qa[1] * bfhi(w.x) + qa[2] * bflo(w.y) + qa[3] * bfhi(w.y) + qb[0] * bflo(w.z) + qb[1] * bfhi(w.z) + qb[2] * bflo(w.w) + qb[3] * bfhi(w.w); }
            sc[ch] = act ? d : -INFINITY;
        }
        float m = sc[0];
#pragma unroll
        for (int ch = 1; ch < 7; ++ch) m = fmaxf(m, sc[ch]);
        m = wave_max(m); float l = 0.f;
#pragma unroll
        for (int ch = 0; ch < 7; ++ch) { sc[ch] = exp2f(sc[ch] - m); l += sc[ch]; P[ch * 64 + lane] = sc[ch]; }
        l = wave_sum(l);
        LDS_WAIT();
        float o = 0.f;
        const bf16* vbase = VB + (size_t)b * SEQ * 512 + h * 64 + lane;
#pragma unroll
        for (int p = 0; p < 3; ++p) { const int dl = (p == 0) ? 1 : (p == 1) ? 4 : 16; int nrel = pos / dl + 1; if (nrel > 129) nrel = 129;
#pragma unroll 8
            for (int rel = 0; rel < nrel; ++rel) { const int tk = pos - dl * rel; o += P[p * 129 + rel] * __uint_as_float((unsigned)vbase[(size_t)tk * 512] << 16); } }
        HX[(size_t)t * KOUT + 1024 + h * 64 + lane] = (bf16)f2bf(o / l);
        LDS_WAIT();
    }
}
typedef short bf16x8 __attribute__((ext_vector_type(8)));
typedef float f32x16 __attribute__((ext_vector_type(16)));
typedef short v4i16_t __attribute__((ext_vector_type(4)));
typedef float f32x2_t __attribute__((ext_vector_type(2)));
typedef __bf16 bf16x2_t __attribute__((ext_vector_type(2)));
__device__ __forceinline__ unsigned cvtpk(float lo, float hi) { f32x2_t v = {lo, hi}; bf16x2_t b = __builtin_convertvector(v, bf16x2_t); return __builtin_bit_cast(unsigned, b); }
__device__ __forceinline__ int crow(int r, int hi) { return (r & 3) + 8 * (r >> 2) + 4 * hi; }
template <int NCH> __device__ __forceinline__ unsigned off_img(unsigned row, unsigned ch) { return (NCH * 128u) * (row >> 3) + 512u * (ch >> 2) + 64u * (row & 7) + 16u * ((ch & 3) ^ ((row >> 2) & 3)); }
template <int NCH> __device__ __forceinline__ unsigned rowread_addr(unsigned lane, unsigned s) { return off_img<NCH>(lane & 31, 2 * s + (lane >> 5)); }
template <int NCH> __device__ __forceinline__ unsigned trread_addr(unsigned lane, unsigned c, unsigned ks, unsigned t) {
    const unsigned h = lane >> 5, blk = (lane >> 4) & 1, q = (lane & 15) >> 2, p = lane & 3;
    return off_img<NCH>(16 * ks + 8 * t + 4 * h + q, 4 * c + 2 * blk + (p >> 1)) + 8 * (p & 1);
}
__device__ __forceinline__ bf16x8 trfrag(LAS unsigned char* p0, LAS unsigned char* p1) {
    const v4i16_t lo = __builtin_amdgcn_ds_read_tr16_b64_v4i16((LAS v4i16_t*)p0), hi = __builtin_amdgcn_ds_read_tr16_b64_v4i16((LAS v4i16_t*)p1);
    return (bf16x8){lo[0], lo[1], lo[2], lo[3], hi[0], hi[1], hi[2], hi[3]};
}
#define MFMA32(a, b, c) __builtin_amdgcn_mfma_f32_32x32x16_bf16((a), (b), (c), 0, 0, 0)
template <int NDT> __device__ __forceinline__ void softmax_tile(f32x16& S, float& m, float& l, f32x16 (&o)[NDT], bf16x8 (&pf)[2]) {
    float mt = fmaxf(fmaxf(fmaxf(S[0], S[1]), fmaxf(S[2], S[3])), fmaxf(fmaxf(S[4], S[5]), fmaxf(S[6], S[7])));
    mt = fmaxf(mt, fmaxf(fmaxf(fmaxf(S[8], S[9]), fmaxf(S[10], S[11])), fmaxf(fmaxf(S[12], S[13]), fmaxf(S[14], S[15]))));
    mt = fmaxf(mt, __shfl_xor(mt, 32));
    if (__any(mt > m)) {
        const float mn = fmaxf(m, mt), al = __builtin_amdgcn_exp2f(m - mn);
        l *= al; m = mn;
#pragma unroll
        for (int d = 0; d < NDT; ++d) o[d] = o[d] * al;
    }
    float s = 0.f;
#pragma unroll
    for (int r = 0; r < 16; ++r) { S[r] = __builtin_amdgcn_exp2f(S[r] - m); s += S[r]; }
    l += s;
    typedef unsigned u32x4_t __attribute__((ext_vector_type(4)));
    u32x4_t w0, w1;
    w0.x = cvtpk(S[0], S[1]); w0.y = cvtpk(S[2], S[3]); w0.z = cvtpk(S[4], S[5]); w0.w = cvtpk(S[6], S[7]);
    w1.x = cvtpk(S[8], S[9]); w1.y = cvtpk(S[10], S[11]); w1.z = cvtpk(S[12], S[13]); w1.w = cvtpk(S[14], S[15]);
    pf[0] = __builtin_bit_cast(bf16x8, w0); pf[1] = __builtin_bit_cast(bf16x8, w1);
}
__device__ __forceinline__ int unit_batch(int c, int ui) { return 4 * (c & 7) + (ui >> 1); }
__device__ __forceinline__ int unit_qtile(int c, int ui) { const int s = c >> 3; return (ui & 1) ? 63 - s : s; }

__device__ __forceinline__ void p3_dilated_mfma(Frame& F) {
    const bf16 *QB = wsp<bf16>(F, WS_QB), *KB = wsp<bf16>(F, WS_KB), *VB = wsp<bf16>(F, WS_VB); bf16* HX = wsp<bf16>(F, WS_HX);
    const int lane = F.lane, q = lane & 31, hi = lane >> 5, h = F.wave;
    LAS unsigned char* kimg = F.lds + F.wave * 16384; LAS unsigned char* vimg = kimg + 4096;
    const unsigned ra0 = rowread_addr<8>(lane, 0), ra1 = rowread_addr<8>(lane, 1);
    const unsigned ta0 = trread_addr<8>(lane, 0, 0, 0), ta1 = trread_addr<8>(lane, 0, 0, 1);
    unsigned wa[4]; int grow[4];
#pragma unroll
    for (int p = 0; p < 4; ++p) { const int e = lane + 64 * p; wa[p] = off_img<8>(e >> 3, e & 7); grow[p] = (e >> 3) * 512 + (e & 7) * 8; }
    float bfar[16], bmid[16];
#pragma unroll
    for (int r = 0; r < 16; ++r) { const int d0 = q - crow(r, hi); const bool m16 = (d0 & 15) == 0, m4 = (d0 & 3) == 0; bfar[r] = m16 ? 0.f : -INFINITY; bmid[r] = m16 ? 1.f : (m4 ? 0.f : -INFINITY); }
    for (int c = blockIdx.x; c < 256; c += gridDim.x) {
        for (int ui = 0; ui < 8; ++ui) {
            const int b = unit_batch(c, ui), j = unit_qtile(c, ui); const size_t tok0 = (size_t)b * SEQ + 32 * j;
            bf16x8 qf[4];
#pragma unroll
            for (int ks = 0; ks < 4; ++ks) qf[ks] = *(const bf16x8*)(QB + (tok0 + q) * 512 + h * 64 + 16 * ks + 8 * hi);
#pragma unroll
            for (int ks = 0; ks < 4; ++ks) asm volatile("" : "+v"(qf[ks]));
            f32x16 o[2]; o[0] = (f32x16){}; o[1] = (f32x16){};
            float m = -1e30f, l = 0.f;
            const bf16* kb = KB + (size_t)b * SEQ * 512 + h * 64; const bf16* vb = VB + (size_t)b * SEQ * 512 + h * 64;
            v4u kr[4], vr[4];
#pragma unroll
            for (int p = 0; p < 4; ++p) { kr[p] = *(const v4u*)(kb + grow[p]); vr[p] = *(const v4u*)(vb + grow[p]); }
            for (int i = 0; i <= j; ++i) {
#pragma unroll
                for (int p = 0; p < 4; ++p) { *(LAS v4u*)(kimg + wa[p]) = kr[p]; *(LAS v4u*)(vimg + wa[p]) = vr[p]; }
                if (i < j) {
#pragma unroll
                    for (int p = 0; p < 4; ++p) { kr[p] = *(const v4u*)(kb + (size_t)(i + 1) * 32 * 512 + grow[p]); vr[p] = *(const v4u*)(vb + (size_t)(i + 1) * 32 * 512 + grow[p]); }
                }
                f32x16 S = (f32x16){};
#pragma unroll
                for (int ks = 0; ks < 4; ++ks) { const bf16x8 kf = *(const LAS bf16x8*)(kimg + ((ks & 1) ? ra1 : ra0) + 512 * (ks >> 1)); S = MFMA32(kf, qf[ks], S); }
                const int dlt = 32 * (j - i);
                if (dlt > 512) {
#pragma unroll
                    for (int r = 0; r < 16; ++r) S[r] += bfar[r];
                } else if (dlt >= 192 && dlt < 512) {
#pragma unroll
                    for (int r = 0; r < 16; ++r) S[r] += bmid[r];
                } else {
#pragma unroll
                    for (int r = 0; r < 16; ++r) { const int df = dlt + q - crow(r, hi);
                        int w = (df <= 128 ? 1 : 0) + ((((df & 3) == 0) && df <= 512) ? 1 : 0) + (((df & 15) == 0) ? 1 : 0); if (df < 0) w = 0;
                        S[r] += (w == 0) ? -INFINITY : (w == 1) ? 0.f : (w == 2) ? 1.f : 1.5849625007211562f; }
                }
                bf16x8 pf[2];
                softmax_tile<2>(S, m, l, o, pf);
#pragma unroll
                for (int dt = 0; dt < 2; ++dt)
#pragma unroll
                    for (int ks = 0; ks < 2; ++ks) { const bf16x8 vf = trfrag(vimg + ta0 + 2048 * ks + 512 * dt, vimg + ta1 + 2048 * ks + 512 * dt); o[dt] = MFMA32(vf, pf[ks], o[dt]); }
            }
            l += __shfl_xor(l, 32); const float il = 1.0f / l;
            bf16* orow = HX + (tok0 + q) * KOUT + 1024 + h * 64 + 4 * hi;
#pragma unroll
            for (int dt = 0; dt < 2; ++dt)
#pragma unroll
                for (int g = 0; g < 4; ++g) { v2u w; w.x = cvtpk(o[dt][4 * g] * il, o[dt][4 * g + 1] * il); w.y = cvtpk(o[dt][4 * g + 2] * il, o[dt][4 * g + 3] * il); *(v2u*)(orow + 32 * dt + 8 * g) = w; }
        }
    }
}

__device__ __forceinline__ void p3_dsa_mfma(Frame& F) {
    const bf16 *QL = wsp<bf16>(F, WS_QL), *QR = wsp<bf16>(F, WS_QR), *CKV = wsp<bf16>(F, WS_CKV), *KR = wsp<bf16>(F, WS_KR); const unsigned* MASK = wsp<unsigned>(F, WS_MASK); bf16* HX = wsp<bf16>(F, WS_HX);
    const int lane = F.lane, q = lane & 31, hi = lane >> 5, h = F.wave;
    LAS unsigned char* cimg = F.lds + F.wave * 16384; LAS unsigned char* rimg = cimg + 8192;
    const unsigned ra0 = rowread_addr<16>(lane, 0), ra1 = rowread_addr<16>(lane, 1);
    const unsigned ta0 = trread_addr<16>(lane, 0, 0, 0), ta1 = trread_addr<16>(lane, 0, 0, 1);
    const unsigned rra = hi * 528 + q * 16;
    unsigned wc[8], wr[2];
#pragma unroll
    for (int p = 0; p < 8; ++p) { const int e = lane + 64 * p; wc[p] = off_img<16>(e >> 4, e & 15); }
#pragma unroll
    for (int p = 0; p < 2; ++p) { const int e = lane + 64 * p; wr[p] = (e & 3) * 528 + (e >> 2) * 16; }
    for (int c = blockIdx.x; c < 256; c += gridDim.x) {
        for (int ui = 0; ui < 8; ++ui) {
            const int b = unit_batch(c, ui), j = unit_qtile(c, ui); const size_t tok0 = (size_t)b * SEQ + 32 * j;
            bf16x8 qf[10];
#pragma unroll
            for (int ks = 0; ks < 8; ++ks) qf[ks] = *(const bf16x8*)(QL + (tok0 + q) * 1024 + h * 128 + 16 * ks + 8 * hi);
#pragma unroll
            for (int ks = 0; ks < 2; ++ks) qf[8 + ks] = *(const bf16x8*)(QR + (tok0 + q) * 256 + h * 32 + 16 * ks + 8 * hi);
#pragma unroll
            for (int ks = 0; ks < 10; ++ks) asm volatile("" : "+v"(qf[ks]));
            f32x16 o[4];
#pragma unroll
            for (int d = 0; d < 4; ++d) o[d] = (f32x16){};
            float m = -1e30f, l = 0.f;
            const bf16* cb = CKV + (size_t)b * SEQ * 128 + 8 * lane; const bf16* rb = KR + (size_t)b * SEQ * 32 + 8 * lane; const unsigned* mrow = MASK + (tok0 + q) * 64;
            v4u cr[8], rr[2]; unsigned mw = mrow[0];
#pragma unroll
            for (int p = 0; p < 8; ++p) cr[p] = *(const v4u*)(cb + 512 * p);
#pragma unroll
            for (int p = 0; p < 2; ++p) rr[p] = *(const v4u*)(rb + 512 * p);
            for (int i = 0; i <= j; ++i) {
#pragma unroll
                for (int p = 0; p < 8; ++p) *(LAS v4u*)(cimg + wc[p]) = cr[p];
#pragma unroll
                for (int p = 0; p < 2; ++p) *(LAS v4u*)(rimg + wr[p]) = rr[p];
                const unsigned mcur = mw >> (4 * hi);
                if (i < j) {
#pragma unroll
                    for (int p = 0; p < 8; ++p) cr[p] = *(const v4u*)(cb + (size_t)(i + 1) * 32 * 128 + 512 * p);
#pragma unroll
                    for (int p = 0; p < 2; ++p) rr[p] = *(const v4u*)(rb + (size_t)(i + 1) * 32 * 32 + 512 * p);
                    mw = mrow[i + 1];
                }
                f32x16 S = (f32x16){};
#pragma unroll
                for (int ks = 0; ks < 8; ++ks) { const bf16x8 kf = *(const LAS bf16x8*)(cimg + ((ks & 1) ? ra1 : ra0) + 512 * (ks >> 1)); S = MFMA32(kf, qf[ks], S); }
#pragma unroll
                for (int ks = 0; ks < 2; ++ks) { const bf16x8 kf = *(const LAS bf16x8*)(rimg + rra + 1056 * ks); S = MFMA32(kf, qf[8 + ks], S); }
#pragma unroll
                for (int r = 0; r < 16; ++r) S[r] = ((mcur >> ((r & 3) + 8 * (r >> 2))) & 1u) ? S[r] : -INFINITY;
                bf16x8 pf[2];
                softmax_tile<4>(S, m, l, o, pf);
#pragma unroll
                for (int dt = 0; dt < 4; ++dt)
#pragma unroll
                    for (int ks = 0; ks < 2; ++ks) { const bf16x8 vf = trfrag(cimg + ta0 + 4096 * ks + 512 * dt, cimg + ta1 + 4096 * ks + 512 * dt); o[dt] = MFMA32(vf, pf[ks], o[dt]); }
            }
            l += __shfl_xor(l, 32); const float il = 1.0f / l;
            bf16* orow = HX + (tok0 + q) * KOUT + h * 128 + 4 * hi;
#pragma unroll
            for (int dt = 0; dt < 4; ++dt)
#pragma unroll
                for (int g = 0; g < 4; ++g) { v2u w; w.x = cvtpk(o[dt][4 * g] * il, o[dt][4 * g + 1] * il); w.y = cvtpk(o[dt][4 * g + 2] * il, o[dt][4 * g + 3] * il); *(v2u*)(orow + 32 * dt + 8 * g) = w; }
        }
    }
}

__device__ __forceinline__ void p2_index_mfma(Frame& F) {
    const bf16 *QI = wsp<bf16>(F, WS_QI), *KI = wsp<bf16>(F, WS_KI); const float* WI = wsp<float>(F, WS_WI); unsigned* MASK = wsp<unsigned>(F, WS_MASK);
    unsigned* SC = wsp<unsigned>(F, WS_HX) + (size_t)blockIdx.x * (32 * 2048);
    const int lane = F.lane, q = lane & 31, hi = lane >> 5, w = F.wave;
    LAS unsigned char* kimg = F.lds + F.wave * 16384;
    LAS unsigned long long* lm = (LAS unsigned long long*)(kimg + 8192);
    const unsigned rra = hi * 528 + q * 16;
    unsigned wa[4];
#pragma unroll
    for (int p = 0; p < 4; ++p) { const int e = lane + 64 * p; wa[p] = (e & 7) * 528 + (e >> 3) * 16; }
    for (int c = blockIdx.x; c < 256; c += gridDim.x) {
        for (int ui = 0; ui < 8; ++ui) {
            const int b = unit_batch(c, ui), j = unit_qtile(c, ui); const size_t tok0 = (size_t)b * SEQ + 32 * j; const int qpos = 32 * j + q;
            for (int rep_ = 0; rep_ < ((DUP_MASK & 128) ? 2 : 1); ++rep_)
            if (w <= j) {
                const f32x4 wva = *(const f32x4*)(WI + (tok0 + q) * 8), wvb = *(const f32x4*)(WI + (tok0 + q) * 8 + 4);
                const float wq[8] = {wva[0], wva[1], wva[2], wva[3], wvb[0], wvb[1], wvb[2], wvb[3]};
                const bf16* kb = KI + (size_t)b * SEQ * 64 + 8 * lane;
#pragma unroll
                for (int hp = 0; hp < 2; ++hp) {
                    bf16x8 qf[4][4];
#pragma unroll
                    for (int hh = 0; hh < 4; ++hh)
#pragma unroll
                        for (int ks = 0; ks < 4; ++ks) qf[hh][ks] = *(const bf16x8*)(QI + (tok0 + q) * 512 + (4 * hp + hh) * 64 + 16 * ks + 8 * hi);
#pragma unroll
                    for (int hh = 0; hh < 4; ++hh)
#pragma unroll
                        for (int ks = 0; ks < 4; ++ks) asm volatile("" : "+v"(qf[hh][ks]));
                    v4u kr[4];
#pragma unroll
                    for (int p = 0; p < 4; ++p) kr[p] = *(const v4u*)(kb + (size_t)w * 32 * 64 + 512 * p);
                    f32x4 pvn[4];
#pragma unroll
                    for (int g = 0; g < 4; ++g) pvn[g] = (hp == 1) ? *(const f32x4*)(SC + (size_t)q * 2048 + 32 * w + 4 * hi + 8 * g) : (f32x4){0.f, 0.f, 0.f, 0.f};
                    for (int i = w; i <= j; i += 8) {
#pragma unroll
                        for (int p = 0; p < 4; ++p) *(LAS v4u*)(kimg + wa[p]) = kr[p];
                        if (i + 8 <= j) {
#pragma unroll
                            for (int p = 0; p < 4; ++p) kr[p] = *(const v4u*)(kb + (size_t)(i + 8) * 32 * 64 + 512 * p);
                        }
                        unsigned* srow = SC + (size_t)q * 2048 + 32 * i + 4 * hi;
                        f32x16 idx = (f32x16){};
                        if (hp == 1) {
#pragma unroll
                            for (int g = 0; g < 4; ++g) { idx[4 * g] = pvn[g][0]; idx[4 * g + 1] = pvn[g][1]; idx[4 * g + 2] = pvn[g][2]; idx[4 * g + 3] = pvn[g][3]; }
                            if (i + 8 <= j) {
#pragma unroll
                                for (int g = 0; g < 4; ++g) pvn[g] = *(const f32x4*)(srow + 256 + 8 * g);
                            }
                        }
#pragma unroll
                        for (int hh = 0; hh < 4; ++hh) {
                            f32x16 S = (f32x16){};
#pragma unroll
                            for (int ks = 0; ks < 4; ++ks) { const bf16x8 kf = *(const LAS bf16x8*)(kimg + rra + 1056 * ks); S = MFMA32(kf, qf[hh][ks], S); }
#pragma unroll
                            for (int r = 0; r < 16; ++r) idx[r] = fmaf(fmaxf(S[r], 0.f), wq[4 * hp + hh], idx[r]);
                            __builtin_amdgcn_sched_barrier(0);
                        }
                        if (hp == 0) {
#pragma unroll
                            for (int g = 0; g < 4; ++g) *(f32x4*)(srow + 8 * g) = (f32x4){idx[4 * g], idx[4 * g + 1], idx[4 * g + 2], idx[4 * g + 3]};
                        } else {
#pragma unroll
                            for (int g = 0; g < 4; ++g) { v4u kv;
#pragma unroll
                                for (int e = 0; e < 4; ++e) { const int s = 32 * i + 8 * g + 4 * hi + e; unsigned ord = __float_as_uint(idx[4 * g + e]); ord ^= (ord >> 31) ? 0xFFFFFFFFu : 0x80000000u;
                                    kv[e] = (s <= qpos) ? ((ord & 0xFFFFF800u) | (unsigned)(SEQ - 1 - s)) : 0u; }
                                *(v4u*)(srow + 8 * g) = kv; }
                        }
                    }
                }
            }
            __syncthreads();
#pragma unroll 1
            for (int n4 = 0; n4 < ((DUP_MASK & 256) ? 8 : 4); ++n4) {
                const int n = n4 & 3;
                const int qq = 4 * w + n, qp = 32 * j + qq, nr = (qp >> 6) + 1; const size_t t = tok0 + qq;
                unsigned key[32];
#pragma unroll
                for (int r = 0; r < 32; ++r) { const unsigned v = SC[(size_t)qq * 2048 + r * 64 + lane]; key[r] = (r * 64 + lane <= qp) ? v : 0u; }
                unsigned thr = 1u;
                if (qp >= 256) {
                    unsigned lo = 0u;
#pragma unroll 1
                    for (int bit = 31; bit >= 0; --bit) {
                        const unsigned cand = lo | (1u << bit); int cnt = 0;
#pragma unroll
                        for (int g = 0; g < 8; ++g) if (4 * g < nr) {
                            cnt += __popcll(__ballot(key[4 * g] >= cand)) + __popcll(__ballot(key[4 * g + 1] >= cand)); cnt += __popcll(__ballot(key[4 * g + 2] >= cand)) + __popcll(__ballot(key[4 * g + 3] >= cand)); }
                        if (cnt >= 256) lo = cand;
                        if (cnt == 256) break;
                    }
                    thr = lo;
                }
#pragma unroll
                for (int r = 0; r < 32; ++r) { const unsigned long long bm = __ballot(key[r] >= thr && key[r] != 0u); if (lane == 0) lm[r] = bm; if ((r & 3) == 3) __builtin_amdgcn_sched_barrier(0); }
                LDS_WAIT();
                const unsigned long long mine = lm[lane & 31];
                if (lane < 32) *(unsigned long long*)(MASK + t * 64 + 2 * lane) = mine;
                LDS_WAIT();
            }
            __syncthreads();
        }
    }
}

__device__ __forceinline__ void p3_dsa_mfma2(Frame& F) {
    const bf16 *QL = wsp<bf16>(F, WS_QL), *QR = wsp<bf16>(F, WS_QR), *CKV = wsp<bf16>(F, WS_CKV), *KR = wsp<bf16>(F, WS_KR); const unsigned* MASK = wsp<unsigned>(F, WS_MASK); bf16* HX = wsp<bf16>(F, WS_HX);
    const int lane = F.lane, q = lane & 31, hi = lane >> 5, h = F.wave, tid = F.tid;
    constexpr int BUFB = 10496;
    const unsigned ra0 = rowread_addr<16>(lane, 0), ra1 = rowread_addr<16>(lane, 1);
    const unsigned ta0 = trread_addr<16>(lane, 0, 0, 0), ta1 = trread_addr<16>(lane, 0, 0, 1);
    const unsigned rra = 8192 + hi * 528 + q * 16;
    const unsigned wcs = off_img<16>(tid >> 4, tid & 15), wrs = 8192 + (tid & 3) * 528 + ((tid >> 2) & 31) * 16;
    const bool rl = tid < 128;
    for (int c = blockIdx.x; c < 256; c += gridDim.x) {
        for (int ui = 0; ui < 8; ++ui) {
            const int b = unit_batch(c, ui), j = unit_qtile(c, ui); const size_t tok0 = (size_t)b * SEQ + 32 * j;
            bf16x8 qf[10];
#pragma unroll
            for (int ks = 0; ks < 8; ++ks) qf[ks] = *(const bf16x8*)(QL + (tok0 + q) * 1024 + h * 128 + 16 * ks + 8 * hi);
#pragma unroll
            for (int ks = 0; ks < 2; ++ks) qf[8 + ks] = *(const bf16x8*)(QR + (tok0 + q) * 256 + h * 32 + 16 * ks + 8 * hi);
#pragma unroll
            for (int ks = 0; ks < 10; ++ks) asm volatile("" : "+v"(qf[ks]));
            f32x16 o[4];
#pragma unroll
            for (int d = 0; d < 4; ++d) o[d] = (f32x16){};
            float m = -1e30f, l = 0.f;
            const bf16* cb = CKV + (size_t)b * SEQ * 128 + 8 * tid; const bf16* rb = KR + (size_t)b * SEQ * 32 + 8 * (tid & 127); const unsigned* mrow = MASK + (tok0 + q) * 64;
            v4u cr = *(const v4u*)cb, rr = *(const v4u*)rb; unsigned mw = mrow[0], mwn = 0u;
            *(LAS v4u*)(F.lds + wcs) = cr; if (rl) *(LAS v4u*)(F.lds + wrs) = rr;
            __syncthreads();
            for (int i = 0; i <= j; ++i) {
                LAS unsigned char* cur = F.lds + (i & 1) * BUFB;
                if (i < j) { cr = *(const v4u*)(cb + (size_t)(i + 1) * 32 * 128); rr = *(const v4u*)(rb + (size_t)(i + 1) * 32 * 32); mwn = mrow[i + 1]; }
                f32x16 S = (f32x16){};
#pragma unroll
                for (int ks = 0; ks < 8; ++ks) { const bf16x8 kf = *(const LAS bf16x8*)(cur + ((ks & 1) ? ra1 : ra0) + 512 * (ks >> 1)); S = MFMA32(kf, qf[ks], S); }
#pragma unroll
                for (int ks = 0; ks < 2; ++ks) { const bf16x8 kf = *(const LAS bf16x8*)(cur + rra + 1056 * ks); S = MFMA32(kf, qf[8 + ks], S); }
                const unsigned mcur = mw >> (4 * hi);
#pragma unroll
                for (int r = 0; r < 16; ++r) S[r] = ((mcur >> ((r & 3) + 8 * (r >> 2))) & 1u) ? S[r] : -INFINITY;
                bf16x8 pf[2];
                softmax_tile<4>(S, m, l, o, pf);
#pragma unroll
                for (int dt = 0; dt < 4; ++dt)
#pragma unroll
                    for (int ks = 0; ks < 2; ++ks) { const bf16x8 vf = trfrag(cur + ta0 + 4096 * ks + 512 * dt, cur + ta1 + 4096 * ks + 512 * dt); o[dt] = MFMA32(vf, pf[ks], o[dt]); }
                if (i < j) { LAS unsigned char* nxt = F.lds + ((i + 1) & 1) * BUFB; *(LAS v4u*)(nxt + wcs) = cr; if (rl) *(LAS v4u*)(nxt + wrs) = rr; mw = mwn; }
                __syncthreads();
            }
            l += __shfl_xor(l, 32); const float il = 1.0f / l;
            bf16* orow = HX + (tok0 + q) * KOUT + h * 128 + 4 * hi;
#pragma unroll
            for (int dt = 0; dt < 4; ++dt)
#pragma unroll
                for (int g = 0; g < 4; ++g) { v2u w; w.x = cvtpk(o[dt][4 * g] * il, o[dt][4 * g + 1] * il); w.y = cvtpk(o[dt][4 * g + 2] * il, o[dt][4 * g + 3] * il); *(v2u*)(orow + 32 * dt + 8 * g) = w; }
        }
    }
}

__device__ __forceinline__ void p3_dsa_mfma3(Frame& F) {
    const bf16 *QL = wsp<bf16>(F, WS_QL), *QR = wsp<bf16>(F, WS_QR), *CKV = wsp<bf16>(F, WS_CKV), *KR = wsp<bf16>(F, WS_KR); const unsigned* MASK = wsp<unsigned>(F, WS_MASK); bf16* HX = wsp<bf16>(F, WS_HX);
    const int lane = F.lane, q = lane & 31, hi = lane >> 5, h = F.wave, tid = F.tid;
    constexpr int BUFB = 10496;
    const unsigned ra0 = rowread_addr<16>(lane, 0), ra1 = rowread_addr<16>(lane, 1);
    const unsigned ta0 = trread_addr<16>(lane, 0, 0, 0), ta1 = trread_addr<16>(lane, 0, 0, 1);
    const unsigned rra = 8192 + hi * 528 + q * 16;
    const unsigned wcs = off_img<16>(tid >> 4, tid & 15), wrs = 8192 + (tid & 3) * 528 + ((tid >> 2) & 31) * 16;
    const bool rl = tid < 128;
#define DSA_QK(Sv, buf) do { Sv = (f32x16){}; \
        _Pragma("unroll") for (int ks = 0; ks < 8; ++ks) { const bf16x8 kf = *(const LAS bf16x8*)((buf) + ((ks & 1) ? ra1 : ra0) + 512 * (ks >> 1)); Sv = MFMA32(kf, qf[ks], Sv); } \
        _Pragma("unroll") for (int ks = 0; ks < 2; ++ks) { const bf16x8 kf = *(const LAS bf16x8*)((buf) + rra + 1056 * ks); Sv = MFMA32(kf, qf[8 + ks], Sv); } } while (0)
    for (int c = blockIdx.x; c < 256; c += gridDim.x) {
        for (int ui = 0; ui < 8; ++ui) {
            const int b = unit_batch(c, ui), j = unit_qtile(c, ui); const size_t tok0 = (size_t)b * SEQ + 32 * j;
            bf16x8 qf[10];
#pragma unroll
            for (int ks = 0; ks < 8; ++ks) qf[ks] = *(const bf16x8*)(QL + (tok0 + q) * 1024 + h * 128 + 16 * ks + 8 * hi);
#pragma unroll
            for (int ks = 0; ks < 2; ++ks) qf[8 + ks] = *(const bf16x8*)(QR + (tok0 + q) * 256 + h * 32 + 16 * ks + 8 * hi);
            f32x16 o[4];
#pragma unroll
            for (int d = 0; d < 4; ++d) o[d] = (f32x16){};
            float m = -1e30f, l = 0.f;
            const bf16* cb = CKV + (size_t)b * SEQ * 128 + 8 * tid; const bf16* rb = KR + (size_t)b * SEQ * 32 + 8 * (tid & 127); const unsigned* mrow = MASK + (tok0 + q) * 64;
            { const v4u c0 = *(const v4u*)cb, r0 = *(const v4u*)rb; *(LAS v4u*)(F.lds + wcs) = c0; if (rl) *(LAS v4u*)(F.lds + wrs) = r0; }
            if (j >= 1) { const v4u c1 = *(const v4u*)(cb + 32 * 128), r1 = *(const v4u*)(rb + 32 * 32); *(LAS v4u*)(F.lds + BUFB + wcs) = c1; if (rl) *(LAS v4u*)(F.lds + BUFB + wrs) = r1; }
            unsigned mw = mrow[0], mwn = 0u;
#pragma unroll
            for (int ks = 0; ks < 10; ++ks) asm volatile("" : "+v"(qf[ks]));
            __syncthreads();
            f32x16 Sn; DSA_QK(Sn, F.lds);
            int bi = 0;
            for (int i = 0; i <= j; ++i) {
                const int b1 = (bi == 2) ? 0 : bi + 1, b2 = (b1 == 2) ? 0 : b1 + 1;
                LAS unsigned char* cur = F.lds + bi * BUFB;
                v4u cr, rr;
                if (i + 2 <= j) { cr = *(const v4u*)(cb + (size_t)(i + 2) * 32 * 128); rr = *(const v4u*)(rb + (size_t)(i + 2) * 32 * 32); }
                if (i < j) mwn = mrow[i + 1];
                f32x16 S = Sn;
                if (i < j) DSA_QK(Sn, F.lds + b1 * BUFB);
                const unsigned mcur = mw >> (4 * hi);
#pragma unroll
                for (int r = 0; r < 16; ++r) S[r] = ((mcur >> ((r & 3) + 8 * (r >> 2))) & 1u) ? S[r] : -INFINITY;
                bf16x8 pf[2];
                softmax_tile<4>(S, m, l, o, pf);
#pragma unroll
                for (int dt = 0; dt < 4; ++dt)
#pragma unroll
                    for (int ks = 0; ks < 2; ++ks) { const bf16x8 vf = trfrag(cur + ta0 + 4096 * ks + 512 * dt, cur + ta1 + 4096 * ks + 512 * dt); o[dt] = MFMA32(vf, pf[ks], o[dt]); }
                if (i + 2 <= j) { LAS unsigned char* nx = F.lds + b2 * BUFB; *(LAS v4u*)(nx + wcs) = cr; if (rl) *(LAS v4u*)(nx + wrs) = rr; }
                mw = mwn; bi = b1;
                __syncthreads();
            }
            l += __shfl_xor(l, 32); const float il = 1.0f / l;
            bf16* orow = HX + (tok0 + q) * KOUT + h * 128 + 4 * hi;
#pragma unroll
            for (int dt = 0; dt < 4; ++dt)
#pragma unroll
                for (int g = 0; g < 4; ++g) { v2u w; w.x = cvtpk(o[dt][4 * g] * il, o[dt][4 * g + 1] * il); w.y = cvtpk(o[dt][4 * g + 2] * il, o[dt][4 * g + 3] * il); *(v2u*)(orow + 32 * dt + 8 * g) = w; }
        }
    }
#undef DSA_QK
}

__device__ __forceinline__ float fmax3(float a, float b, float c) { float r; asm("v_max3_f32 %0, %1, %2, %3" : "=v"(r) : "v"(a), "v"(b), "v"(c)); return r; }
template <int NDT> __device__ __forceinline__ void softmax_tile_m(f32x16& S, float mt, float& m, float& l, f32x16 (&o)[NDT], bf16x8 (&pf)[2]) {
    if (__any(mt > m)) {
        const float mn = fmaxf(m, mt), al = __builtin_amdgcn_exp2f(m - mn);
        l *= al; m = mn;
#pragma unroll
        for (int d = 0; d < NDT; ++d) o[d] = o[d] * al;
    }
    float s = 0.f;
#pragma unroll
    for (int r = 0; r < 16; ++r) { S[r] = __builtin_amdgcn_exp2f(S[r] - m); s += S[r]; }
    l += s;
    typedef unsigned u32x4_t __attribute__((ext_vector_type(4)));
    u32x4_t w0, w1;
    w0.x = cvtpk(S[0], S[1]); w0.y = cvtpk(S[2], S[3]); w0.z = cvtpk(S[4], S[5]); w0.w = cvtpk(S[6], S[7]);
    w1.x = cvtpk(S[8], S[9]); w1.y = cvtpk(S[10], S[11]); w1.z = cvtpk(S[12], S[13]); w1.w = cvtpk(S[14], S[15]);
    pf[0] = __builtin_bit_cast(bf16x8, w0); pf[1] = __builtin_bit_cast(bf16x8, w1);
}
__device__ __forceinline__ void p3_dsa_mfma4(Frame& F) {
    const bf16 *QL = wsp<bf16>(F, WS_QL), *QR = wsp<bf16>(F, WS_QR), *CKV = wsp<bf16>(F, WS_CKV), *KR = wsp<bf16>(F, WS_KR); const unsigned* MASK = wsp<unsigned>(F, WS_MASK); bf16* HX = wsp<bf16>(F, WS_HX);
    const int lane = F.lane, q = lane & 31, hi = lane >> 5, h = F.wave, tid = F.tid;
    constexpr int BUFB = 10496;
    const unsigned ra0 = rowread_addr<16>(lane, 0), ra1 = rowread_addr<16>(lane, 1);
    const unsigned ta0 = trread_addr<16>(lane, 0, 0, 0), ta1 = trread_addr<16>(lane, 0, 0, 1);
    const unsigned rra = 8192 + hi * 528 + q * 16;
    const unsigned wcs = off_img<16>(tid >> 4, tid & 15), wrs = 8192 + (tid & 3) * 528 + ((tid >> 2) & 31) * 16;
    const bool rl = tid < 128;
#define DSA_QK(Sv, buf) do { Sv = (f32x16){}; \
        _Pragma("unroll") for (int ks = 0; ks < 8; ++ks) { const bf16x8 kf = *(const LAS bf16x8*)((buf) + ((ks & 1) ? ra1 : ra0) + 512 * (ks >> 1)); Sv = MFMA32(kf, qf[ks], Sv); } \
        _Pragma("unroll") for (int ks = 0; ks < 2; ++ks) { const bf16x8 kf = *(const LAS bf16x8*)((buf) + rra + 1056 * ks); Sv = MFMA32(kf, qf[8 + ks], Sv); } } while (0)
    for (int c = blockIdx.x; c < 256; c += gridDim.x) {
        for (int ui = 0; ui < 8; ++ui) {
            const int b = unit_batch(c, ui), j = unit_qtile(c, ui); const size_t tok0 = (size_t)b * SEQ + 32 * j;
            bf16x8 qf[10];
#pragma unroll
            for (int ks = 0; ks < 8; ++ks) qf[ks] = *(const bf16x8*)(QL + (tok0 + q) * 1024 + h * 128 + 16 * ks + 8 * hi);
#pragma unroll
            for (int ks = 0; ks < 2; ++ks) qf[8 + ks] = *(const bf16x8*)(QR + (tok0 + q) * 256 + h * 32 + 16 * ks + 8 * hi);
            f32x16 o[4];
#pragma unroll
            for (int d = 0; d < 4; ++d) o[d] = (f32x16){};
            float m = -1e30f, l = 0.f;
            const bf16* cb = CKV + (size_t)b * SEQ * 128 + 8 * tid; const bf16* rb = KR + (size_t)b * SEQ * 32 + 8 * (tid & 127); const unsigned* mrow = MASK + (tok0 + q) * 64;
            { const v4u c0 = *(const v4u*)cb, r0 = *(const v4u*)rb; *(LAS v4u*)(F.lds + wcs) = c0; if (rl) *(LAS v4u*)(F.lds + wrs) = r0; }
            if (j >= 1) { const v4u c1 = *(const v4u*)(cb + 32 * 128), r1 = *(const v4u*)(rb + 32 * 32); *(LAS v4u*)(F.lds + BUFB + wcs) = c1; if (rl) *(LAS v4u*)(F.lds + BUFB + wrs) = r1; }
            unsigned mw = mrow[0], mwn = 0u;
#pragma unroll
            for (int ks = 0; ks < 10; ++ks) asm volatile("" : "+v"(qf[ks]));
            __syncthreads();
            f32x16 Sn; DSA_QK(Sn, F.lds);
            int bi = 0;
            for (int i = 0; i <= j; ++i) {
                const int b1 = (bi == 2) ? 0 : bi + 1, b2 = (b1 == 2) ? 0 : b1 + 1;
                LAS unsigned char* cur = F.lds + bi * BUFB;
                const int i2 = (i + 2 <= j) ? i + 2 : j, i1 = (i < j) ? i + 1 : j;
                const v4u cr = *(const v4u*)(cb + (size_t)i2 * 32 * 128), rr = *(const v4u*)(rb + (size_t)i2 * 32 * 32);
                mwn = mrow[i1];
                f32x16 S = Sn;
                const unsigned mcur = mw >> (4 * hi);
#pragma unroll
                for (int r = 0; r < 16; ++r) S[r] = ((mcur >> ((r & 3) + 8 * (r >> 2))) & 1u) ? S[r] : -INFINITY;
                float mt = fmax3(fmax3(S[0], S[1], S[2]), fmax3(S[3], S[4], S[5]), fmax3(S[6], S[7], S[8]));
                mt = fmax3(mt, fmax3(S[9], S[10], S[11]), fmax3(S[12], S[13], fmax3(S[14], S[15], S[15])));
                DSA_QK(Sn, F.lds + b1 * BUFB);
                { auto rrx = __builtin_amdgcn_permlane32_swap(__float_as_uint(mt), __float_as_uint(mt), false, false); mt = fmax3(__uint_as_float(rrx[0]), __uint_as_float(rrx[1]), mt); }
                bf16x8 pf[2];
                softmax_tile_m<4>(S, mt, m, l, o, pf);
#pragma unroll
                for (int dt = 0; dt < 4; ++dt)
#pragma unroll
                    for (int ks = 0; ks < 2; ++ks) { const bf16x8 vf = trfrag(cur + ta0 + 4096 * ks + 512 * dt, cur + ta1 + 4096 * ks + 512 * dt); o[dt] = MFMA32(vf, pf[ks], o[dt]); }
                { LAS unsigned char* nx = F.lds + b2 * BUFB; *(LAS v4u*)(nx + wcs) = cr; if (rl) *(LAS v4u*)(nx + wrs) = rr; }
                mw = mwn; bi = b1;
                __syncthreads();
            }
            l += __shfl_xor(l, 32); const float il = 1.0f / l;
            bf16* orow = HX + (tok0 + q) * KOUT + h * 128 + 4 * hi;
#pragma unroll
            for (int dt = 0; dt < 4; ++dt)
#pragma unroll
                for (int g = 0; g < 4; ++g) { v2u w; w.x = cvtpk(o[dt][4 * g] * il, o[dt][4 * g + 1] * il); w.y = cvtpk(o[dt][4 * g + 2] * il, o[dt][4 * g + 3] * il); *(v2u*)(orow + 32 * dt + 8 * g) = w; }
        }
    }
#undef DSA_QK
}

__device__ __forceinline__ void p3_dsa_mfma5(Frame& F) {
    const bf16 *QL = wsp<bf16>(F, WS_QL), *QR = wsp<bf16>(F, WS_QR), *CKV = wsp<bf16>(F, WS_CKV), *KR = wsp<bf16>(F, WS_KR); const unsigned* MASK = wsp<unsigned>(F, WS_MASK); bf16* HX = wsp<bf16>(F, WS_HX);
    const int lane = F.lane, q = lane & 31, hi = lane >> 5, h = F.wave, tid = F.tid;
    constexpr int BUFB = 10496;
    const unsigned ra0 = rowread_addr<16>(lane, 0), ra1 = rowread_addr<16>(lane, 1);
    const unsigned ta0 = trread_addr<16>(lane, 0, 0, 0), ta1 = trread_addr<16>(lane, 0, 0, 1);
    const unsigned rra = 8192 + hi * 528 + q * 16;
    const unsigned wcs = off_img<16>(tid >> 4, tid & 15), wrs = 8192 + (tid & 3) * 528 + ((tid >> 2) & 31) * 16;
    const bool rl = tid < 128;
#define DSA_QK(Sv, buf) do { Sv = (f32x16){}; \
        _Pragma("unroll") for (int ks = 0; ks < 8; ++ks) { const bf16x8 kf = *(const LAS bf16x8*)((buf) + ((ks & 1) ? ra1 : ra0) + 512 * (ks >> 1)); Sv = MFMA32(kf, qf[ks], Sv); } \
        _Pragma("unroll") for (int ks = 0; ks < 2; ++ks) { const bf16x8 kf = *(const LAS bf16x8*)((buf) + rra + 1056 * ks); Sv = MFMA32(kf, qf[8 + ks], Sv); } } while (0)
#define DSA_LD(cv, rv, t) do { const int t_ = ((t) <= j) ? (t) : j; cv = *(const v4u*)(cb + (size_t)t_ * 32 * 128); rv = *(const v4u*)(rb + (size_t)t_ * 32 * 32); } while (0)
#define DSA_TILE(i, cw, rw, cl, rl_) do { \
        const int b1 = (bi == 2) ? 0 : bi + 1, b2 = (b1 == 2) ? 0 : b1 + 1; \
        LAS unsigned char* cur = F.lds + bi * BUFB; \
        DSA_LD(cl, rl_, (i) + 3); \
        const unsigned mw2 = mrow[((i) + 2 <= j) ? (i) + 2 : j]; \
        f32x16 S = Sn; \
        const unsigned mcur = mw >> (4 * hi); \
        _Pragma("unroll") for (int r = 0; r < 16; ++r) S[r] = ((mcur >> ((r & 3) + 8 * (r >> 2))) & 1u) ? S[r] : -INFINITY; \
        float mt = fmax3(fmax3(S[0], S[1], S[2]), fmax3(S[3], S[4], S[5]), fmax3(S[6], S[7], S[8])); \
        mt = fmax3(mt, fmax3(S[9], S[10], S[11]), fmax3(S[12], S[13], fmax3(S[14], S[15], S[15]))); \
        DSA_QK(Sn, F.lds + b1 * BUFB); \
        { auto rrx = __builtin_amdgcn_permlane32_swap(__float_as_uint(mt), __float_as_uint(mt), false, false); mt = fmax3(__uint_as_float(rrx[0]), __uint_as_float(rrx[1]), mt); } \
        bf16x8 pf[2]; \
        softmax_tile_m<4>(S, mt, m, l, o, pf); \
        _Pragma("unroll") for (int dt = 0; dt < 4; ++dt) \
            _Pragma("unroll") for (int ks = 0; ks < 2; ++ks) { const bf16x8 vf = trfrag(cur + ta0 + 4096 * ks + 512 * dt, cur + ta1 + 4096 * ks + 512 * dt); o[dt] = MFMA32(vf, pf[ks], o[dt]); } \
        { LAS unsigned char* nx = F.lds + b2 * BUFB; *(LAS v4u*)(nx + wcs) = cw; if (rl) *(LAS v4u*)(nx + wrs) = rw; } \
        mw = mw1; mw1 = mw2; bi = b1; \
        asm volatile("s_waitcnt lgkmcnt(0)" ::: "memory"); __builtin_amdgcn_s_barrier(); asm volatile("" ::: "memory"); } while (0)
    for (int c = blockIdx.x; c < 256; c += gridDim.x) {
        for (int ui = 0; ui < 8; ++ui) {
            const int b = unit_batch(c, ui), j = unit_qtile(c, ui); const size_t tok0 = (size_t)b * SEQ + 32 * j;
            bf16x8 qf[10];
#pragma unroll
            for (int ks = 0; ks < 8; ++ks) qf[ks] = *(const bf16x8*)(QL + (tok0 + q) * 1024 + h * 128 + 16 * ks + 8 * hi);
#pragma unroll
            for (int ks = 0; ks < 2; ++ks) qf[8 + ks] = *(const bf16x8*)(QR + (tok0 + q) * 256 + h * 32 + 16 * ks + 8 * hi);
            f32x16 o[4];
#pragma unroll
            for (int d = 0; d < 4; ++d) o[d] = (f32x16){};
            float m = -1e30f, l = 0.f;
            const bf16* cb = CKV + (size_t)b * SEQ * 128 + 8 * tid; const bf16* rb = KR + (size_t)b * SEQ * 32 + 8 * (tid & 127); const unsigned* mrow = MASK + (tok0 + q) * 64;
            v4u cA, rA, cB, rB;
            { v4u c0, r0, c1, r1; DSA_LD(c0, r0, 0); DSA_LD(c1, r1, 1); DSA_LD(cA, rA, 2);
              *(LAS v4u*)(F.lds + wcs) = c0; if (rl) *(LAS v4u*)(F.lds + wrs) = r0; *(LAS v4u*)(F.lds + BUFB + wcs) = c1; if (rl) *(LAS v4u*)(F.lds + BUFB + wrs) = r1; }
            unsigned mw = mrow[0], mw1 = mrow[(1 <= j) ? 1 : j];
#pragma unroll
            for (int ks = 0; ks < 10; ++ks) asm volatile("" : "+v"(qf[ks]));
            asm volatile("s_waitcnt lgkmcnt(0)" ::: "memory"); __builtin_amdgcn_s_barrier(); asm volatile("" ::: "memory");
            f32x16 Sn; DSA_QK(Sn, F.lds);
            int bi = 0;
            for (int i = 0; i <= j; i += 2) {
                DSA_TILE(i, cA, rA, cB, rB);
                if (i + 1 <= j) DSA_TILE(i + 1, cB, rB, cA, rA);
            }
            l += __shfl_xor(l, 32); const float il = 1.0f / l;
            bf16* orow = HX + (tok0 + q) * KOUT + h * 128 + 4 * hi;
#pragma unroll
            for (int dt = 0; dt < 4; ++dt)
#pragma unroll
                for (int g = 0; g < 4; ++g) { v2u w; w.x = cvtpk(o[dt][4 * g] * il, o[dt][4 * g + 1] * il); w.y = cvtpk(o[dt][4 * g + 2] * il, o[dt][4 * g + 3] * il); *(v2u*)(orow + 32 * dt + 8 * g) = w; }
            asm volatile("s_waitcnt lgkmcnt(0)" ::: "memory"); __builtin_amdgcn_s_barrier(); asm volatile("" ::: "memory");
        }
    }
#undef DSA_QK
#undef DSA_LD
#undef DSA_TILE
}
__device__ __forceinline__ void p6_cross_naive(Frame& F) {
    const bf16 *QC = wsp<bf16>(F, WS_QC), *KVC = wsp<bf16>(F, WS_KVC); bf16* OC = wsp<bf16>(F, WS_OC);
    LAS float* qf = (LAS float*)(F.lds + F.wave * 16384);
    LAS float* P = (LAS float*)(F.lds + F.wave * 16384 + 1024);
    const int lane = F.lane;
    for (int it = F.gw; it < T * 4; it += F.NGW) {
        const int t = it >> 2, h = it & 3, b = t >> 11;
        { const v2u w = *(const v2u*)(QC + (size_t)t * 1024 + h * 256 + 4 * lane); *(LAS f32x4*)(qf + 4 * lane) = (f32x4){bflo(w.x), bfhi(w.x), bflo(w.y), bfhi(w.y)}; }
        LDS_WAIT();
        float sc[4];
#pragma unroll
        for (int ch = 0; ch < 4; ++ch) {
            const v4u* kp = (const v4u*)(KVC + ((size_t)b * MEMT + ch * 64 + lane) * 2048 + h * 256);
            float d = 0.f;
#pragma unroll 8
            for (int i = 0; i < 32; ++i) { const v4u w = kp[i]; const f32x4 qa = *(const LAS f32x4*)(qf + 8 * i), qb = *(const LAS f32x4*)(qf + 8 * i + 4);
                d += qa[0] * bflo(w.x) + qa[1] * bfhi(w.x) + qa[2] * bflo(w.y) + qa[3] * bfhi(w.y) + qb[0] * bflo(w.z) + qb[1] * bfhi(w.z) + qb[2] * bflo(w.w) + qb[3] * bfhi(w.w); }
            sc[ch] = d;
        }
        float m = wave_max(fmaxf(fmaxf(sc[0], sc[1]), fmaxf(sc[2], sc[3]))); float l = 0.f;
#pragma unroll
        for (int ch = 0; ch < 4; ++ch) { sc[ch] = exp2f(sc[ch] - m); l += sc[ch]; P[ch * 64 + lane] = sc[ch]; }
        l = wave_sum(l); const float il = 1.0f / l;
        LDS_WAIT();
        float o0 = 0.f, o1 = 0.f, o2 = 0.f, o3 = 0.f;
        const bf16* vb = KVC + (size_t)b * MEMT * 2048 + 1024 + h * 256 + 4 * lane;
#pragma unroll 8
        for (int j = 0; j < MEMT; ++j) { const v2u w = *(const v2u*)(vb + (size_t)j * 2048); const float p = P[j]; o0 += p * bflo(w.x); o1 += p * bfhi(w.x); o2 += p * bflo(w.y); o3 += p * bfhi(w.y); }
        v2u ow; ow.x = pk2(o0 * il, o1 * il); ow.y = pk2(o2 * il, o3 * il);
        *(v2u*)(OC + (size_t)t * 1024 + h * 256 + 4 * lane) = ow;
        LDS_WAIT();
    }
}
__device__ __forceinline__ void p10_final(Frame& F) {
    const float* parts = wsp<float>(F, WS_P3); const float* g = inp(F, 16); const bf16* XB = wsp<bf16>(F, WS_XB);
    f32x4 gv[4];
#pragma unroll
    for (int j = 0; j < 4; ++j) gv[j] = *((const f32x4*)g + F.lane + 64 * j);
    for (int r0 = F.gw; r0 < T; r0 += 4 * F.NGW) {
        v2u w[4][4]; float rs[4];
#pragma unroll
        for (int u = 0; u < 4; ++u) { const int r = r0 + u * F.NGW; const v2u* xi = (const v2u*)(XB + (size_t)r * DM) + F.lane;
#pragma unroll
            for (int j = 0; j < 4; ++j) w[u][j] = xi[64 * j];
            rs[u] = rstd_from_parts(parts, r); }
#pragma unroll
        for (int u = 0; u < 4; ++u) { const int r = r0 + u * F.NGW; f32x4* o = (f32x4*)(outp(F) + (size_t)r * DM) + F.lane;
#pragma unroll
            for (int j = 0; j < 4; ++j) o[64 * j] = (f32x4){bflo(w[u][j].x), bfhi(w[u][j].x), bflo(w[u][j].y), bfhi(w[u][j].y)} * rs[u] * gv[j]; }
    }
}

#define RLX_AGENT __ATOMIC_RELAXED, __HIP_MEMORY_SCOPE_AGENT
#define XB_TMO      128
#define XB_XCNT(j)  (256  + 64 * (j))
#define XB_XSUB(j)  (1280 + 64 * (j))
#define XB_XGEN(j)  (2304 + 64 * (j))
#define XB_TOP      3328
#define XB_TOPGEN   3392
#define XCD_BAR_WORDS 3456
#define XB_SPIN_CAP (1u << 18)

__device__ __forceinline__ unsigned xb_ld(unsigned* p)              { return __hip_atomic_load(p, __ATOMIC_RELAXED, __HIP_MEMORY_SCOPE_AGENT); }
__device__ __forceinline__ unsigned xb_add(unsigned* p, unsigned v) { return __hip_atomic_fetch_add(p, v, __ATOMIC_RELAXED, __HIP_MEMORY_SCOPE_AGENT); }
__device__ __forceinline__ unsigned xb_xcc_id() { return (unsigned)__builtin_amdgcn_s_getreg((3 << 11) | 20) & 0xFu; }
#define XB_SPIN(cond, bar) do { unsigned _sp = 0; while (cond) { __builtin_amdgcn_s_sleep(1); \
    if ((++_sp & 255u) == 0u) { if (xb_ld(&(bar)[XB_TMO])) break; if (_sp > XB_SPIN_CAP) { atomicAdd(&(bar)[XB_TMO], 1u); break; } } } } while (0)

struct XcdBarrier {
    unsigned* bar; unsigned x;
    volatile LAS unsigned* st;
};

__device__ __forceinline__ XcdBarrier xcd_barrier_post(unsigned* bar, volatile LAS unsigned* st) {
    XcdBarrier b; b.bar = bar; b.x = xb_xcc_id(); b.st = st;
    if (threadIdx.x == 0) (void)xb_add(&bar[XB_XCNT(b.x)], 1u);
    return b;
}
__device__ __forceinline__ void xcd_barrier_complete(unsigned* bar, unsigned x, unsigned& nloc, unsigned& nx) {
    const unsigned G = gridDim.x * gridDim.y * gridDim.z;
    unsigned sum, cnt, mine, sp = 0u;
    for (;;) {
        sum = 0u; cnt = 0u; mine = 0u;
#pragma unroll
        for (unsigned j = 0; j < 16; ++j) { const unsigned c = xb_ld(&bar[XB_XCNT(j)]); sum += c; cnt += (c > 0u) ? 1u : 0u; mine = (j == x) ? c : mine; }
        if (sum == G) break;
        __builtin_amdgcn_s_sleep(1);
        if ((++sp & 255u) == 0u) { if (xb_ld(&bar[XB_TMO])) break; if (sp > XB_SPIN_CAP) { atomicAdd(&bar[XB_TMO], 1u); break; } }
    }
    nloc = mine > 0u ? mine : 1u; nx = cnt > 0u ? cnt : 1u;
}

__device__ __forceinline__ void xcd_barrier(const XcdBarrier& b, const bool t0) {
    asm volatile("s_waitcnt vmcnt(0)" ::: "memory");
    __syncthreads();
    if (t0) {
        unsigned* bar = b.bar;
        __builtin_amdgcn_s_waitcnt(0);
        unsigned nloc = b.st[0], nx = b.st[1];
        if (nloc == 0u) { xcd_barrier_complete(bar, b.x, nloc, nx); b.st[0] = nloc; b.st[1] = nx; }
        const unsigned old = xb_add(&bar[XB_XSUB(b.x)], 1u);
        const unsigned gen = old / nloc;
        if (old + 1u == (gen + 1u) * nloc) {
            __builtin_amdgcn_fence(__ATOMIC_RELEASE, "agent");
            asm volatile("s_waitcnt vmcnt(0)" ::: "memory");
            const unsigned og = xb_add(&bar[XB_TOP], 1u);
            const unsigned tg = og / nx;
            if (og + 1u == (tg + 1u) * nx) xb_add(&bar[XB_TOPGEN], 1u);
            else XB_SPIN(xb_ld(&bar[XB_TOPGEN]) == tg, bar);
            __builtin_amdgcn_fence(__ATOMIC_ACQUIRE, "agent");
            xb_add(&bar[XB_XGEN(b.x)], 1u);
            asm volatile("s_waitcnt vmcnt(0)" ::: "memory");
        } else {
            XB_SPIN(xb_ld(&bar[XB_XGEN(b.x)]) == gen, bar);
            __builtin_amdgcn_fence(__ATOMIC_ACQUIRE, "agent");
            asm volatile("s_waitcnt vmcnt(0)" ::: "memory");
        }
    }
    __syncthreads();
}

struct Args { const float* in[17]; float* out; unsigned char* ws; int ph_lo, ph_hi; };
__global__ void __launch_bounds__(NWAVES * 64, 2) fwd_kernel(Args args) {
    extern __shared__ __attribute__((aligned(16))) unsigned char lds[];
    cg::grid_group grid = cg::this_grid();
    Frame F;
    F.lds = (LAS unsigned char*)lds;
    F.kargs = (const __attribute__((address_space(4))) char*)__builtin_amdgcn_kernarg_segment_ptr();
    F.out = args.out; F.ws = args.ws; F.wave_s = __builtin_amdgcn_readfirstlane((int)threadIdx.x >> 6); phase_ctx(F);
    volatile LAS unsigned* MISC = (volatile LAS unsigned*)(F.lds + 131072 + 64);
    if (threadIdx.x < 16) MISC[threadIdx.x] = 0u;
    __syncthreads();
    XcdBarrier bar = xcd_barrier_post((unsigned*)(args.ws + WS_CTL) + 1024, MISC + 8);
    const int lo = args.ph_lo, hi = args.ph_hi;
    if (hi < 0) grid.sync();
#define IN(k) (((PH_MASK >> (k)) & 1) && lo <= (k) && (k) < hi)
#define SEAM(k) do { if (IN(k) && IN((k) + 1)) { phase_ctx(F); xcd_barrier(bar, F.tid == 0); } phase_ctx(F); } while (0)
    LAS unsigned char* ring = (LAS unsigned char*)lds;

    if (IN(0)) { p0_prologue(F); if (DUP_MASK & 1) p0_prologue(F); }
    SEAM(0);
    if (IN(1)) for (int rep_ = 0; rep_ < ((DUP_MASK & 2) ? 2 : 1); ++rep_) {
        { pg8::Gemm g{wsp<bf16>(F, WS_XB), wsp<bf16>(F, WS_WIN), T, NIN, DM, DM, DM}; pg8::StaticOrder S; S.init(g, F.G, (int)blockIdx.x);
          EpiInProj E{wsp<float>(F, WS_RSTD1), wsp<float>(F, WS_TAB64), wsp<float>(F, WS_TAB32), wsp<bf16>(F, WS_QL), wsp<bf16>(F, WS_QR), wsp<bf16>(F, WS_KR), wsp<bf16>(F, WS_KI), wsp<bf16>(F, WS_QI), wsp<bf16>(F, WS_QB), wsp<bf16>(F, WS_KB), wsp<bf16>(F, WS_VB), wsp<float>(F, WS_CKVF), wsp<float>(F, WS_WI)};
          pg8::gemm_phase<EpiInProj, pg8::StaticOrder, true, true>(ring, g, S, E, F.wave); }
        { pg8::Gemm g{wsp<bf16>(F, WS_MEMB), wsp<bf16>(F, WS_WKV), TM, 2048, DM, DM, DM};
          KvOrder S{F.G, (int)blockIdx.x, (const char*)wsp<bf16>(F, WS_MEMB), (const char*)wsp<bf16>(F, WS_WKV)};
          EpiKv E{wsp<bf16>(F, WS_KVC), wsp<bf16>(F, WS_KVC) + (size_t)TM * DM, wsp<float>(F, WS_RSTDM)};
          pg8::gemm_phase<EpiKv, KvOrder, true, true>(ring, g, S, E, F.wave); }
    }
    SEAM(1);
    if (IN(2)) { p2_ckv_norm(F); p2_index_mfma(F); if (DUP_MASK & 4) { __syncthreads(); p2_index_mfma(F); } }
    SEAM(2);
    if (IN(3)) { p3_dsa_mfma5(F); if (DUP_MASK & 8) p3_dsa_mfma5(F); p3_dilated_mfma(F); if (DUP_MASK & 16) p3_dilated_mfma(F); }
    SEAM(3);
    if (IN(4)) {
        pg8::Gemm g{wsp<bf16>(F, WS_HX), wsp<bf16>(F, WS_WOUT), T, DM, KOUT, KOUT, KOUT}; pg8::StaticOrder S; S.init(g, F.G, (int)blockIdx.x);
        EpiResid E{wsp<bf16>(F, WS_XB), wsp<float>(F, WS_P1)};
        pg8::gemm_phase<EpiResid, pg8::StaticOrder, true, true>(ring, g, S, E, F.wave);
    }
    SEAM(4);
    if (IN(5)) for (int rep_ = 0; rep_ < ((DUP_MASK & 32) ? 2 : 1); ++rep_) {
        pg8::Gemm g{wsp<bf16>(F, WS_XB), wsp<bf16>(F, WS_WQ), T, DM, DM, DM, DM}; pg8::StaticOrder S; S.init(g, F.G, (int)blockIdx.x);
        EpiRowScale<0> E{wsp<bf16>(F, WS_QC), DM, nullptr, wsp<float>(F, WS_P1), SCALE_C};
        pg8::gemm_phase<EpiRowScale<0>, pg8::StaticOrder, true, true>(ring, g, S, E, F.wave);
    }
    SEAM(5);
    if (IN(6)) {
        { pg8::Gemm g{wsp<bf16>(F, WS_QC), wsp<bf16>(F, WS_KVC), T, 256, 256, DM, DM};
          CrossOrder S{F.G, (int)blockIdx.x, (const char*)wsp<bf16>(F, WS_QC), (const char*)wsp<bf16>(F, WS_KVC), (size_t)MEMT * DM * 2, (size_t)256 * 2};
          EpiSoftmaxP E{wsp<bf16>(F, WS_QC), (LAS float*)(F.lds + 131072 + 1024)};
          pg8::gemm_phase<EpiSoftmaxP, CrossOrder, true, true>(ring, g, S, E, F.wave); }
        phase_ctx(F); xcd_barrier(bar, F.tid == 0); phase_ctx(F);
        { pg8::Gemm g{wsp<bf16>(F, WS_QC), wsp<bf16>(F, WS_KVC) + (size_t)TM * DM, T, 256, 256, DM, TM};
          CrossOrder S{F.G, (int)blockIdx.x, (const char*)wsp<bf16>(F, WS_QC), (const char*)(wsp<bf16>(F, WS_KVC) + (size_t)TM * DM), (size_t)MEMT * 2, (size_t)256 * TM * 2};
          EpiRowScale<2> E{wsp<bf16>(F, WS_OC), DM, nullptr, nullptr, 1.0f};
          pg8::gemm_phase<EpiRowScale<2>, CrossOrder, true, true>(ring, g, S, E, F.wave); }
    }
    SEAM(6);
    if (IN(7)) {
        pg8::Gemm g{wsp<bf16>(F, WS_OC), wsp<bf16>(F, WS_WO), T, DM, DM, DM, DM}; pg8::StaticOrder S; S.init(g, F.G, (int)blockIdx.x);
        EpiResid E{wsp<bf16>(F, WS_XB), wsp<float>(F, WS_P2)};
        pg8::gemm_phase<EpiResid, pg8::StaticOrder, true, true>(ring, g, S, E, F.wave);
    }
    SEAM(7);
    if (IN(8)) for (int rep_ = 0; rep_ < ((DUP_MASK & 64) ? 2 : 1); ++rep_) {
        pg8::Gemm g{wsp<bf16>(F, WS_XB), wsp<bf16>(F, WS_WUP), T, FF, DM, DM, DM}; pg8::StaticOrder S; S.init(g, F.G, (int)blockIdx.x);
        EpiRowScale<1> E{wsp<bf16>(F, WS_HID), FF, nullptr, wsp<float>(F, WS_P2), 1.0f};
        pg8::gemm_phase<EpiRowScale<1>, pg8::StaticOrder, true, true>(ring, g, S, E, F.wave);
    }
    SEAM(8);
    if (IN(9)) {
        pg8::Gemm g{wsp<bf16>(F, WS_HID), wsp<bf16>(F, WS_WDN), T, DM, FF, FF, FF}; pg8::StaticOrder S; S.init(g, F.G, (int)blockIdx.x);
        EpiResid E{wsp<bf16>(F, WS_XB), wsp<float>(F, WS_P3)};
        pg8::gemm_phase<EpiResid, pg8::StaticOrder, true, true>(ring, g, S, E, F.wave);
    }
    SEAM(9);
    if (IN(10)) { p10_final(F); }
#undef IN
#undef SEAM
}

#ifndef N_LAUNCH_SPLIT
#define N_LAUNCH_SPLIT 0
#endif
extern "C" void kernel_launch(void* const* d_in, const int* in_sizes, int n_in, void* d_out, int out_size, void* d_ws, size_t ws_size, hipStream_t stream) {
    static int grid = 0;
    if (grid == 0) {
        if (n_in != 17 || out_size != T * DM || ws_size < WS_END) { fprintf(stderr, "kernel_launch: unexpected shapes: n_in %d out %d ws %zu\n", n_in, out_size, ws_size); grid = -1; return; }
        int dev = 0, cus = 0, per_cu = 0;
        if (hipGetDevice(&dev) != hipSuccess || hipDeviceGetAttribute(&cus, hipDeviceAttributeMultiprocessorCount, dev) != hipSuccess) { grid = -1; return; }
        if (hipFuncSetAttribute((const void*)fwd_kernel, hipFuncAttributeMaxDynamicSharedMemorySize, LDS_BYTES) != hipSuccess) { fprintf(stderr, "hipFuncSetAttribute failed\n"); grid = -1; return; }
        if (hipOccupancyMaxActiveBlocksPerMultiprocessor(&per_cu, (const void*)fwd_kernel, NWAVES * 64, LDS_BYTES) != hipSuccess || per_cu < 1) { fprintf(stderr, "occupancy query: %d\n", per_cu); per_cu = 1; }
        (void)hipGetLastError();
        grid = cus;
        fprintf(stderr, "kernel_launch: cus %d per_cu %d grid %d ws %zu\n", cus, per_cu, grid, ws_size);
    }
    if (grid < 0) return;
    if (hipMemsetAsync((char*)d_ws + WS_CTL, 0, 65536, stream) != hipSuccess) { fprintf(stderr, "memset failed\n"); return; }
    Args a{};
    for (int i = 0; i < 17; ++i) a.in[i] = (const float*)d_in[i];
    a.out = (float*)d_out; a.ws = (unsigned char*)d_ws;
#if N_LAUNCH_SPLIT
    for (int p = 0; p < 11; ++p) { a.ph_lo = p; a.ph_hi = p + 1; void* kargs[] = {&a};
        hipError_t e = hipLaunchCooperativeKernel((const void*)fwd_kernel, dim3(grid), dim3(NWAVES * 64), kargs, LDS_BYTES, stream);
        if (e != hipSuccess) { fprintf(stderr, "launch %d failed: %s\n", p, hipGetErrorString(e)); break; } }
#else
    a.ph_lo = 0; a.ph_hi = 11; void* kargs[] = {&a};
    hipError_t e = hipLaunchCooperativeKernel((const void*)fwd_kernel, dim3(grid), dim3(NWAVES * 64), kargs, LDS_BYTES, stream);
    if (e != hipSuccess) fprintf(stderr, "cooperative launch failed: %s (grid %d)\n", hipGetErrorString(e), grid);
#endif
}
```

```cpp
#include <hip/hip_runtime.h>
#include <hip/hip_cooperative_groups.h>
#include <cstdio>
#include <cstdint>
namespace cg = cooperative_groups;
namespace pg8 {
#define PG8_LAS __attribute__((address_space(3)))
typedef unsigned short bf16_t;
typedef short bf16x8 __attribute__((ext_vector_type(8)));
typedef float f32x4 __attribute__((ext_vector_type(4)));
typedef unsigned u32x4 __attribute__((ext_vector_type(4)));
constexpr int BM = 256, BK = 64, HALF = 128, HTB = HALF * BK * 2  , STAGE_BYTES = 8 * HTB, NXCD = 8, WGM = 8;

__host__ __device__ __forceinline__ int lds_byte(int r, int c) { const int st = (r >> 4) * 2 + (c >> 5), rr = r & 15, cc = c & 31, ob = rr * 64 + cc * 2; return st * 1024 + (ob ^ (((ob >> 9) & 1) << 5)); }
__host__ __device__ __forceinline__ void stage_rc(int b, int& R, int& C) { const int st = b / 1024, sb = b % 1024, swz = sb ^ (((sb >> 9) & 1) << 5); R = (st >> 1) * 16 + swz / 64; C = (st & 1) * 32 + (swz % 64) / 2; }
__host__ __device__ __forceinline__ int perm32(int rho) { const int n = rho >> 4, i = rho & 15; return 8 * (i >> 2) + 4 * n + (i & 3); }

struct Unit { int pm, pn; const char* pa; const char* pb; };
struct Gemm { const bf16_t* A; const bf16_t* Bt; int M, N, K, lda, ldb; };

struct StaticOrder {
    int nM, nN, nwg, G, c; const char* A; const char* B; size_t ta, tb;
    __host__ __device__ void init(const Gemm& g, int G_, int c_) { nM = g.M / BM; nN = g.N / BM; nwg = nM * nN; G = G_; c = c_; A = (const char*)g.A; B = (const char*)g.Bt; ta = (size_t)BM * g.lda * 2; tb = (size_t)BM * g.ldb * 2; }
    __host__ __device__ bool next(int i, Unit& u) const {
        const long L = (long)i * G + c; if (L >= nwg) return false;
        int wgid = (int)L; { const int q = nwg / NXCD, r = nwg % NXCD, xcd = wgid % NXCD, off = wgid / NXCD; wgid = (xcd < r ? xcd * (q + 1) : r * (q + 1) + (xcd - r) * q) + off; }
        const int nig = WGM * nN, gid = wgid / nig, fm = gid * WGM, gsz = (nM - fm) < WGM ? (nM - fm) : WGM;
        u.pm = fm + ((wgid % nig) % gsz); u.pn = (wgid % nig) / gsz; u.pa = A + (size_t)u.pm * ta; u.pb = B + (size_t)u.pn * tb; return true;
    }
    __device__ __forceinline__ void a_ready(const Unit&) const {}
    __device__ __forceinline__ void done(const Unit&) const {}
};


template <class Epi, class Sched, bool ALIGN_EPI = false, bool SP2 = false>
__device__ __forceinline__ void gemm_phase(PG8_LAS unsigned char* lds, const Gemm g, const Sched& S, const Epi& E, int wave_id) {
    unsigned ones_ = ~0u; asm volatile("" : "+s"(ones_));
    int tid_ = wave_id * 64 + (int)__builtin_amdgcn_mbcnt_hi(ones_, __builtin_amdgcn_mbcnt_lo(ones_, 0u)); asm volatile("" : "+v"(tid_));
    const int tid = tid_, wid = __builtin_amdgcn_readfirstlane(tid >> 6), lane = tid & 63, wr = wid >> 2, wc = wid & 3, fr = lane & 15, fq = lane >> 4;
    const int K = g.K, nt = K / BK;
    unsigned voffA[2], voffB[2];
#pragma unroll
    for (int i = 0; i < 2; ++i) { int R, C; stage_rc(tid * 16 + i * 8192, R, C); const int Rb = Epi::PERM ? ((R & ~31) + perm32(R & 31)) : R;
        voffA[i] = (unsigned)(R * g.lda + C) * 2u; voffB[i] = (unsigned)(Rb * g.ldb + C) * 2u; }
    const size_t kstep = (size_t)(BK * 2);
    const size_t hstepA = (size_t)HALF * g.lda * 2, hstepB = (size_t)HALF * g.ldb * 2;
    const unsigned ldsw = (unsigned)wid * 1024u;
    const int aoff = lds_byte(wr * 64 + fr, fq * 8), boff = lds_byte(wc * 32 + fr, fq * 8);
#define PG8_SA(b, h) (((b) * 2 + (h)) * HTB)
#define PG8_SB(b, h) ((4 + (b) * 2 + (h)) * HTB)
#define PG8_STAGE(bufoff, gbase, voff) do { _Pragma("unroll") for (int _i = 0; _i < 2; ++_i) \
        __builtin_amdgcn_global_load_lds((const unsigned*)((const char*)(gbase) + (voff)[_i]), (PG8_LAS unsigned*)(lds + (bufoff) + ldsw + _i * 8192), 16, 0, 0); } while (0)
#define PG8_LDA(dst, b, h) do { _Pragma("unroll") for (int m = 0; m < 4; ++m) _Pragma("unroll") for (int k = 0; k < 2; ++k) dst[m][k] = *(const PG8_LAS bf16x8*)(lds + PG8_SA(b, h) + aoff + m * 2048 + k * 1024); } while (0)
#define PG8_LDB(dst, b, h) do { _Pragma("unroll") for (int n = 0; n < 2; ++n) _Pragma("unroll") for (int k = 0; k < 2; ++k) dst[n][k] = *(const PG8_LAS bf16x8*)(lds + PG8_SB(b, h) + boff + n * 2048 + k * 1024); } while (0)
#define PG8_MMA(ai, bj, At, Bt) do { __builtin_amdgcn_s_setprio(1); _Pragma("unroll") for (int m = 0; m < 4; ++m) _Pragma("unroll") for (int n = 0; n < 2; ++n) _Pragma("unroll") for (int k = 0; k < 2; ++k) \
        acc[ai][bj][m][n] = __builtin_amdgcn_mfma_f32_16x16x32_bf16(Bt[n][k], At[m][k], acc[ai][bj][m][n], 0, 0, 0); __builtin_amdgcn_s_setprio(0); } while (0)
#define PG8_WAIT_V(n) asm volatile("s_waitcnt vmcnt(" #n ")" ::: "memory")
#define PG8_WAIT_L(n) asm volatile("s_waitcnt lgkmcnt(" #n ")" ::: "memory")
#define PG8_BAR __builtin_amdgcn_s_barrier()
#define PG8_SCHED __builtin_amdgcn_sched_barrier(0)
    Unit cur, nxt; int ui = 0;
    if (!S.next(0, cur)) return;
    f32x4 acc[2][2][4][2];
#pragma unroll
    for (int a = 0; a < 2; ++a)
#pragma unroll
        for (int b = 0; b < 2; ++b)
#pragma unroll
            for (int m = 0; m < 4; ++m)
#pragma unroll
                for (int n = 0; n < 2; ++n) acc[a][b][m][n] = (f32x4){0.f, 0.f, 0.f, 0.f};
    bf16x8 At[4][2], B0[2][2], B1[2][2];
    const char* cA = cur.pa; const char* cB = cur.pb;
    S.a_ready(cur);
    if constexpr (SP2) {
        PG8_STAGE(PG8_SB(0, 0), cB, voffB); PG8_STAGE(PG8_SB(0, 1), cB + hstepB, voffB); PG8_STAGE(PG8_SA(0, 0), cA, voffA); PG8_STAGE(PG8_SA(0, 1), cA + hstepA, voffA);
        if (wr == 1) PG8_BAR;
        PG8_WAIT_V(2); PG8_BAR;
        PG8_STAGE(PG8_SB(1, 0), cB + kstep, voffB); PG8_STAGE(PG8_SA(1, 0), cA + kstep, voffA); PG8_STAGE(PG8_SB(1, 1), cB + hstepB + kstep, voffB);
        PG8_WAIT_V(6); PG8_BAR;
    } else {
        PG8_STAGE(PG8_SB(0, 0), cB, voffB); PG8_STAGE(PG8_SA(0, 0), cA, voffA); PG8_STAGE(PG8_SB(0, 1), cB + hstepB, voffB); PG8_STAGE(PG8_SA(0, 1), cA + hstepA, voffA);
        if (wr == 1) PG8_BAR;
        PG8_WAIT_V(4); PG8_BAR;
        PG8_STAGE(PG8_SB(1, 0), cB + kstep, voffB); PG8_STAGE(PG8_SA(1, 0), cA + kstep, voffA); PG8_STAGE(PG8_SB(1, 1), cB + hstepB + kstep, voffB);
        PG8_WAIT_V(6); PG8_BAR;
    }
    for (;;) {
        const bool has_next = S.next(ui + 1, nxt);
        const char* nA = has_next ? nxt.pa : cA; const char* nB = has_next ? nxt.pb : cB;
        for (int t = 0; t < nt; t += 2) {
            const bool last = (t == nt - 2);
            const char* a1 = cA + (size_t)(t + 1) * kstep;
            const char* a2 = last ? nA : cA + (size_t)(t + 2) * kstep; const char* b2 = last ? nB : cB + (size_t)(t + 2) * kstep;
            const char* a3 = a2 + kstep; const char* b3 = b2 + kstep;
            if (last && has_next) S.a_ready(nxt);
            if constexpr (SP2) {
            PG8_LDB(B0, 0, 0); PG8_LDB(B1, 0, 1); PG8_SCHED; PG8_LDA(At, 0, 0); PG8_STAGE(PG8_SA(1, 1), a1 + hstepA, voffA);
            PG8_WAIT_V(8); PG8_WAIT_L(0); PG8_BAR; PG8_MMA(0, 0, At, B0); PG8_MMA(0, 1, At, B1); PG8_BAR; PG8_SCHED;
            PG8_LDA(At, 0, 1); PG8_STAGE(PG8_SB(0, 0), b2, voffB); PG8_STAGE(PG8_SB(0, 1), b2 + hstepB, voffB); PG8_STAGE(PG8_SA(0, 0), a2, voffA);
            PG8_WAIT_V(8); PG8_WAIT_L(0); PG8_BAR; PG8_MMA(1, 0, At, B0); PG8_MMA(1, 1, At, B1); PG8_BAR; PG8_SCHED;
            PG8_LDB(B0, 1, 0); PG8_LDB(B1, 1, 1); PG8_SCHED; PG8_LDA(At, 1, 0); PG8_STAGE(PG8_SA(0, 1), a2 + hstepA, voffA);
            PG8_WAIT_V(8); PG8_WAIT_L(0); PG8_BAR; PG8_MMA(0, 0, At, B0); PG8_MMA(0, 1, At, B1); PG8_BAR; PG8_SCHED;
            PG8_LDA(At, 1, 1); PG8_STAGE(PG8_SB(1, 0), b3, voffB); PG8_STAGE(PG8_SB(1, 1), b3 + hstepB, voffB); PG8_STAGE(PG8_SA(1, 0), a3, voffA);
            PG8_WAIT_V(8); PG8_WAIT_L(0); PG8_BAR; PG8_MMA(1, 0, At, B0); PG8_MMA(1, 1, At, B1); PG8_BAR; PG8_SCHED;
            } else {
            PG8_LDB(B0, 0, 0); PG8_SCHED; PG8_LDA(At, 0, 0); PG8_STAGE(PG8_SA(1, 1), a1 + hstepA, voffA);
            PG8_WAIT_L(8); PG8_BAR; PG8_WAIT_L(0); PG8_MMA(0, 0, At, B0); PG8_BAR; PG8_SCHED;
            PG8_LDB(B1, 0, 1); PG8_STAGE(PG8_SB(0, 0), b2, voffB);
            PG8_BAR; PG8_WAIT_L(0); PG8_MMA(0, 1, At, B1); PG8_BAR;
            PG8_LDA(At, 0, 1); PG8_STAGE(PG8_SA(0, 0), a2, voffA);
            PG8_BAR; PG8_WAIT_L(0); PG8_MMA(1, 0, At, B0); PG8_BAR; PG8_SCHED;
            PG8_STAGE(PG8_SB(0, 1), b2 + hstepB, voffB);
            PG8_WAIT_V(6); PG8_BAR; PG8_MMA(1, 1, At, B1); PG8_BAR;
            PG8_LDB(B0, 1, 0); PG8_SCHED; PG8_LDA(At, 1, 0); PG8_STAGE(PG8_SA(0, 1), a2 + hstepA, voffA);
            PG8_WAIT_L(8); PG8_BAR; PG8_WAIT_L(0); PG8_MMA(0, 0, At, B0); PG8_BAR; PG8_SCHED;
            PG8_LDB(B1, 1, 1); PG8_STAGE(PG8_SB(1, 0), b3, voffB);
            PG8_BAR; PG8_WAIT_L(0); PG8_MMA(0, 1, At, B1); PG8_BAR;
            PG8_LDA(At, 1, 1); PG8_STAGE(PG8_SA(1, 0), a3, voffA);
            PG8_BAR; PG8_WAIT_L(0); PG8_MMA(1, 0, At, B0); PG8_BAR; PG8_SCHED;
            PG8_STAGE(PG8_SB(1, 1), b3 + hstepB, voffB);
            PG8_WAIT_V(6); PG8_BAR; PG8_MMA(1, 1, At, B1); PG8_BAR;
            }
        }
        if constexpr (ALIGN_EPI) { if (wr == 0) PG8_BAR; }
        if constexpr (!Epi::AFTER_DRAIN) { E(acc, cur, wr, wc, fr, fq); S.done(cur); }
        if (!has_next) break;
#pragma unroll
        for (int a = 0; a < 2; ++a)
#pragma unroll
            for (int b = 0; b < 2; ++b)
#pragma unroll
                for (int m = 0; m < 4; ++m)
#pragma unroll
                    for (int n = 0; n < 2; ++n) acc[a][b][m][n] = (f32x4){0.f, 0.f, 0.f, 0.f};
        cur = nxt; cA = nA; cB = nB; ++ui;
        if constexpr (ALIGN_EPI) { if (wr == 1) PG8_BAR; }
    }
    PG8_WAIT_V(0);
    if constexpr (!ALIGN_EPI) { if (wr == 0) PG8_BAR; }
    PG8_BAR;
    if constexpr (Epi::AFTER_DRAIN) { E.fused(acc, cur, wr, wc, fr, fq, lds, wid, lane); S.done(cur); }
#undef PG8_SA
#undef PG8_SB
#undef PG8_STAGE
#undef PG8_LDA
#undef PG8_LDB
#undef PG8_MMA
#undef PG8_WAIT_V
#undef PG8_WAIT_L
#undef PG8_BAR
#undef PG8_SCHED
}
}


#ifndef PH_MASK
#define PH_MASK 0x7ff
#endif
#ifndef DUP_MASK
#define DUP_MASK 0
#endif

constexpr int NB = 32, SEQ = 2048, DM = 1024, T = NB * SEQ, MEMT = 256, TM = NB * MEMT, FF = 4096;
constexpr int NIN = 3072;
constexpr int KOUT = 1024;
constexpr int W_IN_COLS = 3048;
constexpr float EPS = 1e-6f, LOG2E = 1.4426950408889634f;
constexpr float SCALE_A = 0.10206207261596577f * LOG2E;
constexpr float SCALE_B = 0.125f * LOG2E;
constexpr float SCALE_C = 0.0625f * LOG2E;
constexpr float IDX_W = 0.044194173824159216f;
constexpr int NWAVES = 8;

constexpr size_t MiB = 1u << 20;
constexpr size_t WS_CTL = 0, WS_TAB64 = 1 * MiB, WS_TAB32 = 1 * MiB + 512 * 1024, WS_RSTD1 = 2 * MiB, WS_RSTDM = 2 * MiB + 512 * 1024;
constexpr size_t WS_WUKF = 3 * MiB, WS_WUVF = 3 * MiB + 256 * 1024;
constexpr size_t WS_P1 = 4 * MiB, WS_P2 = 8 * MiB, WS_P3 = 12 * MiB;
constexpr size_t WS_WIN = 16 * MiB, WS_WOUT = 24 * MiB, WS_WQ = 28 * MiB, WS_WKV = 30 * MiB, WS_WO = 34 * MiB, WS_WUP = 36 * MiB, WS_WDN = 44 * MiB;
constexpr size_t WS_XB = 52 * MiB, WS_MEMB = 180 * MiB, WS_KVC = 196 * MiB, WS_MASK = 228 * MiB, WS_HX = 244 * MiB;
constexpr size_t WS_QL = 436 * MiB, WS_QR = 564 * MiB, WS_CKVF = 596 * MiB, WS_CKV = 628 * MiB, WS_KR = 644 * MiB, WS_KI = 648 * MiB, WS_WI = 656 * MiB, WS_QI = 658 * MiB;
constexpr size_t WS_QB = 722 * MiB, WS_KB = 786 * MiB, WS_VB = 850 * MiB;
constexpr size_t WS_QC = 436 * MiB, WS_OC = 564 * MiB, WS_HID = 436 * MiB, WS_END = 948 * MiB;

constexpr int LDS_BYTES = 147456;

#define GAS __attribute__((address_space(1)))
#define LAS __attribute__((address_space(3)))
typedef unsigned short bf16;
typedef unsigned v4u __attribute__((ext_vector_type(4)));
typedef unsigned v2u __attribute__((ext_vector_type(2)));
typedef float f32x4 __attribute__((ext_vector_type(4)));
typedef float f32x2 __attribute__((ext_vector_type(2)));
#define LDS_WAIT() asm volatile("s_waitcnt lgkmcnt(0)" ::: "memory")

__device__ __forceinline__ unsigned f2bf(float f) { unsigned u = __builtin_bit_cast(unsigned, f); return (u + 0x7fffu + ((u >> 16) & 1u)) >> 16; }
__device__ __forceinline__ unsigned pk2(float lo, float hi) { return f2bf(lo) | (f2bf(hi) << 16); }
__device__ __forceinline__ float bflo(unsigned w) { return __uint_as_float(w << 16); }
__device__ __forceinline__ float bfhi(unsigned w) { return __uint_as_float(w & 0xffff0000u); }
__device__ __forceinline__ float wave_sum(float v) {
#pragma unroll
    for (int o = 1; o < 64; o <<= 1) v += __shfl_xor(v, o);
    return v;
}
__device__ __forceinline__ float wave_max(float v) {
#pragma unroll
    for (int o = 1; o < 64; o <<= 1) v = fmaxf(v, __shfl_xor(v, o));
    return v;
}

struct Frame {
    LAS unsigned char* lds;
    int tid, lane, wave, G, gw, NGW;
    int wave_s;
    const __attribute__((address_space(4))) char* kargs;
    float* out;
    unsigned char* ws;
    size_t z;
};
__device__ __forceinline__ const float* inp(const Frame& F, int i) {
    const __attribute__((address_space(4))) char* p = F.kargs; asm volatile("" : "+s"(p));
    return *(const float* const __attribute__((address_space(4)))*)(p + 8 * i);
}
template <class TT> __device__ __forceinline__ TT* wsp(const Frame& F, size_t off) { return (TT*)(F.ws + F.z + off); }
__device__ __forceinline__ float* outp(const Frame& F) { return (float*)((unsigned char*)F.out + F.z); }
__device__ __forceinline__ void phase_ctx(Frame& F) {
    size_t z = 0; asm volatile("" : "+s"(z)); F.z = z;
    int ws_ = F.wave_s; asm volatile("" : "+s"(ws_));
    unsigned ones_ = ~0u; asm volatile("" : "+s"(ones_));
    const int lane_ = (int)__builtin_amdgcn_mbcnt_hi(ones_, __builtin_amdgcn_mbcnt_lo(ones_, 0u));
    F.tid = ws_ * 64 + lane_; F.lane = lane_; F.wave = ws_; F.G = gridDim.x; F.gw = blockIdx.x * NWAVES + F.wave; F.NGW = F.G * NWAVES;
}

__device__ __forceinline__ float rstd_from_parts(const float* part, int row) {
    const f32x4* p = (const f32x4*)(part + (size_t)row * 16);
    const f32x4 a = p[0], b = p[1], c = p[2], d = p[3];
    const float s = ((a[0] + a[1]) + (a[2] + a[3])) + ((b[0] + b[1]) + (b[2] + b[3])) + ((c[0] + c[1]) + (c[2] + c[3])) + ((d[0] + d[1]) + (d[2] + d[3]));
    return 1.0f / sqrtf(s * (1.0f / DM) + EPS);
}
__device__ __forceinline__ f32x4 rope4(f32x4 v, f32x4 cs) { return (f32x4){v[0] * cs[0] - v[1] * cs[1], v[1] * cs[0] + v[0] * cs[1], v[2] * cs[2] - v[3] * cs[3], v[3] * cs[2] + v[2] * cs[3]}; }
__device__ __forceinline__ v4u pack8(f32x4 a, f32x4 b) { v4u w; w.x = pk2(a[0], a[1]); w.y = pk2(a[2], a[3]); w.z = pk2(b[0], b[1]); w.w = pk2(b[2], b[3]); return w; }

struct EpiInProj {
    static constexpr bool PERM = true, AFTER_DRAIN = false;
    const float* rstd; const float* tab64; const float* tab32;
    bf16 *QL, *QR, *KR, *KI, *QI, *QB, *KB, *VB; float *CKVF, *WI;
    __device__ __forceinline__ void operator()(const pg8::f32x4 (&acc)[2][2][4][2], const pg8::Unit& u, int wr, int wc, int fr, int fq) const {
        const int pn = u.pn;
#pragma unroll
        for (int ai = 0; ai < 2; ++ai)
#pragma unroll
            for (int m = 0; m < 4; ++m) {
                const int row = u.pm * 256 + ai * 128 + wr * 64 + m * 16 + fr, pos = row & (SEQ - 1);
                const float rs = rstd[row];
                if (pn < 2) {
#pragma unroll
                    for (int bj = 0; bj < 2; ++bj) { const f32x4 a = acc[ai][bj][m][0] * (rs * SCALE_A), b = acc[ai][bj][m][1] * (rs * SCALE_A);
                        *(v4u*)(QL + (size_t)row * 512 + pn * 256 + bj * 128 + wc * 32 + 8 * fq) = pack8(a, b); }
                } else if (pn == 2) {
                    const f32x4 cs0 = *(const f32x4*)(tab32 + ((size_t)pos * 16 + 4 * fq) * 2), cs1 = *(const f32x4*)(tab32 + ((size_t)pos * 16 + 4 * fq + 2) * 2);
#pragma unroll
                    for (int bj = 0; bj < 2; ++bj) { const f32x4 a = rope4(acc[ai][bj][m][0] * (rs * SCALE_A), cs0), b = rope4(acc[ai][bj][m][1] * (rs * SCALE_A), cs1);
                        *(v4u*)(QR + (size_t)row * 256 + bj * 128 + wc * 32 + 8 * fq) = pack8(a, b); }
                } else if (pn == 3) {
                    { const f32x4 a = acc[ai][0][m][0] * rs, b = acc[ai][0][m][1] * rs; float* o = CKVF + (size_t)row * 128 + wc * 32 + 8 * fq; *(f32x4*)o = a; *(f32x4*)(o + 4) = b; }
                    if (wc == 0) {
                        const f32x4 cs0 = *(const f32x4*)(tab32 + ((size_t)pos * 16 + 4 * fq) * 2), cs1 = *(const f32x4*)(tab32 + ((size_t)pos * 16 + 4 * fq + 2) * 2);
                        const f32x4 a = rope4(acc[ai][1][m][0] * rs, cs0), b = rope4(acc[ai][1][m][1] * rs, cs1);
                        *(v4u*)(KR + (size_t)row * 32 + 8 * fq) = pack8(a, b);
                    } else if (wc < 3) {
                        const int tb = 16 * (wc - 1) + 4 * fq;
                        const f32x4 cs0 = *(const f32x4*)(tab64 + ((size_t)pos * 32 + tb) * 2), cs1 = *(const f32x4*)(tab64 + ((size_t)pos * 32 + tb + 2) * 2);
                        const f32x4 a = rope4(acc[ai][1][m][0] * rs, cs0), b = rope4(acc[ai][1][m][1] * rs, cs1);
                        *(v4u*)(KI + (size_t)row * 64 + 32 * (wc - 1) + 8 * fq) = pack8(a, b);
                    } else if (fq == 0) {
                        const f32x4 a = acc[ai][1][m][0] * (rs * IDX_W), b = acc[ai][1][m][1] * (rs * IDX_W); float* o = WI + (size_t)row * 8; *(f32x4*)o = a; *(f32x4*)(o + 4) = b;
                    }
                } else if (pn < 10) {
                    const int tb = 16 * (wc & 1) + 4 * fq;
                    const f32x4 cs0 = *(const f32x4*)(tab64 + ((size_t)pos * 32 + tb) * 2), cs1 = *(const f32x4*)(tab64 + ((size_t)pos * 32 + tb + 2) * 2);
                    const float sc = (pn == 6 || pn == 7) ? rs * SCALE_B : rs;
                    const size_t eoff = (size_t)row * 512 + (pn & 1) * 256 + wc * 32 + 8 * fq;
#pragma unroll
                    for (int bj = 0; bj < 2; ++bj) { const f32x4 a = rope4(acc[ai][bj][m][0] * sc, cs0), b = rope4(acc[ai][bj][m][1] * sc, cs1); const v4u w = pack8(a, b);
                        if (pn < 6) *(v4u*)(QI + eoff + bj * 128) = w; else if (pn < 8) *(v4u*)(QB + eoff + bj * 128) = w; else *(v4u*)(KB + eoff + bj * 128) = w; }
                } else {
#pragma unroll
                    for (int bj = 0; bj < 2; ++bj) { const f32x4 a = acc[ai][bj][m][0] * rs, b = acc[ai][bj][m][1] * rs;
                        *(v4u*)(VB + (size_t)row * 512 + (pn & 1) * 256 + bj * 128 + wc * 32 + 8 * fq) = pack8(a, b); }
                }
            }
    }
};
template <int ACT  > struct EpiRowScale {
    static constexpr bool PERM = true, AFTER_DRAIN = false;
    bf16* O; int ldc; const float* rstd_direct; const float* parts; float cs;
    __device__ __forceinline__ void operator()(const pg8::f32x4 (&acc)[2][2][4][2], const pg8::Unit& u, int wr, int wc, int fr, int fq) const {
#pragma unroll
        for (int ai = 0; ai < 2; ++ai)
#pragma unroll
            for (int m = 0; m < 4; ++m) {
                const int row = u.pm * 256 + ai * 128 + wr * 64 + m * 16 + fr;
                const float rs = (ACT == 2) ? 1.0f : (parts ? rstd_from_parts(parts, row) : rstd_direct[row]) * cs;
#pragma unroll
                for (int bj = 0; bj < 2; ++bj) { f32x4 a = acc[ai][bj][m][0] * rs, b = acc[ai][bj][m][1] * rs;
                    if (ACT == 1) {
#pragma unroll
                        for (int e = 0; e < 4; ++e) { const float x = fmaxf(a[e], 0.f), y = fmaxf(b[e], 0.f); a[e] = x * x; b[e] = y * y; } }
                    *(v4u*)(O + (size_t)row * ldc + u.pn * 256 + bj * 128 + wc * 32 + 8 * fq) = pack8(a, b); }
            }
    }
};
struct EpiResid {
    static constexpr bool PERM = true, AFTER_DRAIN = false;
    bf16* XBio; float* parts;
    __device__ __forceinline__ void operator()(const pg8::f32x4 (&acc)[2][2][4][2], const pg8::Unit& u, int wr, int wc, int fr, int fq) const {
#pragma unroll
        for (int ai = 0; ai < 2; ++ai)
#pragma unroll
            for (int m = 0; m < 4; ++m) {
                const int row = u.pm * 256 + ai * 128 + wr * 64 + m * 16 + fr;
                float ss = 0.f;
#pragma unroll
                for (int bj = 0; bj < 2; ++bj) { const size_t off = (size_t)row * DM + u.pn * 256 + bj * 128 + wc * 32 + 8 * fq;
                    const v4u rw = *(const v4u*)(XBio + off);
                    const f32x4 a = (f32x4){bflo(rw.x), bfhi(rw.x), bflo(rw.y), bfhi(rw.y)} + acc[ai][bj][m][0], b = (f32x4){bflo(rw.z), bfhi(rw.z), bflo(rw.w), bfhi(rw.w)} + acc[ai][bj][m][1];
                    *(v4u*)(XBio + off) = pack8(a, b);
                    ss += (a[0] * a[0] + a[1] * a[1]) + (a[2] * a[2] + a[3] * a[3]) + (b[0] * b[0] + b[1] * b[1]) + (b[2] * b[2] + b[3] * b[3]); }
                ss += __shfl_xor(ss, 16); ss += __shfl_xor(ss, 32);
                if (fq == 0) parts[(size_t)row * 16 + u.pn * 4 + wc] = ss;
            }
    }
};

struct KvOrder {
    int G, c; const char* memb; const char* wkv;
    __device__ __forceinline__ bool next(int i, pg8::Unit& u) const {
        const int L = i * G + c; if (L >= 256) return false;
        if (L < 128) { u.pm = L >> 2; u.pn = L & 3; u.pa = memb + (size_t)u.pm * 256 * DM * 2; u.pb = wkv + (size_t)u.pn * 256 * DM * 2; }
        else { const int l2 = L - 128; u.pm = 64 + (l2 & 3); u.pn = l2 >> 2; u.pa = wkv + (size_t)(1024 + (l2 & 3) * 256) * DM * 2; u.pb = memb + (size_t)u.pn * 256 * DM * 2; }
        return true;
    }
    __device__ __forceinline__ void a_ready(const pg8::Unit&) const {}
    __device__ __forceinline__ void done(const pg8::Unit&) const {}
};
struct EpiKv {
    static constexpr bool PERM = true, AFTER_DRAIN = false;
    bf16* KC; bf16* VT; const float* rstd;
    __device__ __forceinline__ void operator()(const pg8::f32x4 (&acc)[2][2][4][2], const pg8::Unit& u, int wr, int wc, int fr, int fq) const {
        const bool isv = u.pm >= 64; const int pm = isv ? u.pm - 64 : u.pm;
#pragma unroll
        for (int ai = 0; ai < 2; ++ai)
#pragma unroll
            for (int m = 0; m < 4; ++m) {
                const int row = pm * 256 + ai * 128 + wr * 64 + m * 16 + fr;
#pragma unroll
                for (int bj = 0; bj < 2; ++bj) { const int col = u.pn * 256 + bj * 128 + wc * 32 + 8 * fq;
                    if (!isv) { const float rs = rstd[row]; *(v4u*)(KC + (size_t)row * DM + col) = pack8(acc[ai][bj][m][0] * rs, acc[ai][bj][m][1] * rs); }
                    else { const f32x4 r0 = *(const f32x4*)(rstd + col), r1 = *(const f32x4*)(rstd + col + 4); *(v4u*)(VT + (size_t)row * TM + col) = pack8(acc[ai][bj][m][0] * r0, acc[ai][bj][m][1] * r1); } }
            }
    }
};
struct CrossOrder {
    int G, c; const char* A; const char* B; size_t bstride, hstride;
    __device__ __forceinline__ bool next(int i, pg8::Unit& u) const {
        if (i >= 4) return false;
        const int xcd = c & 7, slot = c >> 3, e = i * 32 + slot, pair = xcd * 16 + (e >> 3), qt = e & 7, b = pair >> 2, h = pair & 3;
        u.pm = b * 8 + qt; u.pn = h; u.pa = A + ((size_t)u.pm * 256 * DM + h * 256) * 2; u.pb = B + (size_t)b * bstride + (size_t)h * hstride; return true;
    }
    __device__ __forceinline__ void a_ready(const pg8::Unit&) const {}
    __device__ __forceinline__ void done(const pg8::Unit&) const {}
};
struct EpiSoftmaxP {
    static constexpr bool PERM = true, AFTER_DRAIN = false;
    bf16* P; LAS float* xch;
    __device__ __forceinline__ void operator()(const pg8::f32x4 (&acc_)[2][2][4][2], const pg8::Unit& u, int wr, int wc, int fr, int fq) const {
        pg8::f32x4 (&acc)[2][2][4][2] = const_cast<pg8::f32x4 (&)[2][2][4][2]>(acc_);
        LAS float* xb = xch + (wr * 64 + fr) * 8; asm volatile("" : "+v"(xb));
#pragma unroll
        for (int ai = 0; ai < 2; ++ai)
#pragma unroll
            for (int m = 0; m < 4; ++m) {
                float v = -INFINITY;
#pragma unroll
                for (int bj = 0; bj < 2; ++bj)
#pragma unroll
                    for (int n = 0; n < 2; ++n) { const f32x4 x = acc[ai][bj][m][n]; v = fmaxf(v, fmaxf(fmaxf(x[0], x[1]), fmaxf(x[2], x[3]))); }
                v = fmaxf(v, __shfl_xor(v, 16)); v = fmaxf(v, __shfl_xor(v, 32));
                float s = 0.f;
#pragma unroll
                for (int bj = 0; bj < 2; ++bj)
#pragma unroll
                    for (int n = 0; n < 2; ++n) { f32x4 x = acc[ai][bj][m][n];
#pragma unroll
                        for (int e = 0; e < 4; ++e) { x[e] = __builtin_amdgcn_exp2f(x[e] - v); s += x[e]; }
                        acc[ai][bj][m][n] = x; }
                s += __shfl_xor(s, 16); s += __shfl_xor(s, 32);
                if (fq == 0) *(LAS f32x2*)(xb + (ai * 128 + m * 16) * 8 + wc * 2) = (f32x2){v, s};
            }
        asm volatile("s_waitcnt lgkmcnt(0)" ::: "memory"); __builtin_amdgcn_s_barrier(); asm volatile("" ::: "memory");
#pragma unroll
        for (int ai = 0; ai < 2; ++ai)
#pragma unroll
            for (int m = 0; m < 4; ++m) {
                const int rl = ai * 128 + wr * 64 + m * 16 + fr, row = u.pm * 256 + rl;
                const f32x4 a = *(const LAS f32x4*)(xb + (ai * 128 + m * 16) * 8), b = *(const LAS f32x4*)(xb + (ai * 128 + m * 16) * 8 + 4);
                const float M = fmaxf(fmaxf(a[0], a[2]), fmaxf(b[0], b[2]));
                const float L = a[1] * __builtin_amdgcn_exp2f(a[0] - M) + a[3] * __builtin_amdgcn_exp2f(a[2] - M) + b[1] * __builtin_amdgcn_exp2f(b[0] - M) + b[3] * __builtin_amdgcn_exp2f(b[2] - M);
                const float mown = (wc == 0) ? a[0] : (wc == 1) ? a[2] : (wc == 2) ? b[0] : b[2];
                const float sc = __builtin_amdgcn_exp2f(mown - M) / L;
#pragma unroll
                for (int bj = 0; bj < 2; ++bj) *(v4u*)(P + (size_t)row * DM + u.pn * 256 + bj * 128 + wc * 32 + 8 * fq) = pack8(acc[ai][bj][m][0] * sc, acc[ai][bj][m][1] * sc);
                __builtin_amdgcn_sched_barrier(0);
            }
        asm volatile("s_waitcnt lgkmcnt(0)" ::: "memory"); __builtin_amdgcn_s_barrier(); asm volatile("" ::: "memory");
    }
};

template <class Map>
__device__ __forceinline__ void transpose_item(const float* W, int srcN, const float* g, bf16* WT, int ldk, int koff, LAS float* scr, int k0, int n0, int lane, const Map& map) {
    const int sc = map(n0 + (lane & 31));
#pragma unroll 8
    for (int i = 0; i < 32; ++i) { const int kk = 2 * i + (lane >> 5); float v = (sc >= 0) ? W[(size_t)(k0 + kk) * srcN + sc] : 0.f; if (g) v *= g[k0 + kk]; scr[kk * 33 + (lane & 31)] = v; }
    LDS_WAIT(); asm volatile("" ::: "memory");
    const int c = lane & 7;
#pragma unroll
    for (int j = 0; j < 4; ++j) { const int n = (lane >> 3) + 8 * j; const LAS float* s = scr + (8 * c) * 33 + n;
        v4u o; o.x = pk2(s[0 * 33], s[1 * 33]); o.y = pk2(s[2 * 33], s[3 * 33]); o.z = pk2(s[4 * 33], s[5 * 33]); o.w = pk2(s[6 * 33], s[7 * 33]);
        *(v4u*)(WT + (size_t)(n0 + n) * ldk + koff + k0 + 8 * c) = o; }
    LDS_WAIT(); asm volatile("" ::: "memory");
}
struct MapId { __device__ __forceinline__ int operator()(int n) const { return n; } };
__device__ __forceinline__ int il64(int p) { return (p >> 1) + 32 * (p & 1); }
__device__ __forceinline__ int il32(int p) { return (p >> 1) + 16 * (p & 1); }
struct MapIn {
    __device__ __forceinline__ int operator()(int nn) const {
        if (nn < 512) return nn;
        int n = nn - 512;
        if (n < 256) return 512 + (n >> 5) * 32 + il32(n & 31);
        n -= 256;
        if (n < 256) { if (n < 128) return 768 + n; if (n < 160) return 896 + il32(n - 128); if (n < 224) return 1440 + il64(n - 160); if (n < 232) return 1504 + (n - 224); return -1; }
        n -= 256;
        if (n < 512) return 928 + (n >> 6) * 64 + il64(n & 63);
        n -= 512;
        if (n < 512) return 1512 + (n >> 6) * 64 + il64(n & 63);
        n -= 512;
        if (n < 512) return 2024 + (n >> 6) * 64 + il64(n & 63);
        n -= 512;
        return 2536 + n;
    }
};

__device__ __forceinline__ void p0_prologue(Frame& F) {
    LAS float* scr = (LAS float*)(F.lds + F.wave * 16384);
    const int gw = F.gw, NGW = F.NGW, lane = F.lane;
    const float *x = inp(F, 0), *mem = inp(F, 1), *g_mix = inp(F, 2), *w_in = inp(F, 3), *w_uk = inp(F, 5), *w_uv = inp(F, 6), *w_out = inp(F, 7), *g_cross = inp(F, 8), *g_mem = inp(F, 9);
    const float *w_q = inp(F, 10), *w_kv = inp(F, 11), *w_o = inp(F, 12), *g_mlp = inp(F, 13), *w_up = inp(F, 14), *w_dn = inp(F, 15);
    bf16 *WIN = wsp<bf16>(F, WS_WIN), *WOUT = wsp<bf16>(F, WS_WOUT), *WQ = wsp<bf16>(F, WS_WQ), *WKV = wsp<bf16>(F, WS_WKV), *WO = wsp<bf16>(F, WS_WO), *WUP = wsp<bf16>(F, WS_WUP), *WDN = wsp<bf16>(F, WS_WDN);
    constexpr int I_IN = 16 * (3072 / 32), I_OUT2 = 16 * 32, I_Q = 16 * 32, I_KV = 16 * 64, I_O = 16 * 32, I_UP = 16 * 128, I_DN = 64 * 32;
    constexpr int NIT = I_IN + I_OUT2 + I_Q + I_KV + I_O + I_UP + I_DN;
    for (int it = gw; it < NIT; it += NGW) {
        int r = it;
        if (r < I_IN) { const int nb = r % 96, kb = r / 96; transpose_item(w_in, W_IN_COLS, g_mix, WIN, DM, 0, scr, 64 * kb, 32 * nb, lane, MapIn()); continue; } r -= I_IN;
        if (r < I_OUT2) { const int nb = r % 32, kb = r / 32; transpose_item(w_out, DM, nullptr, WOUT, KOUT, 0, scr, 64 * kb, 32 * nb, lane, MapId()); continue; } r -= I_OUT2;
        if (r < I_Q) { const int nb = r % 32, kb = r / 32; transpose_item(w_q, DM, g_cross, WQ, DM, 0, scr, 64 * kb, 32 * nb, lane, MapId()); continue; } r -= I_Q;
        if (r < I_KV) { const int nb = r % 64, kb = r / 64; transpose_item(w_kv, 2048, g_mem, WKV, DM, 0, scr, 64 * kb, 32 * nb, lane, MapId()); continue; } r -= I_KV;
        if (r < I_O) { const int nb = r % 32, kb = r / 32; transpose_item(w_o, DM, nullptr, WO, DM, 0, scr, 64 * kb, 32 * nb, lane, MapId()); continue; } r -= I_O;
        if (r < I_UP) { const int nb = r % 128, kb = r / 128; transpose_item(w_up, FF, g_mlp, WUP, DM, 0, scr, 64 * kb, 32 * nb, lane, MapId()); continue; } r -= I_UP;
        { const int nb = r % 32, kb = r / 32; transpose_item(w_dn, DM, nullptr, WDN, FF, 0, scr, 64 * kb, 32 * nb, lane, MapId()); }
    }
    { v4u* WUKF = wsp<v4u>(F, WS_WUKF); v4u* WUVF = wsp<v4u>(F, WS_WUVF);
      for (int e = gw * 64 + lane; e < 2 * 8192; e += NGW * 64) {
          const int ln = e & 63, r32 = ln & 31, hi = ln >> 5; float v[8];
          if (e < 8192) { const int ks = (e >> 6) & 3, ct = (e >> 8) & 3, h = e >> 10;
#pragma unroll
              for (int j = 0; j < 8; ++j) v[j] = w_uk[((size_t)h * 64 + 16 * ks + 8 * hi + j) * 128 + 32 * ct + r32];
              v4u o; o.x = pk2(v[0], v[1]); o.y = pk2(v[2], v[3]); o.z = pk2(v[4], v[5]); o.w = pk2(v[6], v[7]); WUKF[e] = o; }
          else { const int e2 = e - 8192, sx = (e2 >> 6) & 1, dt = (e2 >> 7) & 3, vt = (e2 >> 9) & 1, h = e2 >> 10;
#pragma unroll
              for (int j = 0; j < 8; ++j) v[j] = w_uv[((size_t)h * 128 + 32 * dt + 16 * sx + 8 * hi + j) * 64 + 32 * vt + r32];
              v4u o; o.x = pk2(v[0], v[1]); o.y = pk2(v[2], v[3]); o.z = pk2(v[4], v[5]); o.w = pk2(v[6], v[7]); WUVF[e2] = o; }
      } }
    bf16 *XB = wsp<bf16>(F, WS_XB), *MEMB = wsp<bf16>(F, WS_MEMB); float *R1 = wsp<float>(F, WS_RSTD1), *RM = wsp<float>(F, WS_RSTDM);
    for (int m0 = gw; m0 < T + TM; m0 += 4 * NGW) {
        f32x4 v[4][4]; float ssq[4];
#pragma unroll
        for (int u = 0; u < 4; ++u) { const int m = m0 + u * NGW; const bool ok = m < T + TM; const bool isx = m < T; const int r = isx ? m : m - T;
            const f32x4* xr = (const f32x4*)((isx ? x : mem) + (size_t)(ok ? r : 0) * DM) + lane;
#pragma unroll
            for (int j = 0; j < 4; ++j) v[u][j] = xr[64 * j]; }
#pragma unroll
        for (int u = 0; u < 4; ++u) { float s = 0.f;
#pragma unroll
            for (int j = 0; j < 4; ++j) s += (v[u][j][0] * v[u][j][0] + v[u][j][1] * v[u][j][1]) + (v[u][j][2] * v[u][j][2] + v[u][j][3] * v[u][j][3]);
            ssq[u] = wave_sum(s); }
#pragma unroll
        for (int u = 0; u < 4; ++u) { const int m = m0 + u * NGW; if (m < T + TM) { const bool isx = m < T; const int r = isx ? m : m - T;
            if (lane == 0) (isx ? R1 : RM)[r] = 1.0f / sqrtf(ssq[u] * (1.0f / DM) + EPS);
            v2u* o8 = (v2u*)((isx ? XB : MEMB) + (size_t)r * DM) + lane;
#pragma unroll
            for (int j = 0; j < 4; ++j) { v2u w; w.x = pk2(v[u][j][0], v[u][j][1]); w.y = pk2(v[u][j][2], v[u][j][3]); o8[64 * j] = w; } } }
    }
    float *T64 = wsp<float>(F, WS_TAB64), *T32 = wsp<float>(F, WS_TAB32);
    for (int e = gw * 64 + lane; e < SEQ * 32; e += NGW * 64) {
        const int pos = e >> 5, t = e & 31;
        const float inv = exp2f(-(float)t * (13.287712379549449f / 32.0f));
        const float ang = (float)pos * inv;
        const double rev = (double)ang * 0.15915494309189535; const float fr = (float)(rev - floor(rev));
        const float c = __builtin_amdgcn_cosf(fr), s = __builtin_amdgcn_sinf(fr);
        T64[2 * e] = c; T64[2 * e + 1] = s;
        if ((t & 1) == 0) { T32[2 * (pos * 16 + (t >> 1))] = c; T32[2 * (pos * 16 + (t >> 1)) + 1] = s; }
    }
}

__device__ __forceinline__ void p2_ckv_norm(Frame& F) {
    const float* CKVF = wsp<float>(F, WS_CKVF); bf16* CKV = wsp<bf16>(F, WS_CKV); const float* g = inp(F, 4);
    const float g0 = g[2 * F.lane], g1 = g[2 * F.lane + 1];
    const int c0_ = 2 * F.lane, cpos = (c0_ & ~12) | ((c0_ & 4) << 1) | ((c0_ & 8) >> 1);
    for (int r0 = F.gw; r0 < T; r0 += 4 * F.NGW) {
        f32x2 v[4]; float ss[4];
#pragma unroll
        for (int u = 0; u < 4; ++u) v[u] = *(const f32x2*)(CKVF + (size_t)(r0 + u * F.NGW) * 128 + 2 * F.lane);
#pragma unroll
        for (int u = 0; u < 4; ++u) ss[u] = wave_sum(v[u][0] * v[u][0] + v[u][1] * v[u][1]);
#pragma unroll
        for (int u = 0; u < 4; ++u) { const float rs = 1.0f / sqrtf(ss[u] * (1.0f / 128.0f) + EPS);
            *(unsigned*)(CKV + (size_t)(r0 + u * F.NGW) * 128 + cpos) = pk2(v[u][0] * rs * g0, v[u][1] * rs * g1); }
    }
}
typedef short bf16x8 __attribute__((ext_vector_type(8)));
typedef float f32x16 __attribute__((ext_vector_type(16)));
typedef short v4i16_t __attribute__((ext_vector_type(4)));
typedef float f32x2_t __attribute__((ext_vector_type(2)));
typedef __bf16 bf16x2_t __attribute__((ext_vector_type(2)));
__device__ __forceinline__ unsigned cvtpk(float lo, float hi) { f32x2_t v = {lo, hi}; bf16x2_t b = __builtin_convertvector(v, bf16x2_t); return __builtin_bit_cast(unsigned, b); }
__device__ __forceinline__ int crow(int r, int hi) { return (r & 3) + 8 * (r >> 2) + 4 * hi; }
template <int NCH> __device__ __forceinline__ unsigned off_img(unsigned row, unsigned ch) { return (NCH * 128u) * (row >> 3) + 512u * (ch >> 2) + 64u * (row & 7) + 16u * ((ch & 3) ^ ((row >> 2) & 3)); }
template <int NCH> __device__ __forceinline__ unsigned rowread_addr(unsigned lane, unsigned s) { return off_img<NCH>(lane & 31, 2 * s + (lane >> 5)); }
template <int NCH> __device__ __forceinline__ unsigned trread_addr(unsigned lane, unsigned c, unsigned ks, unsigned t) {
    const unsigned h = lane >> 5, blk = (lane >> 4) & 1, q = (lane & 15) >> 2, p = lane & 3;
    return off_img<NCH>(16 * ks + 8 * t + 4 * h + q, 4 * c + 2 * blk + (p >> 1)) + 8 * (p & 1);
}
__device__ __forceinline__ bf16x8 trfrag(LAS unsigned char* p0, LAS unsigned char* p1) {
    const v4i16_t lo = __builtin_amdgcn_ds_read_tr16_b64_v4i16((LAS v4i16_t*)p0), hi = __builtin_amdgcn_ds_read_tr16_b64_v4i16((LAS v4i16_t*)p1);
    return (bf16x8){lo[0], lo[1], lo[2], lo[3], hi[0], hi[1], hi[2], hi[3]};
}
#define MFMA32(a, b, c) __builtin_amdgcn_mfma_f32_32x32x16_bf16((a), (b), (c), 0, 0, 0)
template <int NDT> __device__ __forceinline__ void softmax_tile(f32x16& S, float& m, float& l, f32x16 (&o)[NDT], bf16x8 (&pf)[2]) {
    float mt = fmaxf(fmaxf(fmaxf(S[0], S[1]), fmaxf(S[2], S[3])), fmaxf(fmaxf(S[4], S[5]), fmaxf(S[6], S[7])));
    mt = fmaxf(mt, fmaxf(fmaxf(fmaxf(S[8], S[9]), fmaxf(S[10], S[11])), fmaxf(fmaxf(S[12], S[13]), fmaxf(S[14], S[15]))));
    mt = fmaxf(mt, __shfl_xor(mt, 32));
    if (__any(mt > m)) {
        const float mn = fmaxf(m, mt), al = __builtin_amdgcn_exp2f(m - mn);
        l *= al; m = mn;
#pragma unroll
        for (int d = 0; d < NDT; ++d) o[d] = o[d] * al;
    }
    float s = 0.f;
#pragma unroll
    for (int r = 0; r < 16; ++r) { S[r] = __builtin_amdgcn_exp2f(S[r] - m); s += S[r]; }
    l += s;
    typedef unsigned u32x4_t __attribute__((ext_vector_type(4)));
    u32x4_t w0, w1;
    w0.x = cvtpk(S[0], S[1]); w0.y = cvtpk(S[2], S[3]); w0.z = cvtpk(S[4], S[5]); w0.w = cvtpk(S[6], S[7]);
    w1.x = cvtpk(S[8], S[9]); w1.y = cvtpk(S[10], S[11]); w1.z = cvtpk(S[12], S[13]); w1.w = cvtpk(S[14], S[15]);
    pf[0] = __builtin_bit_cast(bf16x8, w0); pf[1] = __builtin_bit_cast(bf16x8, w1);
}
__device__ __forceinline__ int unit_batch(int c, int ui) { return 4 * (c & 7) + (ui >> 1); }
__device__ __forceinline__ int unit_qtile(int c, int ui) { const int s = c >> 3; return (ui & 1) ? 63 - s : s; }

__device__ __forceinline__ void p2_index_mfma(Frame& F) {
    const bf16 *QI = wsp<bf16>(F, WS_QI), *KI = wsp<bf16>(F, WS_KI); const float* WI = wsp<float>(F, WS_WI); unsigned* MASK = wsp<unsigned>(F, WS_MASK);
    unsigned* SC = wsp<unsigned>(F, WS_HX) + (size_t)blockIdx.x * (32 * 2048);
    const int lane = F.lane, q = lane & 31, hi = lane >> 5, w = F.wave;
    LAS unsigned char* kimg = F.lds + F.wave * 16384;
    LAS unsigned long long* lm = (LAS unsigned long long*)(kimg + 8192);
    const unsigned rra = hi * 528 + q * 16;
    unsigned wa[4];
#pragma unroll
    for (int p = 0; p < 4; ++p) { const int e = lane + 64 * p; wa[p] = (e & 7) * 528 + (e >> 3) * 16; }
    for (int c = blockIdx.x; c < 256; c += gridDim.x) {
        for (int ui = 0; ui < 8; ++ui) {
            const int b = unit_batch(c, ui), j = unit_qtile(c, ui); const size_t tok0 = (size_t)b * SEQ + 32 * j; const int qpos = 32 * j + q;
            for (int rep_ = 0; rep_ < ((DUP_MASK & 128) ? 2 : 1); ++rep_)
            if (w <= j) {
                const f32x4 wva = *(const f32x4*)(WI + (tok0 + q) * 8), wvb = *(const f32x4*)(WI + (tok0 + q) * 8 + 4);
                const float wq[8] = {wva[0], wva[1], wva[2], wva[3], wvb[0], wvb[1], wvb[2], wvb[3]};
                const bf16* kb = KI + (size_t)b * SEQ * 64 + 8 * lane;
#pragma unroll
                for (int hp = 0; hp < 2; ++hp) {
                    bf16x8 qf[4][4];
#pragma unroll
                    for (int hh = 0; hh < 4; ++hh)
#pragma unroll
                        for (int ks = 0; ks < 4; ++ks) qf[hh][ks] = *(const bf16x8*)(QI + (tok0 + q) * 512 + (4 * hp + hh) * 64 + 16 * ks + 8 * hi);
#pragma unroll
                    for (int hh = 0; hh < 4; ++hh)
#pragma unroll
                        for (int ks = 0; ks < 4; ++ks) asm volatile("" : "+v"(qf[hh][ks]));
                    v4u kr[4];
#pragma unroll
                    for (int p = 0; p < 4; ++p) kr[p] = *(const v4u*)(kb + (size_t)w * 32 * 64 + 512 * p);
                    f32x4 pvn[4];
#pragma unroll
                    for (int g = 0; g < 4; ++g) pvn[g] = (hp == 1) ? *(const f32x4*)(SC + (size_t)q * 2048 + 32 * w + 4 * hi + 8 * g) : (f32x4){0.f, 0.f, 0.f, 0.f};
                    for (int i = w; i <= j; i += 8) {
#pragma unroll
                        for (int p = 0; p < 4; ++p) *(LAS v4u*)(kimg + wa[p]) = kr[p];
                        if (i + 8 <= j) {
#pragma unroll
                            for (int p = 0; p < 4; ++p) kr[p] = *(const v4u*)(kb + (size_t)(i + 8) * 32 * 64 + 512 * p);
                        }
                        unsigned* srow = SC + (size_t)q * 2048 + 32 * i + 4 * hi;
                        f32x16 idx = (f32x16){};
                        if (hp == 1) {
#pragma unroll
                            for (int g = 0; g < 4; ++g) { idx[4 * g] = pvn[g][0]; idx[4 * g + 1] = pvn[g][1]; idx[4 * g + 2] = pvn[g][2]; idx[4 * g + 3] = pvn[g][3]; }
                            if (i + 8 <= j) {
#pragma unroll
                                for (int g = 0; g < 4; ++g) pvn[g] = *(const f32x4*)(srow + 256 + 8 * g);
                            }
                        }
#pragma unroll
                        for (int hh = 0; hh < 4; ++hh) {
                            f32x16 S = (f32x16){};
#pragma unroll
                            for (int ks = 0; ks < 4; ++ks) { const bf16x8 kf = *(const LAS bf16x8*)(kimg + rra + 1056 * ks); S = MFMA32(kf, qf[hh][ks], S); }
#pragma unroll
                            for (int r = 0; r < 16; ++r) idx[r] = fmaf(fmaxf(S[r], 0.f), wq[4 * hp + hh], idx[r]);
                            __builtin_amdgcn_sched_barrier(0);
                        }
                        if (hp == 0) {
#pragma unroll
                            for (int g = 0; g < 4; ++g) *(f32x4*)(srow + 8 * g) = (f32x4){idx[4 * g], idx[4 * g + 1], idx[4 * g + 2], idx[4 * g + 3]};
                        } else {
#pragma unroll
                            for (int g = 0; g < 4; ++g) { v4u kv;
#pragma unroll
                                for (int e = 0; e < 4; ++e) { const int s = 32 * i + 8 * g + 4 * hi + e; unsigned ord = __float_as_uint(idx[4 * g + e]); ord ^= (ord >> 31) ? 0xFFFFFFFFu : 0x80000000u;
                                    kv[e] = (s <= qpos) ? ((ord & 0xFFFFF800u) | (unsigned)(SEQ - 1 - s)) : 0u; }
                                *(v4u*)(srow + 8 * g) = kv; }
                        }
                    }
                }
            }
            __syncthreads();
#pragma unroll 1
            for (int n4 = 0; n4 < ((DUP_MASK & 256) ? 8 : 4); ++n4) {
                const int n = n4 & 3;
                const int qq = 4 * w + n, qp = 32 * j + qq, nr = (qp >> 6) + 1; const size_t t = tok0 + qq;
                unsigned key[32];
#pragma unroll
                for (int r = 0; r < 32; ++r) { const unsigned v = SC[(size_t)qq * 2048 + r * 64 + lane]; key[r] = (r * 64 + lane <= qp) ? v : 0u; }
                unsigned thr = 1u;
                if (qp >= 256) {
                    unsigned lo = 0u;
#pragma unroll 1
                    for (int bit = 31; bit >= 0; --bit) {
                        const unsigned cand = lo | (1u << bit); int cnt = 0;
#pragma unroll
                        for (int g = 0; g < 8; ++g) if (4 * g < nr) {
                            cnt += __popcll(__ballot(key[4 * g] >= cand)) + __popcll(__ballot(key[4 * g + 1] >= cand)); cnt += __popcll(__ballot(key[4 * g + 2] >= cand)) + __popcll(__ballot(key[4 * g + 3] >= cand)); }
                        if (cnt >= 256) lo = cand;
                        if (cnt == 256) break;
                    }
                    thr = lo;
                }
#pragma unroll
                for (int r = 0; r < 32; ++r) { const unsigned long long bm = __ballot(key[r] >= thr && key[r] != 0u); if (lane == 0) lm[r] = bm; if ((r & 3) == 3) __builtin_amdgcn_sched_barrier(0); }
                LDS_WAIT();
                const unsigned long long mine = lm[lane & 31];
                if (lane < 32) *(unsigned long long*)(MASK + t * 64 + 2 * lane) = mine;
                LDS_WAIT();
            }
            __syncthreads();
        }
    }
}

__device__ __forceinline__ float fmax3(float a, float b, float c) { float r; asm("v_max3_f32 %0, %1, %2, %3" : "=v"(r) : "v"(a), "v"(b), "v"(c)); return r; }
template <int NDT> __device__ __forceinline__ void softmax_tile_m(f32x16& S, float mt, float& m, float& l, f32x16 (&o)[NDT], bf16x8 (&pf)[2]) {
    if (__any(mt > m)) {
        const float mn = fmaxf(m, mt), al = __builtin_amdgcn_exp2f(m - mn);
        l *= al; m = mn;
#pragma unroll
        for (int d = 0; d < NDT; ++d) o[d] = o[d] * al;
    }
    float s = 0.f;
#pragma unroll
    for (int r = 0; r < 16; ++r) { S[r] = __builtin_amdgcn_exp2f(S[r] - m); s += S[r]; }
    l += s;
    typedef unsigned u32x4_t __attribute__((ext_vector_type(4)));
    u32x4_t w0, w1;
    w0.x = cvtpk(S[0], S[1]); w0.y = cvtpk(S[2], S[3]); w0.z = cvtpk(S[4], S[5]); w0.w = cvtpk(S[6], S[7]);
    w1.x = cvtpk(S[8], S[9]); w1.y = cvtpk(S[10], S[11]); w1.z = cvtpk(S[12], S[13]); w1.w = cvtpk(S[14], S[15]);
    pf[0] = __builtin_bit_cast(bf16x8, w0); pf[1] = __builtin_bit_cast(bf16x8, w1);
}
__device__ __forceinline__ void p3_dsa_mfma5(Frame& F) {
    const bf16 *QL = wsp<bf16>(F, WS_QL), *QR = wsp<bf16>(F, WS_QR), *CKV = wsp<bf16>(F, WS_CKV), *KR = wsp<bf16>(F, WS_KR); const unsigned* MASK = wsp<unsigned>(F, WS_MASK); bf16* HX = wsp<bf16>(F, WS_HX);
    const v4u *WUKF = wsp<v4u>(F, WS_WUKF), *WUVF = wsp<v4u>(F, WS_WUVF);
    typedef unsigned u32x4_t __attribute__((ext_vector_type(4)));
    const int lane = F.lane, q = lane & 31, hi = lane >> 5, h = F.wave, tid = F.tid;
    constexpr int BUFB = 10496;
    const unsigned ra0 = rowread_addr<16>(lane, 0), ra1 = rowread_addr<16>(lane, 1);
    const unsigned ta0 = trread_addr<16>(lane, 0, 0, 0), ta1 = trread_addr<16>(lane, 0, 0, 1);
    const unsigned rra = 8192 + hi * 528 + q * 16;
    const unsigned wcs = off_img<16>(tid >> 4, tid & 15), wrs = 8192 + (tid & 3) * 528 + ((tid >> 2) & 31) * 16;
    const bool rl = tid < 128;
#define DSA_QK(Sv, buf) do { Sv = (f32x16){}; \
        _Pragma("unroll") for (int ks = 0; ks < 8; ++ks) { const bf16x8 kf = *(const LAS bf16x8*)((buf) + ((ks & 1) ? ra1 : ra0) + 512 * (ks >> 1)); Sv = MFMA32(kf, qf[ks], Sv); } \
        _Pragma("unroll") for (int ks = 0; ks < 2; ++ks) { const bf16x8 kf = *(const LAS bf16x8*)((buf) + rra + 1056 * ks); Sv = MFMA32(kf, qf[8 + ks], Sv); } } while (0)
#define DSA_LD(cv, rv, t) do { const int t_ = ((t) <= j) ? (t) : j; const bf16* ct_ = cbb + (size_t)t_ * 32 * 128; const bf16* rt_ = rbb + (size_t)t_ * 32 * 32; asm volatile("" : "+s"(ct_)); asm volatile("" : "+s"(rt_)); cv = *(const v4u*)(ct_ + cbo); rv = *(const v4u*)(rt_ + rbo); } while (0)
#define DSA_TILE(i, cw, rw, cl, rl_) do { \
        const int b1 = (bi == 2) ? 0 : bi + 1, b2 = (b1 == 2) ? 0 : b1 + 1; \
        LAS unsigned char* cur = F.lds + bi * BUFB; \
        DSA_LD(cl, rl_, (i) + 3); \
        const unsigned mw2 = mrb[mro + (((i) + 2 <= j) ? (i) + 2 : j)]; \
        f32x16 S = Sn; \
        const unsigned mcur = mw >> (4 * hi); \
        _Pragma("unroll") for (int r = 0; r < 16; ++r) S[r] = ((mcur >> ((r & 3) + 8 * (r >> 2))) & 1u) ? S[r] : -INFINITY; \
        float mt = fmax3(fmax3(S[0], S[1], S[2]), fmax3(S[3], S[4], S[5]), fmax3(S[6], S[7], S[8])); \
        mt = fmax3(mt, fmax3(S[9], S[10], S[11]), fmax3(S[12], S[13], fmax3(S[14], S[15], S[15]))); \
        DSA_QK(Sn, F.lds + b1 * BUFB); \
        { auto rrx = __builtin_amdgcn_permlane32_swap(__float_as_uint(mt), __float_as_uint(mt), false, false); mt = fmax3(__uint_as_float(rrx[0]), __uint_as_float(rrx[1]), mt); } \
        bf16x8 pf[2]; \
        softmax_tile_m<4>(S, mt, m, l, o, pf); \
        _Pragma("unroll") for (int dt = 0; dt < 4; ++dt) \
            _Pragma("unroll") for (int ks = 0; ks < 2; ++ks) { const bf16x8 vf = trfrag(cur + ta0 + 4096 * ks + 512 * dt, cur + ta1 + 4096 * ks + 512 * dt); o[dt] = MFMA32(vf, pf[ks], o[dt]); } \
        { LAS unsigned char* nx = F.lds + b2 * BUFB; *(LAS v4u*)(nx + wcs) = cw; if (rl) *(LAS v4u*)(nx + wrs) = rw; } \
        mw = mw1; mw1 = mw2; bi = b1; \
        asm volatile("s_waitcnt lgkmcnt(0)" ::: "memory"); __builtin_amdgcn_s_barrier(); asm volatile("" ::: "memory"); } while (0)
    for (int c = blockIdx.x; c < 256; c += gridDim.x) {
        for (int ui = 0; ui < 8; ++ui) {
            const int b = unit_batch(c, ui), j = unit_qtile(c, ui); const size_t tok0 = (size_t)b * SEQ + 32 * j;
#define UPTR(ty, nm, ex) const ty* nm = (ex); asm volatile("" : "+s"(nm))
            UPTR(bf16, qlb, QL + tok0 * 512 + h * 64); UPTR(bf16, qrb, QR + tok0 * 256 + h * 32); UPTR(v4u, wkb, WUKF + h * 1024); UPTR(unsigned, mrb, MASK + tok0 * 64);
            UPTR(bf16, cbb, CKV + (size_t)b * SEQ * 128); UPTR(bf16, rbb, KR + (size_t)b * SEQ * 32);
            const int qo = q * 512 + 8 * hi, ro = q * 256 + 8 * hi;
            bf16x8 qf[10];
            {
              bf16x8 qn[4];
#pragma unroll
              for (int ks = 0; ks < 4; ++ks) qn[ks] = *(const bf16x8*)(qlb + qo + 16 * ks);
#pragma unroll
              for (int ct = 0; ct < 4; ++ct) { f32x16 X = (f32x16){};
#pragma unroll
                  for (int ks = 0; ks < 4; ++ks) { const bf16x8 wf = __builtin_bit_cast(bf16x8, wkb[(ct * 4 + ks) * 64 + lane]); X = MFMA32(wf, qn[ks], X); }
                  u32x4_t w0, w1; w0.x = cvtpk(X[0], X[1]); w0.y = cvtpk(X[2], X[3]); w0.z = cvtpk(X[4], X[5]); w0.w = cvtpk(X[6], X[7]); w1.x = cvtpk(X[8], X[9]); w1.y = cvtpk(X[10], X[11]); w1.z = cvtpk(X[12], X[13]); w1.w = cvtpk(X[14], X[15]);
                  qf[2 * ct] = __builtin_bit_cast(bf16x8, w0); qf[2 * ct + 1] = __builtin_bit_cast(bf16x8, w1); } }
#pragma unroll
            for (int ks = 0; ks < 2; ++ks) qf[8 + ks] = *(const bf16x8*)(qrb + ro + 16 * ks);
            f32x16 o[4];
#pragma unroll
            for (int d = 0; d < 4; ++d) o[d] = (f32x16){};
            float m = -1e30f, l = 0.f;
            const int cbo = 8 * tid, rbo = 8 * (tid & 127), mro = q * 64;
            v4u cA, rA, cB, rB;
            { v4u c0, r0, c1, r1; DSA_LD(c0, r0, 0); DSA_LD(c1, r1, 1); DSA_LD(cA, rA, 2);
              *(LAS v4u*)(F.lds + wcs) = c0; if (rl) *(LAS v4u*)(F.lds + wrs) = r0; *(LAS v4u*)(F.lds + BUFB + wcs) = c1; if (rl) *(LAS v4u*)(F.lds + BUFB + wrs) = r1; }
            unsigned mw = mrb[mro], mw1 = mrb[mro + ((1 <= j) ? 1 : j)];
#pragma unroll
            for (int ks = 0; ks < 10; ++ks) asm volatile("" : "+v"(qf[ks]));
            asm volatile("s_waitcnt lgkmcnt(0)" ::: "memory"); __builtin_amdgcn_s_barrier(); asm volatile("" ::: "memory");
            f32x16 Sn; DSA_QK(Sn, F.lds);
            int bi = 0;
            for (int i = 0; i <= j; i += 2) {
                DSA_TILE(i, cA, rA, cB, rB);
                if (i + 1 <= j) DSA_TILE(i + 1, cB, rB, cA, rA);
            }
            l += __shfl_xor(l, 32); const float il = 1.0f / l;
            UPTR(v4u, wvb, WUVF + h * 1024); UPTR(bf16, hxb, HX + tok0 * KOUT + h * 64);
            f32x16 oa[2]; oa[0] = (f32x16){}; oa[1] = (f32x16){};
#pragma unroll
            for (int dt = 0; dt < 4; ++dt) {
                u32x4_t w0, w1; w0.x = cvtpk(o[dt][0] * il, o[dt][1] * il); w0.y = cvtpk(o[dt][2] * il, o[dt][3] * il); w0.z = cvtpk(o[dt][4] * il, o[dt][5] * il); w0.w = cvtpk(o[dt][6] * il, o[dt][7] * il);
                w1.x = cvtpk(o[dt][8] * il, o[dt][9] * il); w1.y = cvtpk(o[dt][10] * il, o[dt][11] * il); w1.z = cvtpk(o[dt][12] * il, o[dt][13] * il); w1.w = cvtpk(o[dt][14] * il, o[dt][15] * il);
                const bf16x8 of0 = __builtin_bit_cast(bf16x8, w0), of1 = __builtin_bit_cast(bf16x8, w1);
#pragma unroll
                for (int vt = 0; vt < 2; ++vt) { oa[vt] = MFMA32(__builtin_bit_cast(bf16x8, wvb[((vt * 4 + dt) * 2 + 0) * 64 + lane]), of0, oa[vt]);
                                                 oa[vt] = MFMA32(__builtin_bit_cast(bf16x8, wvb[((vt * 4 + dt) * 2 + 1) * 64 + lane]), of1, oa[vt]); }
            }
            bf16* orow = (bf16*)hxb + q * KOUT + 4 * hi;
#pragma unroll
            for (int vt = 0; vt < 2; ++vt)
#pragma unroll
                for (int g = 0; g < 4; ++g) { v2u w; w.x = cvtpk(oa[vt][4 * g], oa[vt][4 * g + 1]); w.y = cvtpk(oa[vt][4 * g + 2], oa[vt][4 * g + 3]); *(v2u*)(orow + 32 * vt + 8 * g) = w; }
            asm volatile("s_waitcnt lgkmcnt(0)" ::: "memory"); __builtin_amdgcn_s_barrier(); asm volatile("" ::: "memory");
        }
    }
#undef DSA_QK
#undef DSA_LD
#undef DSA_TILE
#undef UPTR
}
__device__ __forceinline__ void p3_dilated_mfma2(Frame& F) {
    const bf16 *QB = wsp<bf16>(F, WS_QB), *KB = wsp<bf16>(F, WS_KB), *VB = wsp<bf16>(F, WS_VB); bf16* HX = wsp<bf16>(F, WS_HX);
    const int lane = F.lane, q = lane & 31, hi = lane >> 5, h = F.wave;
    LAS unsigned char* kimg = F.lds + F.wave * 16384; LAS unsigned char* vimg = kimg + 4096;
    const unsigned ra0 = rowread_addr<8>(lane, 0), ra1 = rowread_addr<8>(lane, 1);
    const unsigned ta0 = trread_addr<8>(lane, 0, 0, 0), ta1 = trread_addr<8>(lane, 0, 0, 1);
    const unsigned wa_e = off_img<8>(lane >> 3, lane & 7), wa_o = off_img<8>((lane >> 3) + 8, lane & 7) - 1024;
    const int grow0 = (lane >> 3) * 512 + (lane & 7) * 8;
    float bfar[16]; unsigned m4bits = 0u;
#pragma unroll
    for (int r = 0; r < 16; ++r) { const int d0 = q - crow(r, hi); bfar[r] = ((d0 & 15) == 0) ? 0.f : -INFINITY; m4bits |= (((d0 & 3) == 0) ? 1u : 0u) << r; }
    for (int c = blockIdx.x; c < 256; c += gridDim.x) {
        const int sl = c >> 3;
        for (int ui = 0; ui < 4; ++ui) {
            const int b = 4 * (c & 7) + ui, jj = (ui & 1) ? 31 - sl : sl; const size_t tok0 = (size_t)b * SEQ + 64 * jj;
            bf16x8 qf[2][4];
#pragma unroll
            for (int t = 0; t < 2; ++t)
#pragma unroll
                for (int ks = 0; ks < 4; ++ks) qf[t][ks] = *(const bf16x8*)(QB + (tok0 + 32 * t + q) * 512 + h * 64 + 16 * ks + 8 * hi);
            f32x16 o[2][2];
#pragma unroll
            for (int t = 0; t < 2; ++t) { o[t][0] = (f32x16){}; o[t][1] = (f32x16){}; }
            float m[2] = {-1e30f, -1e30f}, l[2] = {0.f, 0.f};
            const bf16* kb = KB + (size_t)b * SEQ * 512 + h * 64; const bf16* vb = VB + (size_t)b * SEQ * 512 + h * 64;
            const int nt = 2 * jj + 2;
            v4u kr[4], vr[4];
#pragma unroll
            for (int p = 0; p < 4; ++p) { const bf16* kt = kb; const bf16* vt = vb; asm volatile("" : "+s"(kt)); asm volatile("" : "+s"(vt)); kr[p] = *(const v4u*)(kt + grow0 + 4096 * p); vr[p] = *(const v4u*)(vt + grow0 + 4096 * p); }
#pragma unroll
            for (int t = 0; t < 2; ++t)
#pragma unroll
                for (int ks = 0; ks < 4; ++ks) asm volatile("" : "+v"(qf[t][ks]));
            for (int i = 0; i < nt; ++i) {
#pragma unroll
                for (int p = 0; p < 4; ++p) { *(LAS v4u*)(kimg + ((p & 1) ? wa_o : wa_e) + 1024 * p) = kr[p]; *(LAS v4u*)(vimg + ((p & 1) ? wa_o : wa_e) + 1024 * p) = vr[p]; }
                { const int i1 = (i + 1 < nt) ? i + 1 : i; const bf16* kt = kb + (size_t)i1 * 32 * 512; const bf16* vt = vb + (size_t)i1 * 32 * 512;
                  asm volatile("" : "+s"(kt)); asm volatile("" : "+s"(vt));
#pragma unroll
                  for (int p = 0; p < 4; ++p) { kr[p] = *(const v4u*)(kt + grow0 + 4096 * p); vr[p] = *(const v4u*)(vt + grow0 + 4096 * p); } }
                f32x16 S[2]; bf16x8 pf[2][2];
                S[0] = (f32x16){}; S[1] = (f32x16){};
#pragma unroll
                for (int ks = 0; ks < 4; ++ks) { const bf16x8 kf = *(const LAS bf16x8*)(kimg + ((ks & 1) ? ra1 : ra0) + 512 * (ks >> 1)); S[0] = MFMA32(kf, qf[0][ks], S[0]); S[1] = MFMA32(kf, qf[1][ks], S[1]); }
#pragma unroll
                for (int t = 0; t < 2; ++t) {
                    const int dlt = 32 * (2 * jj + t - i);
                    if (dlt > 512) {
#pragma unroll
                        for (int r = 0; r < 16; ++r) S[t][r] += bfar[r];
                    } else if (dlt >= 192 && dlt < 512) {
#pragma unroll
                        for (int r = 0; r < 16; ++r) S[t][r] += (bfar[r] == 0.f) ? 1.f : (((m4bits >> r) & 1u) ? 0.f : -INFINITY);
                    } else {
#pragma unroll
                        for (int r = 0; r < 16; ++r) { const int df = dlt + q - crow(r, hi);
                            int w = (df <= 128 ? 1 : 0) + ((((df & 3) == 0) && df <= 512) ? 1 : 0) + (((df & 15) == 0) ? 1 : 0); if (df < 0) w = 0;
                            S[t][r] += (w == 0) ? -INFINITY : (w == 1) ? 0.f : (w == 2) ? 1.f : 1.5849625007211562f; }
                    }
                    softmax_tile<2>(S[t], m[t], l[t], o[t], pf[t]);
                }
#pragma unroll
                for (int dt = 0; dt < 2; ++dt)
#pragma unroll
                    for (int ks = 0; ks < 2; ++ks) { const bf16x8 vf = trfrag(vimg + ta0 + 2048 * ks + 512 * dt, vimg + ta1 + 2048 * ks + 512 * dt);
                        o[0][dt] = MFMA32(vf, pf[0][ks], o[0][dt]); o[1][dt] = MFMA32(vf, pf[1][ks], o[1][dt]); }
            }
#pragma unroll
            for (int t = 0; t < 2; ++t) {
                float lt = l[t]; lt += __shfl_xor(lt, 32); const float il = 1.0f / lt;
                bf16* orow = HX + (tok0 + 32 * t + q) * KOUT + 512 + h * 64 + 4 * hi;
#pragma unroll
                for (int dt = 0; dt < 2; ++dt)
#pragma unroll
                    for (int g = 0; g < 4; ++g) { v2u w; w.x = cvtpk(o[t][dt][4 * g] * il, o[t][dt][4 * g + 1] * il); w.y = cvtpk(o[t][dt][4 * g + 2] * il, o[t][dt][4 * g + 3] * il); *(v2u*)(orow + 32 * dt + 8 * g) = w; }
            }
        }
    }
}

__device__ __forceinline__ void p10_final(Frame& F) {
    const float* parts = wsp<float>(F, WS_P3); const float* g = inp(F, 16); const bf16* XB = wsp<bf16>(F, WS_XB);
    f32x4 gv[4];
#pragma unroll
    for (int j = 0; j < 4; ++j) gv[j] = *((const f32x4*)g + F.lane + 64 * j);
    for (int r0 = F.gw; r0 < T; r0 += 4 * F.NGW) {
        v2u w[4][4]; float rs[4];
#pragma unroll
        for (int u = 0; u < 4; ++u) { const int r = r0 + u * F.NGW; const v2u* xi = (const v2u*)(XB + (size_t)r * DM) + F.lane;
#pragma unroll
            for (int j = 0; j < 4; ++j) w[u][j] = xi[64 * j];
            rs[u] = rstd_from_parts(parts, r); }
#pragma unroll
        for (int u = 0; u < 4; ++u) { const int r = r0 + u * F.NGW; f32x4* o = (f32x4*)(outp(F) + (size_t)r * DM) + F.lane;
#pragma unroll
            for (int j = 0; j < 4; ++j) o[64 * j] = (f32x4){bflo(w[u][j].x), bfhi(w[u][j].x), bflo(w[u][j].y), bfhi(w[u][j].y)} * rs[u] * gv[j]; }
    }
}

#define RLX_AGENT __ATOMIC_RELAXED, __HIP_MEMORY_SCOPE_AGENT
#define XB_TMO      128
#define XB_XCNT(j)  (256  + 64 * (j))
#define XB_XSUB(j)  (1280 + 64 * (j))
#define XB_XGEN(j)  (2304 + 64 * (j))
#define XB_TOP      3328
#define XB_TOPGEN   3392
#define XCD_BAR_WORDS 3456
#define XB_SPIN_CAP (1u << 18)

__device__ __forceinline__ unsigned xb_ld(unsigned* p)              { return __hip_atomic_load(p, __ATOMIC_RELAXED, __HIP_MEMORY_SCOPE_AGENT); }
__device__ __forceinline__ unsigned xb_add(unsigned* p, unsigned v) { return __hip_atomic_fetch_add(p, v, __ATOMIC_RELAXED, __HIP_MEMORY_SCOPE_AGENT); }
__device__ __forceinline__ unsigned xb_xcc_id() { return (unsigned)__builtin_amdgcn_s_getreg((3 << 11) | 20) & 0xFu; }
#define XB_SPIN(cond, bar) do { unsigned _sp = 0; while (cond) { __builtin_amdgcn_s_sleep(1); \
    if ((++_sp & 255u) == 0u) { if (xb_ld(&(bar)[XB_TMO])) break; if (_sp > XB_SPIN_CAP) { atomicAdd(&(bar)[XB_TMO], 1u); break; } } } } while (0)

struct XcdBarrier {
    unsigned* bar; unsigned x;
    volatile LAS unsigned* st;
};

__device__ __forceinline__ XcdBarrier xcd_barrier_post(unsigned* bar, volatile LAS unsigned* st) {
    XcdBarrier b; b.bar = bar; b.x = xb_xcc_id(); b.st = st;
    if (threadIdx.x == 0) (void)xb_add(&bar[XB_XCNT(b.x)], 1u);
    return b;
}
__device__ __forceinline__ void xcd_barrier_complete(unsigned* bar, unsigned x, unsigned& nloc, unsigned& nx) {
    const unsigned G = gridDim.x * gridDim.y * gridDim.z;
    unsigned sum, cnt, mine, sp = 0u;
    for (;;) {
        sum = 0u; cnt = 0u; mine = 0u;
#pragma unroll
        for (unsigned j = 0; j < 16; ++j) { const unsigned c = xb_ld(&bar[XB_XCNT(j)]); sum += c; cnt += (c > 0u) ? 1u : 0u; mine = (j == x) ? c : mine; }
        if (sum == G) break;
        __builtin_amdgcn_s_sleep(1);
        if ((++sp & 255u) == 0u) { if (xb_ld(&bar[XB_TMO])) break; if (sp > XB_SPIN_CAP) { atomicAdd(&bar[XB_TMO], 1u); break; } }
    }
    nloc = mine > 0u ? mine : 1u; nx = cnt > 0u ? cnt : 1u;
}

__device__ __forceinline__ void xcd_barrier(const XcdBarrier& b, const bool t0) {
    asm volatile("s_waitcnt vmcnt(0)" ::: "memory");
    __syncthreads();
    if (t0) {
        unsigned* bar = b.bar;
        __builtin_amdgcn_s_waitcnt(0);
        unsigned nloc = b.st[0], nx = b.st[1];
        if (nloc == 0u) { xcd_barrier_complete(bar, b.x, nloc, nx); b.st[0] = nloc; b.st[1] = nx; }
        const unsigned old = xb_add(&bar[XB_XSUB(b.x)], 1u);
        const unsigned gen = old / nloc;
        if (old + 1u == (gen + 1u) * nloc) {
            __builtin_amdgcn_fence(__ATOMIC_RELEASE, "agent");
            asm volatile("s_waitcnt vmcnt(0)" ::: "memory");
            const unsigned og = xb_add(&bar[XB_TOP], 1u);
            const unsigned tg = og / nx;
            if (og + 1u == (tg + 1u) * nx) xb_add(&bar[XB_TOPGEN], 1u);
            else XB_SPIN(xb_ld(&bar[XB_TOPGEN]) == tg, bar);
            __builtin_amdgcn_fence(__ATOMIC_ACQUIRE, "agent");
            xb_add(&bar[XB_XGEN(b.x)], 1u);
            asm volatile("s_waitcnt vmcnt(0)" ::: "memory");
        } else {
            XB_SPIN(xb_ld(&bar[XB_XGEN(b.x)]) == gen, bar);
            __builtin_amdgcn_fence(__ATOMIC_ACQUIRE, "agent");
            asm volatile("s_waitcnt vmcnt(0)" ::: "memory");
        }
    }
    __syncthreads();
}

struct Args { const float* in[17]; float* out; unsigned char* ws; int ph_lo, ph_hi; };
__global__ void __launch_bounds__(NWAVES * 64, 2) fwd_kernel(Args args) {
    extern __shared__ __attribute__((aligned(16))) unsigned char lds[];
    cg::grid_group grid = cg::this_grid();
    Frame F;
    F.lds = (LAS unsigned char*)lds;
    F.kargs = (const __attribute__((address_space(4))) char*)__builtin_amdgcn_kernarg_segment_ptr();
    F.out = args.out; F.ws = args.ws; F.wave_s = __builtin_amdgcn_readfirstlane((int)threadIdx.x >> 6); phase_ctx(F);
    volatile LAS unsigned* MISC = (volatile LAS unsigned*)(F.lds + 131072 + 64);
    if (threadIdx.x < 16) MISC[threadIdx.x] = 0u;
    __syncthreads();
    XcdBarrier bar = xcd_barrier_post((unsigned*)(args.ws + WS_CTL) + 1024, MISC + 8);
    const int lo = args.ph_lo, hi = args.ph_hi;
    if (hi < 0) grid.sync();
#define IN(k) (((PH_MASK >> (k)) & 1) && lo <= (k) && (k) < hi)
#define SEAM(k) do { if (IN(k) && IN((k) + 1)) { phase_ctx(F); xcd_barrier(bar, F.tid == 0); } phase_ctx(F); } while (0)
    LAS unsigned char* ring = (LAS unsigned char*)lds;

    if (IN(0)) { p0_prologue(F); if (DUP_MASK & 1) p0_prologue(F); }
    SEAM(0);
    if (IN(1)) for (int rep_ = 0; rep_ < ((DUP_MASK & 2) ? 2 : 1); ++rep_) {
        { pg8::Gemm g{wsp<bf16>(F, WS_XB), wsp<bf16>(F, WS_WIN), T, NIN, DM, DM, DM}; pg8::StaticOrder S; S.init(g, F.G, (int)blockIdx.x);
          EpiInProj E{wsp<float>(F, WS_RSTD1), wsp<float>(F, WS_TAB64), wsp<float>(F, WS_TAB32), wsp<bf16>(F, WS_QL), wsp<bf16>(F, WS_QR), wsp<bf16>(F, WS_KR), wsp<bf16>(F, WS_KI), wsp<bf16>(F, WS_QI), wsp<bf16>(F, WS_QB), wsp<bf16>(F, WS_KB), wsp<bf16>(F, WS_VB), wsp<float>(F, WS_CKVF), wsp<float>(F, WS_WI)};
          pg8::gemm_phase<EpiInProj, pg8::StaticOrder, true, true>(ring, g, S, E, F.wave); }
        { pg8::Gemm g{wsp<bf16>(F, WS_MEMB), wsp<bf16>(F, WS_WKV), TM, 2048, DM, DM, DM};
          KvOrder S{F.G, (int)blockIdx.x, (const char*)wsp<bf16>(F, WS_MEMB), (const char*)wsp<bf16>(F, WS_WKV)};
          EpiKv E{wsp<bf16>(F, WS_KVC), wsp<bf16>(F, WS_KVC) + (size_t)TM * DM, wsp<float>(F, WS_RSTDM)};
          pg8::gemm_phase<EpiKv, KvOrder, true, true>(ring, g, S, E, F.wave); }
    }
    SEAM(1);
    if (IN(2)) { p2_ckv_norm(F); p2_index_mfma(F); if (DUP_MASK & 4) { __syncthreads(); p2_index_mfma(F); } }
    SEAM(2);
    if (IN(3)) { p3_dsa_mfma5(F); if (DUP_MASK & 8) p3_dsa_mfma5(F); p3_dilated_mfma2(F); if (DUP_MASK & 16) p3_dilated_mfma2(F); }
    SEAM(3);
    if (IN(4)) {
        pg8::Gemm g{wsp<bf16>(F, WS_HX), wsp<bf16>(F, WS_WOUT), T, DM, KOUT, KOUT, KOUT}; pg8::StaticOrder S; S.init(g, F.G, (int)blockIdx.x);
        EpiResid E{wsp<bf16>(F, WS_XB), wsp<float>(F, WS_P1)};
        pg8::gemm_phase<EpiResid, pg8::StaticOrder, true, true>(ring, g, S, E, F.wave);
    }
    SEAM(4);
    if (IN(5)) for (int rep_ = 0; rep_ < ((DUP_MASK & 32) ? 2 : 1); ++rep_) {
        pg8::Gemm g{wsp<bf16>(F, WS_XB), wsp<bf16>(F, WS_WQ), T, DM, DM, DM, DM}; pg8::StaticOrder S; S.init(g, F.G, (int)blockIdx.x);
        EpiRowScale<0> E{wsp<bf16>(F, WS_QC), DM, nullptr, wsp<float>(F, WS_P1), SCALE_C};
        pg8::gemm_phase<EpiRowScale<0>, pg8::StaticOrder, true, true>(ring, g, S, E, F.wave);
    }
    SEAM(5);
    if (IN(6)) {
        { pg8::Gemm g{wsp<bf16>(F, WS_QC), wsp<bf16>(F, WS_KVC), T, 256, 256, DM, DM};
          CrossOrder S{F.G, (int)blockIdx.x, (const char*)wsp<bf16>(F, WS_QC), (const char*)wsp<bf16>(F, WS_KVC), (size_t)MEMT * DM * 2, (size_t)256 * 2};
          EpiSoftmaxP E{wsp<bf16>(F, WS_QC), (LAS float*)(F.lds + 131072 + 1024)};
          pg8::gemm_phase<EpiSoftmaxP, CrossOrder, true, true>(ring, g, S, E, F.wave); }
        phase_ctx(F); xcd_barrier(bar, F.tid == 0); phase_ctx(F);
        { pg8::Gemm g{wsp<bf16>(F, WS_QC), wsp<bf16>(F, WS_KVC) + (size_t)TM * DM, T, 256, 256, DM, TM};
          CrossOrder S{F.G, (int)blockIdx.x, (const char*)wsp<bf16>(F, WS_QC), (const char*)(wsp<bf16>(F, WS_KVC) + (size_t)TM * DM), (size_t)MEMT * 2, (size_t)256 * TM * 2};
          EpiRowScale<2> E{wsp<bf16>(F, WS_OC), DM, nullptr, nullptr, 1.0f};
          pg8::gemm_phase<EpiRowScale<2>, CrossOrder, true, true>(ring, g, S, E, F.wave); }
    }
    SEAM(6);
    if (IN(7)) {
        pg8::Gemm g{wsp<bf16>(F, WS_OC), wsp<bf16>(F, WS_WO), T, DM, DM, DM, DM}; pg8::StaticOrder S; S.init(g, F.G, (int)blockIdx.x);
        EpiResid E{wsp<bf16>(F, WS_XB), wsp<float>(F, WS_P2)};
        pg8::gemm_phase<EpiResid, pg8::StaticOrder, true, true>(ring, g, S, E, F.wave);
    }
    SEAM(7);
    if (IN(8)) for (int rep_ = 0; rep_ < ((DUP_MASK & 64) ? 2 : 1); ++rep_) {
        pg8::Gemm g{wsp<bf16>(F, WS_XB), wsp<bf16>(F, WS_WUP), T, FF, DM, DM, DM}; pg8::StaticOrder S; S.init(g, F.G, (int)blockIdx.x);
        EpiRowScale<1> E{wsp<bf16>(F, WS_HID), FF, nullptr, wsp<float>(F, WS_P2), 1.0f};
        pg8::gemm_phase<EpiRowScale<1>, pg8::StaticOrder, true, true>(ring, g, S, E, F.wave);
    }
    SEAM(8);
    if (IN(9)) {
        pg8::Gemm g{wsp<bf16>(F, WS_HID), wsp<bf16>(F, WS_WDN), T, DM, FF, FF, FF}; pg8::StaticOrder S; S.init(g, F.G, (int)blockIdx.x);
        EpiResid E{wsp<bf16>(F, WS_XB), wsp<float>(F, WS_P3)};
        pg8::gemm_phase<EpiResid, pg8::StaticOrder, true, true>(ring, g, S, E, F.wave);
    }
    SEAM(9);
    if (IN(10)) { p10_final(F); }
#undef IN
#undef SEAM
}

#ifndef N_LAUNCH_SPLIT
#define N_LAUNCH_SPLIT 0
#endif
extern "C" void kernel_launch(void* const* d_in, const int* in_sizes, int n_in, void* d_out, int out_size, void* d_ws, size_t ws_size, hipStream_t stream) {
    static int grid = 0;
    if (grid == 0) {
        if (n_in != 17 || out_size != T * DM || ws_size < WS_END) { fprintf(stderr, "kernel_launch: unexpected shapes: n_in %d out %d ws %zu\n", n_in, out_size, ws_size); grid = -1; return; }
        int dev = 0, cus = 0, per_cu = 0;
        if (hipGetDevice(&dev) != hipSuccess || hipDeviceGetAttribute(&cus, hipDeviceAttributeMultiprocessorCount, dev) != hipSuccess) { grid = -1; return; }
        if (hipFuncSetAttribute((const void*)fwd_kernel, hipFuncAttributeMaxDynamicSharedMemorySize, LDS_BYTES) != hipSuccess) { fprintf(stderr, "hipFuncSetAttribute failed\n"); grid = -1; return; }
        if (hipOccupancyMaxActiveBlocksPerMultiprocessor(&per_cu, (const void*)fwd_kernel, NWAVES * 64, LDS_BYTES) != hipSuccess || per_cu < 1) { fprintf(stderr, "occupancy query: %d\n", per_cu); per_cu = 1; }
        (void)hipGetLastError();
        grid = cus;
        fprintf(stderr, "kernel_launch: cus %d per_cu %d grid %d ws %zu\n", cus, per_cu, grid, ws_size);
    }
    if (grid < 0) return;
    if (hipMemsetAsync((char*)d_ws + WS_CTL, 0, 65536, stream) != hipSuccess) { fprintf(stderr, "memset failed\n"); return; }
    Args a{};
    for (int i = 0; i < 17; ++i) a.in[i] = (const float*)d_in[i];
    a.out = (float*)d_out; a.ws = (unsigned char*)d_ws;
#if N_LAUNCH_SPLIT
    for (int p = 0; p < 11; ++p) { a.ph_lo = p; a.ph_hi = p + 1; void* kargs[] = {&a};
        hipError_t e = hipLaunchCooperativeKernel((const void*)fwd_kernel, dim3(grid), dim3(NWAVES * 64), kargs, LDS_BYTES, stream);
        if (e != hipSuccess) { fprintf(stderr, "launch %d failed: %s\n", p, hipGetErrorString(e)); break; } }
#else
    a.ph_lo = 0; a.ph_hi = 11; void* kargs[] = {&a};
    hipError_t e = hipLaunchCooperativeKernel((const void*)fwd_kernel, dim3(grid), dim3(NWAVES * 64), kargs, LDS_BYTES, stream);
    if (e != hipSuccess) fprintf(stderr, "cooperative launch failed: %s (grid %d)\n", hipGetErrorString(e), grid);
#endif
}
```

```cpp
#include <hip/hip_runtime.h>
#include <hip/hip_cooperative_groups.h>
#include <cstdio>
#include <cstdint>
namespace cg = cooperative_groups;
namespace pg8 {
#define PG8_LAS __attribute__((address_space(3)))
typedef unsigned short bf16_t;
typedef short bf16x8 __attribute__((ext_vector_type(8)));
typedef float f32x4 __attribute__((ext_vector_type(4)));
typedef unsigned u32x4 __attribute__((ext_vector_type(4)));
constexpr int BM = 256, BK = 64, HALF = 128, HTB = HALF * BK * 2  , STAGE_BYTES = 8 * HTB, NXCD = 8, WGM = 8;

__host__ __device__ __forceinline__ int lds_byte(int r, int c) { const int st = (r >> 4) * 2 + (c >> 5), rr = r & 15, cc = c & 31, ob = rr * 64 + cc * 2; return st * 1024 + (ob ^ (((ob >> 9) & 1) << 5)); }
__host__ __device__ __forceinline__ void stage_rc(int b, int& R, int& C) { const int st = b / 1024, sb = b % 1024, swz = sb ^ (((sb >> 9) & 1) << 5); R = (st >> 1) * 16 + swz / 64; C = (st & 1) * 32 + (swz % 64) / 2; }
__host__ __device__ __forceinline__ int perm32(int rho) { const int n = rho >> 4, i = rho & 15; return 8 * (i >> 2) + 4 * n + (i & 3); }

struct Unit { int pm, pn; const char* pa; const char* pb; };
struct Gemm { const bf16_t* A; const bf16_t* Bt; int M, N, K, lda, ldb; };

struct StaticOrder {
    int nM, nN, nwg, G, c; const char* A; const char* B; size_t ta, tb;
    __host__ __device__ void init(const Gemm& g, int G_, int c_) { nM = g.M / BM; nN = g.N / BM; nwg = nM * nN; G = G_; c = c_; A = (const char*)g.A; B = (const char*)g.Bt; ta = (size_t)BM * g.lda * 2; tb = (size_t)BM * g.ldb * 2; }
    __host__ __device__ bool next(int i, Unit& u) const {
        const long L = (long)i * G + c; if (L >= nwg) return false;
        int wgid = (int)L; { const int q = nwg / NXCD, r = nwg % NXCD, xcd = wgid % NXCD, off = wgid / NXCD; wgid = (xcd < r ? xcd * (q + 1) : r * (q + 1) + (xcd - r) * q) + off; }
        const int nig = WGM * nN, gid = wgid / nig, fm = gid * WGM, gsz = (nM - fm) < WGM ? (nM - fm) : WGM;
        u.pm = fm + ((wgid % nig) % gsz); u.pn = (wgid % nig) / gsz; u.pa = A + (size_t)u.pm * ta; u.pb = B + (size_t)u.pn * tb; return true;
    }
    __device__ __forceinline__ void a_ready(const Unit&) const {}
    __device__ __forceinline__ void done(const Unit&) const {}
};


template <class Epi, class Sched, bool ALIGN_EPI = false, bool SP2 = false>
__device__ __forceinline__ void gemm_phase(PG8_LAS unsigned char* lds, const Gemm g, const Sched& S, const Epi& E, int wave_id) {
    unsigned ones_ = ~0u; asm volatile("" : "+s"(ones_));
    int tid_ = wave_id * 64 + (int)__builtin_amdgcn_mbcnt_hi(ones_, __builtin_amdgcn_mbcnt_lo(ones_, 0u)); asm volatile("" : "+v"(tid_));
    const int tid = tid_, wid = __builtin_amdgcn_readfirstlane(tid >> 6), lane = tid & 63, wr = wid >> 2, wc = wid & 3, fr = lane & 15, fq = lane >> 4;
    const int K = g.K, nt = K / BK;
    unsigned voffA[2], voffB[2];
#pragma unroll
    for (int i = 0; i < 2; ++i) { int R, C; stage_rc(tid * 16 + i * 8192, R, C); const int Rb = Epi::PERM ? ((R & ~31) + perm32(R & 31)) : R;
        voffA[i] = (unsigned)(R * g.lda + C) * 2u; voffB[i] = (unsigned)(Rb * g.ldb + C) * 2u; }
    const size_t kstep = (size_t)(BK * 2);
    const size_t hstepA = (size_t)HALF * g.lda * 2, hstepB = (size_t)HALF * g.ldb * 2;
    const unsigned ldsw = (unsigned)wid * 1024u;
    const int aoff = lds_byte(wr * 64 + fr, fq * 8), boff = lds_byte(wc * 32 + fr, fq * 8);
#define PG8_SA(b, h) (((b) * 2 + (h)) * HTB)
#define PG8_SB(b, h) ((4 + (b) * 2 + (h)) * HTB)
#define PG8_STAGE(bufoff, gbase, voff) do { _Pragma("unroll") for (int _i = 0; _i < 2; ++_i) \
        __builtin_amdgcn_global_load_lds((const unsigned*)((const char*)(gbase) + (voff)[_i]), (PG8_LAS unsigned*)(lds + (bufoff) + ldsw + _i * 8192), 16, 0, 0); } while (0)
#define PG8_LDA(dst, b, h) do { _Pragma("unroll") for (int m = 0; m < 4; ++m) _Pragma("unroll") for (int k = 0; k < 2; ++k) dst[m][k] = *(const PG8_LAS bf16x8*)(lds + PG8_SA(b, h) + aoff + m * 2048 + k * 1024); } while (0)
#define PG8_LDB(dst, b, h) do { _Pragma("unroll") for (int n = 0; n < 2; ++n) _Pragma("unroll") for (int k = 0; k < 2; ++k) dst[n][k] = *(const PG8_LAS bf16x8*)(lds + PG8_SB(b, h) + boff + n * 2048 + k * 1024); } while (0)
#define PG8_MMA(ai, bj, At, Bt) do { __builtin_amdgcn_s_setprio(1); _Pragma("unroll") for (int m = 0; m < 4; ++m) _Pragma("unroll") for (int n = 0; n < 2; ++n) _Pragma("unroll") for (int k = 0; k < 2; ++k) \
        acc[ai][bj][m][n] = __builtin_amdgcn_mfma_f32_16x16x32_bf16(Bt[n][k], At[m][k], acc[ai][bj][m][n], 0, 0, 0); __builtin_amdgcn_s_setprio(0); } while (0)
#define PG8_WAIT_V(n) asm volatile("s_waitcnt vmcnt(" #n ")" ::: "memory")
#define PG8_WAIT_L(n) asm volatile("s_waitcnt lgkmcnt(" #n ")" ::: "memory")
#define PG8_BAR __builtin_amdgcn_s_barrier()
#define PG8_SCHED __builtin_amdgcn_sched_barrier(0)
    Unit cur, nxt; int ui = 0;
    if (!S.next(0, cur)) return;
    f32x4 acc[2][2][4][2];
#pragma unroll
    for (int a = 0; a < 2; ++a)
#pragma unroll
        for (int b = 0; b < 2; ++b)
#pragma unroll
            for (int m = 0; m < 4; ++m)
#pragma unroll
                for (int n = 0; n < 2; ++n) acc[a][b][m][n] = (f32x4){0.f, 0.f, 0.f, 0.f};
    bf16x8 At[4][2], B0[2][2], B1[2][2];
    const char* cA = cur.pa; const char* cB = cur.pb;
    S.a_ready(cur);
    if constexpr (SP2) {
        PG8_STAGE(PG8_SB(0, 0), cB, voffB); PG8_STAGE(PG8_SB(0, 1), cB + hstepB, voffB); PG8_STAGE(PG8_SA(0, 0), cA, voffA); PG8_STAGE(PG8_SA(0, 1), cA + hstepA, voffA);
        if (wr == 1) PG8_BAR;
        PG8_WAIT_V(2); PG8_BAR;
        PG8_STAGE(PG8_SB(1, 0), cB + kstep, voffB); PG8_STAGE(PG8_SA(1, 0), cA + kstep, voffA); PG8_STAGE(PG8_SB(1, 1), cB + hstepB + kstep, voffB);
        PG8_WAIT_V(6); PG8_BAR;
    } else {
        PG8_STAGE(PG8_SB(0, 0), cB, voffB); PG8_STAGE(PG8_SA(0, 0), cA, voffA); PG8_STAGE(PG8_SB(0, 1), cB + hstepB, voffB); PG8_STAGE(PG8_SA(0, 1), cA + hstepA, voffA);
        if (wr == 1) PG8_BAR;
        PG8_WAIT_V(4); PG8_BAR;
        PG8_STAGE(PG8_SB(1, 0), cB + kstep, voffB); PG8_STAGE(PG8_SA(1, 0), cA + kstep, voffA); PG8_STAGE(PG8_SB(1, 1), cB + hstepB + kstep, voffB);
        PG8_WAIT_V(6); PG8_BAR;
    }
    for (;;) {
        const bool has_next = S.next(ui + 1, nxt);
        const char* nA = has_next ? nxt.pa : cA; const char* nB = has_next ? nxt.pb : cB;
        for (int t = 0; t < nt; t += 2) {
            const bool last = (t == nt - 2);
            const char* a1 = cA + (size_t)(t + 1) * kstep;
            const char* a2 = last ? nA : cA + (size_t)(t + 2) * kstep; const char* b2 = last ? nB : cB + (size_t)(t + 2) * kstep;
            const char* a3 = a2 + kstep; const char* b3 = b2 + kstep;
            if (last && has_next) S.a_ready(nxt);
            if constexpr (SP2) {
            PG8_LDB(B0, 0, 0); PG8_LDB(B1, 0, 1); PG8_SCHED; PG8_LDA(At, 0, 0); PG8_STAGE(PG8_SA(1, 1), a1 + hstepA, voffA);
            PG8_WAIT_V(8); PG8_WAIT_L(0); PG8_BAR; PG8_MMA(0, 0, At, B0); PG8_MMA(0, 1, At, B1); PG8_BAR; PG8_SCHED;
            PG8_LDA(At, 0, 1); PG8_STAGE(PG8_SB(0, 0), b2, voffB); PG8_STAGE(PG8_SB(0, 1), b2 + hstepB, voffB); PG8_STAGE(PG8_SA(0, 0), a2, voffA);
            PG8_WAIT_V(8); PG8_WAIT_L(0); PG8_BAR; PG8_MMA(1, 0, At, B0); PG8_MMA(1, 1, At, B1); PG8_BAR; PG8_SCHED;
            PG8_LDB(B0, 1, 0); PG8_LDB(B1, 1, 1); PG8_SCHED; PG8_LDA(At, 1, 0); PG8_STAGE(PG8_SA(0, 1), a2 + hstepA, voffA);
            PG8_WAIT_V(8); PG8_WAIT_L(0); PG8_BAR; PG8_MMA(0, 0, At, B0); PG8_MMA(0, 1, At, B1); PG8_BAR; PG8_SCHED;
            PG8_LDA(At, 1, 1); PG8_STAGE(PG8_SB(1, 0), b3, voffB); PG8_STAGE(PG8_SB(1, 1), b3 + hstepB, voffB); PG8_STAGE(PG8_SA(1, 0), a3, voffA);
            PG8_WAIT_V(8); PG8_WAIT_L(0); PG8_BAR; PG8_MMA(1, 0, At, B0); PG8_MMA(1, 1, At, B1); PG8_BAR; PG8_SCHED;
            } else {
            PG8_LDB(B0, 0, 0); PG8_SCHED; PG8_LDA(At, 0, 0); PG8_STAGE(PG8_SA(1, 1), a1 + hstepA, voffA);
            PG8_WAIT_L(8); PG8_BAR; PG8_WAIT_L(0); PG8_MMA(0, 0, At, B0); PG8_BAR; PG8_SCHED;
            PG8_LDB(B1, 0, 1); PG8_STAGE(PG8_SB(0, 0), b2, voffB);
            PG8_BAR; PG8_WAIT_L(0); PG8_MMA(0, 1, At, B1); PG8_BAR;
            PG8_LDA(At, 0, 1); PG8_STAGE(PG8_SA(0, 0), a2, voffA);
            PG8_BAR; PG8_WAIT_L(0); PG8_MMA(1, 0, At, B0); PG8_BAR; PG8_SCHED;
            PG8_STAGE(PG8_SB(0, 1), b2 + hstepB, voffB);
            PG8_WAIT_V(6); PG8_BAR; PG8_MMA(1, 1, At, B1); PG8_BAR;
            PG8_LDB(B0, 1, 0); PG8_SCHED; PG8_LDA(At, 1, 0); PG8_STAGE(PG8_SA(0, 1), a2 + hstepA, voffA);
            PG8_WAIT_L(8); PG8_BAR; PG8_WAIT_L(0); PG8_MMA(0, 0, At, B0); PG8_BAR; PG8_SCHED;
            PG8_LDB(B1, 1, 1); PG8_STAGE(PG8_SB(1, 0), b3, voffB);
            PG8_BAR; PG8_WAIT_L(0); PG8_MMA(0, 1, At, B1); PG8_BAR;
            PG8_LDA(At, 1, 1); PG8_STAGE(PG8_SA(1, 0), a3, voffA);
            PG8_BAR; PG8_WAIT_L(0); PG8_MMA(1, 0, At, B0); PG8_BAR; PG8_SCHED;
            PG8_STAGE(PG8_SB(1, 1), b3 + hstepB, voffB);
            PG8_WAIT_V(6); PG8_BAR; PG8_MMA(1, 1, At, B1); PG8_BAR;
            }
        }
        if constexpr (ALIGN_EPI) { if (wr == 0) PG8_BAR; }
        if constexpr (!Epi::AFTER_DRAIN) { E(acc, cur, wr, wc, fr, fq); S.done(cur); }
        if (!has_next) break;
#pragma unroll
        for (int a = 0; a < 2; ++a)
#pragma unroll
            for (int b = 0; b < 2; ++b)
#pragma unroll
                for (int m = 0; m < 4; ++m)
#pragma unroll
                    for (int n = 0; n < 2; ++n) acc[a][b][m][n] = (f32x4){0.f, 0.f, 0.f, 0.f};
        cur = nxt; cA = nA; cB = nB; ++ui;
        if constexpr (ALIGN_EPI) { if (wr == 1) PG8_BAR; }
    }
    PG8_WAIT_V(0);
    if constexpr (!ALIGN_EPI) { if (wr == 0) PG8_BAR; }
    PG8_BAR;
    if constexpr (Epi::AFTER_DRAIN) { E.fused(acc, cur, wr, wc, fr, fq, lds, wid, lane); S.done(cur); }
#undef PG8_SA
#undef PG8_SB
#undef PG8_STAGE
#undef PG8_LDA
#undef PG8_LDB
#undef PG8_MMA
#undef PG8_WAIT_V
#undef PG8_WAIT_L
#undef PG8_BAR
#undef PG8_SCHED
}
}

#ifndef PH_MASK
#define PH_MASK 0x3ff
#endif
#ifndef STAG_TICKS
#define STAG_TICKS 800
#endif
#ifndef DUP_MASK
#define DUP_MASK 0
#endif

constexpr int NB = 32, SEQ = 2048, DM = 1024, T = NB * SEQ, MEMT = 256, TM = NB * MEMT, FF = 4096;
constexpr int NIN = 3072;
constexpr int KOUT = 1024;
constexpr int W_IN_COLS = 3048;
constexpr float EPS = 1e-6f, LOG2E = 1.4426950408889634f;
constexpr float SCALE_A = 0.10206207261596577f * LOG2E;
constexpr float SCALE_B = 0.125f * LOG2E;
constexpr float SCALE_C = 0.0625f * LOG2E;
constexpr float IDX_W = 0.044194173824159216f;
constexpr int NWAVES = 8;
constexpr float RESCALE_THR = 8.0f;

constexpr size_t MiB = 1u << 20;
constexpr size_t WS_CTL = 0, WS_TAB64 = 1 * MiB, WS_TAB32 = 1 * MiB + 512 * 1024, WS_RSTD1 = 2 * MiB, WS_RSTDM = 2 * MiB + 512 * 1024;
constexpr size_t WS_WUKF = 3 * MiB, WS_WUVF = 3 * MiB + 256 * 1024;
constexpr size_t WS_P1 = 4 * MiB, WS_P2 = 8 * MiB, WS_P3 = 12 * MiB;
constexpr size_t WS_WIN = 16 * MiB, WS_WOUT = 24 * MiB, WS_WQ = 28 * MiB, WS_WKV = 30 * MiB, WS_WO = 34 * MiB, WS_WUP = 36 * MiB, WS_WDN = 44 * MiB;
constexpr size_t WS_XB = 52 * MiB, WS_MEMB = 180 * MiB, WS_KVC = 196 * MiB, WS_MASK = 228 * MiB, WS_HX = 244 * MiB;
constexpr size_t WS_QL = 436 * MiB, WS_QR = 564 * MiB, WS_CKVF = 596 * MiB, WS_CKV = 628 * MiB, WS_KR = 644 * MiB, WS_KI = 648 * MiB, WS_WI = 656 * MiB, WS_QI = 658 * MiB;
constexpr size_t WS_QB = 722 * MiB, WS_KB = 786 * MiB, WS_VB = 850 * MiB;
constexpr size_t WS_ML = 4 * MiB  , WS_PB = 372 * MiB  , WS_SC = 948 * MiB  ;
constexpr size_t WS_QC = 436 * MiB, WS_MT = 692 * MiB  , WS_HID = 436 * MiB, WS_END = 1012 * MiB;

constexpr int LDS_TP = 131072 + 9216;
constexpr int LDS_BYTES = LDS_TP + 16384;

#define GAS __attribute__((address_space(1)))
#define LAS __attribute__((address_space(3)))
typedef unsigned short bf16;
typedef unsigned v4u __attribute__((ext_vector_type(4)));
typedef unsigned v2u __attribute__((ext_vector_type(2)));
typedef float f32x4 __attribute__((ext_vector_type(4)));
typedef float f32x2 __attribute__((ext_vector_type(2)));
#define LDS_WAIT() asm volatile("s_waitcnt lgkmcnt(0)" ::: "memory")

__device__ __forceinline__ unsigned f2bf(float f) { unsigned u = __builtin_bit_cast(unsigned, f); return (u + 0x7fffu + ((u >> 16) & 1u)) >> 16; }
__device__ __forceinline__ unsigned pk2(float lo, float hi) { return f2bf(lo) | (f2bf(hi) << 16); }
__device__ __forceinline__ float bflo(unsigned w) { return __uint_as_float(w << 16); }
__device__ __forceinline__ float bfhi(unsigned w) { return __uint_as_float(w & 0xffff0000u); }
__device__ __forceinline__ float wave_sum(float v) {
#pragma unroll
    for (int o = 1; o < 64; o <<= 1) v += __shfl_xor(v, o);
    return v;
}
__device__ __forceinline__ float wave_max(float v) {
#pragma unroll
    for (int o = 1; o < 64; o <<= 1) v = fmaxf(v, __shfl_xor(v, o));
    return v;
}

struct Frame {
    LAS unsigned char* lds;
    int tid, lane, wave, G, gw, NGW;
    int wave_s;
    const __attribute__((address_space(4))) char* kargs;
    float* out;
    unsigned char* ws;
    size_t z;
};
__device__ __forceinline__ const float* inp(const Frame& F, int i) {
    const __attribute__((address_space(4))) char* p = F.kargs; asm volatile("" : "+s"(p));
    const float* r_ = *(const float* const __attribute__((address_space(4)))*)(p + 8 * i);
    return (const float*)(const __attribute__((address_space(1))) float*)r_;
}
#define LAUNDER_G(p) asm volatile("" : "+s"(p))
template <class TT> __device__ __forceinline__ TT* wsp(const Frame& F, size_t off) { return (TT*)(F.ws + F.z + off); }
__device__ __forceinline__ float* outp(const Frame& F) { return (float*)((unsigned char*)F.out + F.z); }
__device__ __forceinline__ void phase_ctx(Frame& F) {
    size_t z = 0; asm volatile("" : "+s"(z)); F.z = z;
    int ws_ = F.wave_s; asm volatile("" : "+s"(ws_));
    unsigned ones_ = ~0u; asm volatile("" : "+s"(ones_));
    const int lane_ = (int)__builtin_amdgcn_mbcnt_hi(ones_, __builtin_amdgcn_mbcnt_lo(ones_, 0u));
    F.tid = ws_ * 64 + lane_; F.lane = lane_; F.wave = ws_; F.G = gridDim.x; F.gw = blockIdx.x * NWAVES + F.wave; F.NGW = F.G * NWAVES;
}

__device__ __forceinline__ float rstd_from_parts(const float* part, int row) {
    const f32x4* p = (const f32x4*)(part + (size_t)row * 16);
    const f32x4 a = p[0], b = p[1], c = p[2], d = p[3];
    const float s = ((a[0] + a[1]) + (a[2] + a[3])) + ((b[0] + b[1]) + (b[2] + b[3])) + ((c[0] + c[1]) + (c[2] + c[3])) + ((d[0] + d[1]) + (d[2] + d[3]));
    return 1.0f / sqrtf(s * (1.0f / DM) + EPS);
}
__device__ __forceinline__ f32x4 rope4(f32x4 v, f32x4 cs) { return (f32x4){v[0] * cs[0] - v[1] * cs[1], v[1] * cs[0] + v[0] * cs[1], v[2] * cs[2] - v[3] * cs[3], v[3] * cs[2] + v[2] * cs[3]}; }
typedef float f32x2_e __attribute__((ext_vector_type(2)));
typedef __bf16 bf16x2_e __attribute__((ext_vector_type(2)));
__device__ __forceinline__ unsigned cvtpk_e(float lo, float hi) { f32x2_e v = {lo, hi}; bf16x2_e b = __builtin_convertvector(v, bf16x2_e); return __builtin_bit_cast(unsigned, b); }
__device__ __forceinline__ v4u pack8(f32x4 a, f32x4 b) { v4u w; w.x = cvtpk_e(a[0], a[1]); w.y = cvtpk_e(a[2], a[3]); w.z = cvtpk_e(b[0], b[1]); w.w = cvtpk_e(b[2], b[3]); return w; }

struct TrStore {
    LAS unsigned char* tp; unsigned wo, ro; int rr, pp;
    __device__ __forceinline__ void init(LAS unsigned char* tp_, int fr, int fq) {
        tp = tp_; const int ln = fq * 16 + fr; rr = ln >> 2; pp = ln & 3;
        const unsigned zw = ((fr >> 1) & 3) | ((fr & 1) << 2), zr = ((rr >> 1) & 3) | ((rr & 1) << 2);
        wo = fr * 128 + ((fq ^ zw) << 4); ro = rr * 128 + ((pp ^ zr) << 4);
    }
    __device__ __forceinline__ void xpose(const v4u w0, const v4u w1, v4u& t0, v4u& t1) const {
        *(LAS v4u*)(tp + wo) = w0; *(LAS v4u*)(tp + (wo ^ 64u)) = w1;
        t0 = *(const LAS v4u*)(tp + ro); t1 = *(const LAS v4u*)(tp + (ro ^ 64u));
    }
};
struct EpiInProj {
    static constexpr bool PERM = true, AFTER_DRAIN = false;
    unsigned char* wsb;
    __device__ __forceinline__ void operator()(const pg8::f32x4 (&acc)[2][2][4][2], const pg8::Unit& u, int wr, int wc, int fr_in, int fq_in) const {
        int fr = fr_in, fq = fq_in; asm volatile("" : "+v"(fr), "+v"(fq));
        const float* rstd = (const float*)(wsb + WS_RSTD1); const float* tab64 = (const float*)(wsb + WS_TAB64); const float* tab32 = (const float*)(wsb + WS_TAB32);
        bf16 *QL = (bf16*)(wsb + WS_QL), *QR = (bf16*)(wsb + WS_QR), *KR = (bf16*)(wsb + WS_KR), *KI = (bf16*)(wsb + WS_KI), *QI = (bf16*)(wsb + WS_QI), *QB = (bf16*)(wsb + WS_QB), *KB = (bf16*)(wsb + WS_KB), *VB = (bf16*)(wsb + WS_VB);
        float *CKVF = (float*)(wsb + WS_CKVF), *WI = (float*)(wsb + WS_WI);
        const int pn = u.pn;
        float rsv[8];
#pragma unroll
        for (int i = 0; i < 8; ++i) rsv[i] = rstd[u.pm * 256 + (i >> 2) * 128 + wr * 64 + (i & 3) * 16 + fr];
        const bool r32 = (pn == 2) || (pn == 3 && wc == 0), r64 = (pn >= 4 && pn < 10) || (pn == 3 && (wc == 1 || wc == 2));
        const int tb64 = ((pn == 3) ? 16 * (wc - 1) : 16 * (wc & 1)) + 4 * fq;
#pragma unroll
        for (int ah = 0; ah < 4; ++ah) {
            const int ai = ah >> 1;
            f32x4 c0v[2], c1v[2];
            if (r32 || r64) {
#pragma unroll
                for (int i = 0; i < 2; ++i) { const int pos_ = (u.pm * 256 + ai * 128 + wr * 64 + (2 * (ah & 1) + i) * 16 + fr) & (SEQ - 1);
                    const float* tp = r32 ? tab32 + ((size_t)pos_ * 16 + 4 * fq) * 2 : tab64 + ((size_t)pos_ * 32 + tb64) * 2;
                    c0v[i] = *(const f32x4*)tp; c1v[i] = *(const f32x4*)(tp + 4); }
            }
#pragma unroll
            for (int mi = 0; mi < 2; ++mi) {
                const int m = 2 * (ah & 1) + mi;
                const int row = u.pm * 256 + ai * 128 + wr * 64 + m * 16 + fr;
                const float rs = rsv[ai * 4 + m];
                const f32x4 cs0 = c0v[mi], cs1 = c1v[mi];
                if (pn < 2) {
#pragma unroll
                    for (int bj = 0; bj < 2; ++bj) { const f32x4 a = acc[ai][bj][m][0] * (rs * SCALE_A), b = acc[ai][bj][m][1] * (rs * SCALE_A);
                        __builtin_nontemporal_store(pack8(a, b), (v4u*)(QL + (size_t)row * 512 + pn * 256 + bj * 128 + wc * 32 + 8 * fq)); }
                } else if (pn == 2) {
#pragma unroll
                    for (int bj = 0; bj < 2; ++bj) { const f32x4 a = rope4(acc[ai][bj][m][0] * (rs * SCALE_A), cs0), b = rope4(acc[ai][bj][m][1] * (rs * SCALE_A), cs1);
                        __builtin_nontemporal_store(pack8(a, b), (v4u*)(QR + (size_t)row * 256 + bj * 128 + wc * 32 + 8 * fq)); }
                } else if (pn == 3) {
                    { const f32x4 a = acc[ai][0][m][0] * rs, b = acc[ai][0][m][1] * rs; float* o = CKVF + (size_t)row * 128 + wc * 32 + 8 * fq; *(f32x4*)o = a; *(f32x4*)(o + 4) = b; }
                    if (wc == 0) {
                        const f32x4 a = rope4(acc[ai][1][m][0] * rs, cs0), b = rope4(acc[ai][1][m][1] * rs, cs1);
                        __builtin_nontemporal_store(pack8(a, b), (v4u*)(KR + (size_t)row * 32 + 8 * fq));
                    } else if (wc < 3) {
                        const f32x4 a = rope4(acc[ai][1][m][0] * rs, cs0), b = rope4(acc[ai][1][m][1] * rs, cs1);
                        __builtin_nontemporal_store(pack8(a, b), (v4u*)(KI + (size_t)row * 64 + 32 * (wc - 1) + 8 * fq));
                    } else if (fq == 0) {
                        const f32x4 a = acc[ai][1][m][0] * (rs * IDX_W), b = acc[ai][1][m][1] * (rs * IDX_W); float* o = WI + (size_t)row * 8; *(f32x4*)o = a; *(f32x4*)(o + 4) = b;
                    }
                } else if (pn < 10) {
                    const float sc = (pn == 6 || pn == 7) ? rs * SCALE_B : rs;
                    const size_t eoff = (size_t)row * 512 + (pn & 1) * 256 + wc * 32 + 8 * fq;
#pragma unroll
                    for (int bj = 0; bj < 2; ++bj) { const f32x4 a = rope4(acc[ai][bj][m][0] * sc, cs0), b = rope4(acc[ai][bj][m][1] * sc, cs1); const v4u w = pack8(a, b);
                        if (pn < 6) __builtin_nontemporal_store(w, (v4u*)(QI + eoff + bj * 128)); else if (pn < 8) __builtin_nontemporal_store(w, (v4u*)(QB + eoff + bj * 128)); else __builtin_nontemporal_store(w, (v4u*)(KB + eoff + bj * 128)); }
                } else {
#pragma unroll
                    for (int bj = 0; bj < 2; ++bj) { const f32x4 a = acc[ai][bj][m][0] * rs, b = acc[ai][bj][m][1] * rs;
                        __builtin_nontemporal_store(pack8(a, b), (v4u*)(VB + (size_t)row * 512 + (pn & 1) * 256 + bj * 128 + wc * 32 + 8 * fq)); }
                }
            }
        }
    }
};
template <int ACT  > struct EpiRowScale {
    static constexpr bool PERM = true, AFTER_DRAIN = false;
    bf16* O; int ldc; const float* rstd_direct; const float* parts; float cs; LAS unsigned char* tp;
    __device__ __forceinline__ void operator()(const pg8::f32x4 (&acc)[2][2][4][2], const pg8::Unit& u, int wr, int wc, int fr, int fq) const {
        TrStore X; X.init(tp, fr, fq);
        float rs[8];
        if (ACT == 2) {
#pragma unroll
            for (int i = 0; i < 8; ++i) rs[i] = 1.0f;
        } else if (parts) {
            f32x4 pv[8];
#pragma unroll
            for (int i = 0; i < 8; ++i) { const int row = u.pm * 256 + (i >> 2) * 128 + wr * 64 + (i & 3) * 16 + fr; pv[i] = *(const f32x4*)(parts + (size_t)row * 16 + 4 * fq); }
#pragma unroll
            for (int i = 0; i < 8; ++i) { float t = (pv[i][0] + pv[i][1]) + (pv[i][2] + pv[i][3]); t += __shfl_xor(t, 16); t += __shfl_xor(t, 32); rs[i] = cs / sqrtf(t * (1.0f / DM) + EPS); }
        } else {
#pragma unroll
            for (int i = 0; i < 8; ++i) { const int row = u.pm * 256 + (i >> 2) * 128 + wr * 64 + (i & 3) * 16 + fr; rs[i] = rstd_direct[row]; }
#pragma unroll
            for (int i = 0; i < 8; ++i) rs[i] *= cs;
        }
        v4u tq[2]; size_t oq = 0;
#pragma unroll
        for (int s = 0; s < 8; ++s) { const int ai = s >> 2, m = s & 3;
            const float r_ = rs[s];
            v4u w[2];
#pragma unroll
            for (int bj = 0; bj < 2; ++bj) { f32x4 a = acc[ai][bj][m][0] * r_, b = acc[ai][bj][m][1] * r_;
                if (ACT == 1) {
#pragma unroll
                    for (int e = 0; e < 4; ++e) { const float x = fmaxf(a[e], 0.f), y = fmaxf(b[e], 0.f); a[e] = x * x; b[e] = y * y; } }
                w[bj] = pack8(a, b); }
            if (s > 0) {
#pragma unroll
                for (int bj = 0; bj < 2; ++bj) { v4u* dst_ = (v4u*)(O + oq + bj * 128); if (ACT == 1) __builtin_nontemporal_store(tq[bj], dst_); else *dst_ = tq[bj]; } }
            X.xpose(w[0], w[1], tq[0], tq[1]);
            oq = (size_t)(u.pm * 256 + ai * 128 + wr * 64 + m * 16 + X.rr) * ldc + u.pn * 256 + wc * 32 + 8 * X.pp;
        }
#pragma unroll
        for (int bj = 0; bj < 2; ++bj) { v4u* dst_ = (v4u*)(O + oq + bj * 128); if (ACT == 1) __builtin_nontemporal_store(tq[bj], dst_); else *dst_ = tq[bj]; }
    }
};
struct EpiResid {
    static constexpr bool PERM = true, AFTER_DRAIN = false;
    bf16* XBio; float* parts;
    __device__ __forceinline__ void operator()(const pg8::f32x4 (&acc)[2][2][4][2], const pg8::Unit& u, int wr, int wc, int fr, int fq) const {
#pragma unroll
        for (int ai = 0; ai < 2; ++ai) {
            v4u rw[2][4][2];
#pragma unroll
            for (int m = 0; m < 4; ++m)
#pragma unroll
                for (int bj = 0; bj < 2; ++bj) rw[ai][m][bj] = *(const v4u*)(XBio + (size_t)(u.pm * 256 + ai * 128 + wr * 64 + m * 16 + fr) * DM + u.pn * 256 + bj * 128 + wc * 32 + 8 * fq);
#pragma unroll
            for (int m = 0; m < 4; ++m) {
                const int row = u.pm * 256 + ai * 128 + wr * 64 + m * 16 + fr;
                float ss = 0.f;
#pragma unroll
                for (int bj = 0; bj < 2; ++bj) { const size_t off = (size_t)row * DM + u.pn * 256 + bj * 128 + wc * 32 + 8 * fq; const v4u r_ = rw[ai][m][bj];
                    const f32x4 a = (f32x4){bflo(r_.x), bfhi(r_.x), bflo(r_.y), bfhi(r_.y)} + acc[ai][bj][m][0], b = (f32x4){bflo(r_.z), bfhi(r_.z), bflo(r_.w), bfhi(r_.w)} + acc[ai][bj][m][1];
                    *(v4u*)(XBio + off) = pack8(a, b);
                    ss += (a[0] * a[0] + a[1] * a[1]) + (a[2] * a[2] + a[3] * a[3]) + (b[0] * b[0] + b[1] * b[1]) + (b[2] * b[2] + b[3] * b[3]); }
                ss += __shfl_xor(ss, 16); ss += __shfl_xor(ss, 32);
                if (fq == 0) parts[(size_t)row * 16 + u.pn * 4 + wc] = ss;
            }
        }
    }
};

struct PreOrderA {
    int c; const char* kv; const char* wqn;
    __device__ __forceinline__ bool next(int i, pg8::Unit& u) const {
        if (i >= 2) return false;
        const int L = (c & 7) * 64 + i * 32 + (c >> 3), b = L >> 4, h = (L >> 2) & 3, pn = L & 3;
        u.pm = b * 4 + h; u.pn = pn; u.pa = kv + ((size_t)(b * 256) * 2048 + h * 256) * 2; u.pb = wqn + ((size_t)pn * 256 * DM + h * 256) * 2; return true;
    }
    __device__ __forceinline__ void a_ready(const pg8::Unit&) const {}
    __device__ __forceinline__ void done(const pg8::Unit&) const {}
};
struct PreOrderB {
    int c; const char* kv; const char* wo;
    __device__ __forceinline__ bool next(int i, pg8::Unit& u) const {
        if (i >= 2) return false;
        const int L = (c & 7) * 64 + i * 32 + (c >> 3), b = L >> 4, h = (L >> 2) & 3, pmo = L & 3;
        u.pm = 128 + b * 4 + pmo; u.pn = h; u.pa = wo + ((size_t)pmo * 256 * DM + h * 256) * 2; u.pb = kv + ((size_t)(b * 256) * 2048 + 1024 + h * 256) * 2; return true;
    }
    __device__ __forceinline__ void a_ready(const pg8::Unit&) const {}
    __device__ __forceinline__ void done(const pg8::Unit&) const {}
};
struct BatchOrder {
    pg8::StaticOrder so; size_t bstride;
    __device__ __forceinline__ bool next(int i, pg8::Unit& u) const { if (!so.next(i, u)) return false; u.pb += (size_t)(u.pm >> 3) * bstride; return true; }
    __device__ __forceinline__ void a_ready(const pg8::Unit&) const {}
    __device__ __forceinline__ void done(const pg8::Unit&) const {}
};
struct EpiSoftmaxP {
    static constexpr bool PERM = true, AFTER_DRAIN = false;
    bf16* P; LAS float* xch; const float* parts;
    __device__ __forceinline__ void operator()(const pg8::f32x4 (&acc_)[2][2][4][2], const pg8::Unit& u, int wr, int wc, int fr, int fq) const {
        pg8::f32x4 (&acc)[2][2][4][2] = const_cast<pg8::f32x4 (&)[2][2][4][2]>(acc_);
        LAS float* xb = xch + (wr * 64 + fr) * 8; asm volatile("" : "+v"(xb));
        float rs[8];
        { f32x4 pv[8];
#pragma unroll
          for (int i = 0; i < 8; ++i) { const int row = u.pm * 256 + (i >> 2) * 128 + wr * 64 + (i & 3) * 16 + fr; pv[i] = *(const f32x4*)(parts + (size_t)row * 16 + 4 * fq); }
#pragma unroll
          for (int i = 0; i < 8; ++i) { float t = (pv[i][0] + pv[i][1]) + (pv[i][2] + pv[i][3]); t += __shfl_xor(t, 16); t += __shfl_xor(t, 32); rs[i] = 1.0f / sqrtf(t * (1.0f / DM) + EPS); } }
#pragma unroll
        for (int ai = 0; ai < 2; ++ai)
#pragma unroll
            for (int m = 0; m < 4; ++m) {
                float v = -INFINITY; const float r_ = rs[ai * 4 + m];
#pragma unroll
                for (int bj = 0; bj < 2; ++bj)
#pragma unroll
                    for (int n = 0; n < 2; ++n) { const f32x4 x = acc[ai][bj][m][n]; v = fmaxf(v, fmaxf(fmaxf(x[0], x[1]), fmaxf(x[2], x[3]))); }
                v = fmaxf(v, __shfl_xor(v, 16)); v = fmaxf(v, __shfl_xor(v, 32));
                v *= r_;
                float s = 0.f;
#pragma unroll
                for (int bj = 0; bj < 2; ++bj)
#pragma unroll
                    for (int n = 0; n < 2; ++n) { f32x4 x = acc[ai][bj][m][n];
#pragma unroll
                        for (int e = 0; e < 4; ++e) { x[e] = __builtin_amdgcn_exp2f(fmaf(x[e], r_, -v)); s += x[e]; }
                        acc[ai][bj][m][n] = x; }
                s += __shfl_xor(s, 16); s += __shfl_xor(s, 32);
                if (fq == 0) *(LAS f32x2*)(xb + (ai * 128 + m * 16) * 8 + wc * 2) = (f32x2){v, s};
            }
        asm volatile("s_waitcnt lgkmcnt(0)" ::: "memory"); __builtin_amdgcn_s_barrier(); asm volatile("" ::: "memory");
#pragma unroll
        for (int ai = 0; ai < 2; ++ai)
#pragma unroll
            for (int m = 0; m < 4; ++m) {
                const int rl = ai * 128 + wr * 64 + m * 16 + fr, row = u.pm * 256 + rl;
                const f32x4 a = *(const LAS f32x4*)(xb + (ai * 128 + m * 16) * 8), b = *(const LAS f32x4*)(xb + (ai * 128 + m * 16) * 8 + 4);
                const float M = fmaxf(fmaxf(a[0], a[2]), fmaxf(b[0], b[2]));
                const float L = a[1] * __builtin_amdgcn_exp2f(a[0] - M) + a[3] * __builtin_amdgcn_exp2f(a[2] - M) + b[1] * __builtin_amdgcn_exp2f(b[0] - M) + b[3] * __builtin_amdgcn_exp2f(b[2] - M);
                const float mown = (wc == 0) ? a[0] : (wc == 1) ? a[2] : (wc == 2) ? b[0] : b[2];
                const float sc = __builtin_amdgcn_exp2f(mown - M) / L;
#pragma unroll
                for (int bj = 0; bj < 2; ++bj) *(v4u*)(P + (size_t)row * DM + u.pn * 256 + bj * 128 + wc * 32 + 8 * fq) = pack8(acc[ai][bj][m][0] * sc, acc[ai][bj][m][1] * sc);
                __builtin_amdgcn_sched_barrier(0);
            }
        asm volatile("s_waitcnt lgkmcnt(0)" ::: "memory"); __builtin_amdgcn_s_barrier(); asm volatile("" ::: "memory");
    }
};

struct RowOwner {
    int pm, nN; const char* A; const char* B; size_t ta, tb;
    __device__ __forceinline__ void init(const pg8::Gemm& g, int pm_) { pm = pm_; nN = g.N / 256; A = (const char*)g.A; B = (const char*)g.Bt; ta = (size_t)256 * g.lda * 2; tb = (size_t)256 * g.ldb * 2; }
    __device__ __forceinline__ bool next(int i, pg8::Unit& u) const { if (i >= nN) return false; u.pm = pm; u.pn = i; u.pa = A + (size_t)pm * ta; u.pb = B + (size_t)i * tb; return true; }
    __device__ __forceinline__ void a_ready(const pg8::Unit&) const {}
    __device__ __forceinline__ void done(const pg8::Unit&) const {}
};
struct CrossOwner {
    int pm; const char* A; const char* B; size_t bstride, hstride;
    __device__ __forceinline__ bool next(int i, pg8::Unit& u) const {
        if (i >= 4) return false;
        u.pm = pm; u.pn = i; u.pa = A + ((size_t)pm * 256 * DM + i * 256) * 2; u.pb = B + (size_t)(pm >> 3) * bstride + (size_t)i * hstride; return true;
    }
    __device__ __forceinline__ void a_ready(const pg8::Unit&) const {}
    __device__ __forceinline__ void done(const pg8::Unit&) const {}
};

template <class Map>
__device__ __forceinline__ void transpose_item(const float* W, int srcN, const float* g, bf16* WT, int ldk, int koff, LAS float* scr, int k0, int n0, int lane, const Map& map) {
    const int sc = map(n0 + (lane & 31));
#pragma unroll 8
    for (int i = 0; i < 32; ++i) { const int kk = 2 * i + (lane >> 5); float v = (sc >= 0) ? W[(size_t)(k0 + kk) * srcN + sc] : 0.f; if (g) v *= g[k0 + kk]; scr[kk * 33 + (lane & 31)] = v; }
    LDS_WAIT(); asm volatile("" ::: "memory");
    const int c = lane & 7;
#pragma unroll
    for (int j = 0; j < 4; ++j) { const int n = (lane >> 3) + 8 * j; const LAS float* s = scr + (8 * c) * 33 + n;
        v4u o; o.x = pk2(s[0 * 33], s[1 * 33]); o.y = pk2(s[2 * 33], s[3 * 33]); o.z = pk2(s[4 * 33], s[5 * 33]); o.w = pk2(s[6 * 33], s[7 * 33]);
        *(v4u*)(WT + (size_t)(n0 + n) * ldk + koff + k0 + 8 * c) = o; }
    LDS_WAIT(); asm volatile("" ::: "memory");
}
struct MapId { __device__ __forceinline__ int operator()(int n) const { return n; } };
__device__ __forceinline__ void transpose_item_v4(const float* W, int srcN, const float* g, bf16* WT, int ldk, int koff, LAS float* scr, int k0, int n0, int lane) {
    f32x4 v[8];
#pragma unroll
    for (int i = 0; i < 8; ++i) v[i] = *(const f32x4*)(W + (size_t)(k0 + 8 * i + (lane >> 3)) * srcN + n0 + (lane & 7) * 4);
#pragma unroll
    for (int i = 0; i < 8; ++i) { const int kk = 8 * i + (lane >> 3); f32x4 x = v[i]; if (g) x = x * g[k0 + kk];
        LAS float* d = scr + kk * 33 + (lane & 7) * 4; d[0] = x[0]; d[1] = x[1]; d[2] = x[2]; d[3] = x[3]; }
    LDS_WAIT(); asm volatile("" ::: "memory");
    const int c = lane & 7;
#pragma unroll
    for (int j = 0; j < 4; ++j) { const int n = (lane >> 3) + 8 * j; const LAS float* s_ = scr + (8 * c) * 33 + n;
        v4u o; o.x = pk2(s_[0 * 33], s_[1 * 33]); o.y = pk2(s_[2 * 33], s_[3 * 33]); o.z = pk2(s_[4 * 33], s_[5 * 33]); o.w = pk2(s_[6 * 33], s_[7 * 33]);
        *(v4u*)(WT + (size_t)(n0 + n) * ldk + koff + k0 + 8 * c) = o; }
    LDS_WAIT(); asm volatile("" ::: "memory");
}

__device__ __forceinline__ int il64(int p) { return (p >> 1) + 32 * (p & 1); }
__device__ __forceinline__ int il32(int p) { return (p >> 1) + 16 * (p & 1); }
struct MapIn {
    __device__ __forceinline__ int operator()(int nn) const {
        if (nn < 512) return nn;
        int n = nn - 512;
        if (n < 256) return 512 + (n >> 5) * 32 + il32(n & 31);
        n -= 256;
        if (n < 256) { if (n < 128) return 768 + n; if (n < 160) return 896 + il32(n - 128); if (n < 224) return 1440 + il64(n - 160); if (n < 232) return 1504 + (n - 224); return -1; }
        n -= 256;
        if (n < 512) return 928 + (n >> 6) * 64 + il64(n & 63);
        n -= 512;
        if (n < 512) return 1512 + (n >> 6) * 64 + il64(n & 63);
        n -= 512;
        if (n < 512) return 2024 + (n >> 6) * 64 + il64(n & 63);
        n -= 512;
        return 2536 + n;
    }
};

__device__ __forceinline__ void p0_prologue(Frame& F) {
    LAS float* scr = (LAS float*)(F.lds + F.wave * 16384);
    const int gw = F.gw, NGW = F.NGW, lane = F.lane;
    const float *x = inp(F, 0), *mem = inp(F, 1), *g_mix = inp(F, 2), *w_in = inp(F, 3), *w_uk = inp(F, 5), *w_uv = inp(F, 6), *w_out = inp(F, 7), *g_cross = inp(F, 8), *g_mem = inp(F, 9);
    const float *w_q = inp(F, 10), *w_kv = inp(F, 11), *w_o = inp(F, 12), *g_mlp = inp(F, 13), *w_up = inp(F, 14), *w_dn = inp(F, 15);
    bf16 *WIN = wsp<bf16>(F, WS_WIN), *WOUT = wsp<bf16>(F, WS_WOUT), *WQ = wsp<bf16>(F, WS_WQ), *WKV = wsp<bf16>(F, WS_WKV), *WO = wsp<bf16>(F, WS_WO), *WUP = wsp<bf16>(F, WS_WUP), *WDN = wsp<bf16>(F, WS_WDN);
    constexpr int I_IN = 16 * (3072 / 32), I_OUT2 = 16 * 32, I_Q = 16 * 32, I_KV = 16 * 64, I_O = 16 * 32, I_UP = 16 * 128, I_DN = 64 * 32;
    constexpr int NIT = I_IN + I_OUT2 + I_Q + I_KV + I_O + I_UP + I_DN;
    for (int it = gw; it < NIT; it += NGW) {
        int r = it;
        if (r < I_IN) { const int nb = r % 96, kb = r / 96; transpose_item(w_in, W_IN_COLS, g_mix, WIN, DM, 0, scr, 64 * kb, 32 * nb, lane, MapIn()); continue; } r -= I_IN;
        if (r < I_OUT2) { const int nb = r % 32, kb = r / 32; transpose_item_v4(w_out, DM, nullptr, WOUT, KOUT, 0, scr, 64 * kb, 32 * nb, lane); continue; } r -= I_OUT2;
        if (r < I_Q) {
#pragma unroll
            for (int rr = 0; rr < 2; ++rr) { const int d = 2 * r + rr; const float gs = g_cross[d] * SCALE_C; const f32x4* src = (const f32x4*)(w_q + (size_t)d * DM) + 4 * lane;
                const f32x4 a0 = src[0], a1 = src[1], a2 = src[2], a3 = src[3];
                v4u o0, o1; o0.x = pk2(a0[0] * gs, a0[1] * gs); o0.y = pk2(a0[2] * gs, a0[3] * gs); o0.z = pk2(a1[0] * gs, a1[1] * gs); o0.w = pk2(a1[2] * gs, a1[3] * gs);
                o1.x = pk2(a2[0] * gs, a2[1] * gs); o1.y = pk2(a2[2] * gs, a2[3] * gs); o1.z = pk2(a3[0] * gs, a3[1] * gs); o1.w = pk2(a3[2] * gs, a3[3] * gs);
                v4u* dst = (v4u*)(WQ + (size_t)d * DM) + 2 * lane; dst[0] = o0; dst[1] = o1; }
            continue; } r -= I_Q;
        if (r < I_KV) { const int nb = r % 64, kb = r / 64; transpose_item_v4(w_kv, 2048, g_mem, WKV, DM, 0, scr, 64 * kb, 32 * nb, lane); continue; } r -= I_KV;
        if (r < I_O) { const int nb = r % 32, kb = r / 32; transpose_item_v4(w_o, DM, nullptr, WO, DM, 0, scr, 64 * kb, 32 * nb, lane); continue; } r -= I_O;
        if (r < I_UP) { const int nb = r % 128, kb = r / 128; transpose_item_v4(w_up, FF, g_mlp, WUP, DM, 0, scr, 64 * kb, 32 * nb, lane); continue; } r -= I_UP;
        { const int nb = r % 32, kb = r / 32; transpose_item_v4(w_dn, DM, nullptr, WDN, FF, 0, scr, 64 * kb, 32 * nb, lane); }
    }
    { v4u* WUKF = wsp<v4u>(F, WS_WUKF); v4u* WUVF = wsp<v4u>(F, WS_WUVF);
      for (int e = gw * 64 + lane; e < 2 * 8192; e += NGW * 64) {
          const int ln = e & 63, r32 = ln & 31, hi = ln >> 5; float v[8];
          if (e < 8192) { const int ks = (e >> 6) & 3, ct = (e >> 8) & 3, h = e >> 10;
#pragma unroll
              for (int j = 0; j < 8; ++j) v[j] = w_uk[((size_t)h * 64 + 16 * ks + 8 * hi + j) * 128 + 32 * ct + r32];
              v4u o; o.x = pk2(v[0], v[1]); o.y = pk2(v[2], v[3]); o.z = pk2(v[4], v[5]); o.w = pk2(v[6], v[7]); WUKF[e] = o; }
          else { const int e2 = e - 8192, sx = (e2 >> 6) & 1, dt = (e2 >> 7) & 3, vt = (e2 >> 9) & 1, h = e2 >> 10;
#pragma unroll
              for (int j = 0; j < 8; ++j) v[j] = w_uv[((size_t)h * 128 + 32 * dt + 16 * sx + 8 * hi + j) * 64 + 32 * vt + r32];
              v4u o; o.x = pk2(v[0], v[1]); o.y = pk2(v[2], v[3]); o.z = pk2(v[4], v[5]); o.w = pk2(v[6], v[7]); WUVF[e2] = o; }
      } }
    bf16 *XB = wsp<bf16>(F, WS_XB), *MEMB = wsp<bf16>(F, WS_MEMB); float *R1 = wsp<float>(F, WS_RSTD1), *RM = wsp<float>(F, WS_RSTDM);
    for (int m0 = gw; m0 < T + TM; m0 += 4 * NGW) {
        f32x4 v[4][4]; float ssq[4];
#pragma unroll
        for (int u = 0; u < 4; ++u) { const int m = m0 + u * NGW; const bool ok = m < T + TM; const bool isx = m < T; const int r = isx ? m : m - T;
            const f32x4* xr = (const f32x4*)((isx ? x : mem) + (size_t)(ok ? r : 0) * DM) + lane;
#pragma unroll
            for (int j = 0; j < 4; ++j) v[u][j] = __builtin_nontemporal_load(xr + 64 * j); }
#pragma unroll
        for (int u = 0; u < 4; ++u) { float s = 0.f;
#pragma unroll
            for (int j = 0; j < 4; ++j) s += (v[u][j][0] * v[u][j][0] + v[u][j][1] * v[u][j][1]) + (v[u][j][2] * v[u][j][2] + v[u][j][3] * v[u][j][3]);
            ssq[u] = wave_sum(s); }
#pragma unroll
        for (int u = 0; u < 4; ++u) { const int m = m0 + u * NGW; if (m < T + TM) { const bool isx = m < T; const int r = isx ? m : m - T;
            if (lane == 0) (isx ? R1 : RM)[r] = 1.0f / sqrtf(ssq[u] * (1.0f / DM) + EPS);
            v2u* o8 = (v2u*)((isx ? XB : MEMB) + (size_t)r * DM) + lane;
#pragma unroll
            for (int j = 0; j < 4; ++j) { v2u w; w.x = pk2(v[u][j][0], v[u][j][1]); w.y = pk2(v[u][j][2], v[u][j][3]); o8[64 * j] = w; } } }
    }
    float *T64 = wsp<float>(F, WS_TAB64), *T32 = wsp<float>(F, WS_TAB32);
    for (int e = gw * 64 + lane; e < SEQ * 32; e += NGW * 64) {
        const int pos = e >> 5, t = e & 31;
        const float inv = exp2f(-(float)t * (13.287712379549449f / 32.0f));
        const float ang = (float)pos * inv;
        const double rev = (double)ang * 0.15915494309189535; const float fr = (float)(rev - floor(rev));
        const float c = __builtin_amdgcn_cosf(fr), s = __builtin_amdgcn_sinf(fr);
        T64[2 * e] = c; T64[2 * e + 1] = s;
        if ((t & 1) == 0) { T32[2 * (pos * 16 + (t >> 1))] = c; T32[2 * (pos * 16 + (t >> 1)) + 1] = s; }
    }
}

__device__ __forceinline__ void p2_ckv_norm(Frame& F) {
    const float* CKVF = wsp<float>(F, WS_CKVF); bf16* CKV = wsp<bf16>(F, WS_CKV); const float* g = inp(F, 4);
    const int hl = F.lane & 31, hh = F.lane >> 5, c0_ = 4 * hl;
    const f32x4 gv = *(const f32x4*)(g + c0_);
    const int cpos = (c0_ & ~12) | ((c0_ & 4) << 1) | ((c0_ & 8) >> 1);
    for (int r0 = F.gw * 2 + hh; r0 < T; r0 += 16 * F.NGW) {
        f32x4 v[8]; float ss[8];
#pragma unroll
        for (int u = 0; u < 8; ++u) v[u] = *(const f32x4*)(CKVF + (size_t)(r0 + u * 2 * F.NGW) * 128 + c0_);
#pragma unroll
        for (int u = 0; u < 8; ++u) { float t = (v[u][0] * v[u][0] + v[u][1] * v[u][1]) + (v[u][2] * v[u][2] + v[u][3] * v[u][3]);
#pragma unroll
            for (int o = 1; o < 32; o <<= 1) t += __shfl_xor(t, o);
            ss[u] = t; }
#pragma unroll
        for (int u = 0; u < 8; ++u) { const float rs = 1.0f / sqrtf(ss[u] * (1.0f / 128.0f) + EPS);
            v2u w; w.x = pk2(v[u][0] * rs * gv[0], v[u][1] * rs * gv[1]); w.y = pk2(v[u][2] * rs * gv[2], v[u][3] * rs * gv[3]);
            *(v2u*)(CKV + (size_t)(r0 + u * 2 * F.NGW) * 128 + cpos) = w; }
    }
}
typedef short bf16x8 __attribute__((ext_vector_type(8)));
typedef float f32x16 __attribute__((ext_vector_type(16)));
typedef short v4i16_t __attribute__((ext_vector_type(4)));
typedef float f32x2_t __attribute__((ext_vector_type(2)));
typedef __bf16 bf16x2_t __attribute__((ext_vector_type(2)));
__device__ __forceinline__ unsigned cvtpk(float lo, float hi) { f32x2_t v = {lo, hi}; bf16x2_t b = __builtin_convertvector(v, bf16x2_t); return __builtin_bit_cast(unsigned, b); }
__device__ __forceinline__ int crow(int r, int hi) { return (r & 3) + 8 * (r >> 2) + 4 * hi; }
template <int NCH> __device__ __forceinline__ unsigned off_img(unsigned row, unsigned ch) { return (NCH * 128u) * (row >> 3) + 512u * (ch >> 2) + 64u * (row & 7) + 16u * ((ch & 3) ^ ((row >> 2) & 3)); }
template <int NCH> __device__ __forceinline__ unsigned rowread_addr(unsigned lane, unsigned s) { return off_img<NCH>(lane & 31, 2 * s + (lane >> 5)); }
template <int NCH> __device__ __forceinline__ unsigned trread_addr(unsigned lane, unsigned c, unsigned ks, unsigned t) {
    const unsigned h = lane >> 5, blk = (lane >> 4) & 1, q = (lane & 15) >> 2, p = lane & 3;
    return off_img<NCH>(16 * ks + 8 * t + 4 * h + q, 4 * c + 2 * blk + (p >> 1)) + 8 * (p & 1);
}
__device__ __forceinline__ bf16x8 trfrag(LAS unsigned char* p0, LAS unsigned char* p1) {
    const v4i16_t lo = __builtin_amdgcn_ds_read_tr16_b64_v4i16((LAS v4i16_t*)p0), hi = __builtin_amdgcn_ds_read_tr16_b64_v4i16((LAS v4i16_t*)p1);
    return (bf16x8){lo[0], lo[1], lo[2], lo[3], hi[0], hi[1], hi[2], hi[3]};
}
#define MFMA32(a, b, c) __builtin_amdgcn_mfma_f32_32x32x16_bf16((a), (b), (c), 0, 0, 0)
template <int NDT> __device__ __forceinline__ void softmax_tile(f32x16& S, float& m, float& l, f32x16 (&o)[NDT], bf16x8 (&pf)[2]) {
    float mt = fmaxf(fmaxf(fmaxf(S[0], S[1]), fmaxf(S[2], S[3])), fmaxf(fmaxf(S[4], S[5]), fmaxf(S[6], S[7])));
    mt = fmaxf(mt, fmaxf(fmaxf(fmaxf(S[8], S[9]), fmaxf(S[10], S[11])), fmaxf(fmaxf(S[12], S[13]), fmaxf(S[14], S[15]))));
    mt = fmaxf(mt, __shfl_xor(mt, 32));
    if (__any(mt > m + RESCALE_THR)) {
        const float mn = fmaxf(m, mt), al = __builtin_amdgcn_exp2f(m - mn);
        l *= al; m = mn;
#pragma unroll
        for (int d = 0; d < NDT; ++d) o[d] = o[d] * al;
    }
    float s = 0.f;
#pragma unroll
    for (int r = 0; r < 16; ++r) { S[r] = __builtin_amdgcn_exp2f(S[r] - m); s += S[r]; }
    l += s;
    typedef unsigned u32x4_t __attribute__((ext_vector_type(4)));
    u32x4_t w0, w1;
    w0.x = cvtpk(S[0], S[1]); w0.y = cvtpk(S[2], S[3]); w0.z = cvtpk(S[4], S[5]); w0.w = cvtpk(S[6], S[7]);
    w1.x = cvtpk(S[8], S[9]); w1.y = cvtpk(S[10], S[11]); w1.z = cvtpk(S[12], S[13]); w1.w = cvtpk(S[14], S[15]);
    pf[0] = __builtin_bit_cast(bf16x8, w0); pf[1] = __builtin_bit_cast(bf16x8, w1);
}
__device__ __forceinline__ int unit_batch(int c, int ui) { return 4 * (c & 7) + (ui >> 1); }
__device__ __forceinline__ int unit_qtile(int c, int ui) { const int s = c >> 3; return (ui & 1) ? 63 - s : s; }

__device__ __forceinline__ float fmax3(float a, float b, float c) { float r; asm("v_max3_f32 %0, %1, %2, %3" : "=v"(r) : "v"(a), "v"(b), "v"(c)); return r; }
template <int NDT> __device__ __forceinline__ void softmax_tile_m(f32x16& S, float mt, float& m, float& l, f32x16 (&o)[NDT], bf16x8 (&pf)[2]) {
    if (__any(mt > m + RESCALE_THR)) {
        const float mn = fmaxf(m, mt), al = __builtin_amdgcn_exp2f(m - mn);
        l *= al; m = mn;
#pragma unroll
        for (int d = 0; d < NDT; ++d) o[d] = o[d] * al;
    }
    float s = 0.f;
#pragma unroll
    for (int r = 0; r < 16; ++r) { S[r] = __builtin_amdgcn_exp2f(S[r] - m); s += S[r]; }
    l += s;
    typedef unsigned u32x4_t __attribute__((ext_vector_type(4)));
    u32x4_t w0, w1;
    w0.x = cvtpk(S[0], S[1]); w0.y = cvtpk(S[2], S[3]); w0.z = cvtpk(S[4], S[5]); w0.w = cvtpk(S[6], S[7]);
    w1.x = cvtpk(S[8], S[9]); w1.y = cvtpk(S[10], S[11]); w1.z = cvtpk(S[12], S[13]); w1.w = cvtpk(S[14], S[15]);
    pf[0] = __builtin_bit_cast(bf16x8, w0); pf[1] = __builtin_bit_cast(bf16x8, w1);
}
template <int NDT> __device__ __forceinline__ void softmax_tile_rel(f32x16& S, float mt, const float mb, float& m, float& l, bool& seen, f32x16 (&o)[NDT], bf16x8 (&pf)[2]) {
    if (__any(mb != m)) { const float d = mb - m; mt += d;
#pragma unroll
        for (int r = 0; r < 16; ++r) S[r] += d; }
    const bool fin = mt > -INFINITY;
    if (__any((mt > RESCALE_THR) || (fin && !seen))) {
        const float inc = seen ? fmaxf(mt, 0.f) : (fin ? mt : 0.f), al = seen ? __builtin_amdgcn_exp2f(-inc) : 1.0f;
        seen = seen || fin;
        l *= al; m += inc;
#pragma unroll
        for (int d = 0; d < NDT; ++d) o[d] = o[d] * al;
#pragma unroll
        for (int r = 0; r < 16; ++r) S[r] -= inc;
    }
    float s = 0.f;
#pragma unroll
    for (int r = 0; r < 16; ++r) { S[r] = __builtin_amdgcn_exp2f(S[r]); s += S[r]; }
    l += s;
    typedef unsigned u32x4_t __attribute__((ext_vector_type(4)));
    u32x4_t w0, w1;
    w0.x = cvtpk(S[0], S[1]); w0.y = cvtpk(S[2], S[3]); w0.z = cvtpk(S[4], S[5]); w0.w = cvtpk(S[6], S[7]);
    w1.x = cvtpk(S[8], S[9]); w1.y = cvtpk(S[10], S[11]); w1.z = cvtpk(S[12], S[13]); w1.w = cvtpk(S[14], S[15]);
    pf[0] = __builtin_bit_cast(bf16x8, w0); pf[1] = __builtin_bit_cast(bf16x8, w1);
}
template <int VAR> __device__ __forceinline__ void p3_dsa_mfma5(Frame& F) {
    const bf16 *QL = wsp<bf16>(F, WS_QL), *QR = wsp<bf16>(F, WS_QR), *CKV = wsp<bf16>(F, WS_CKV), *KR = wsp<bf16>(F, WS_KR); const unsigned* MASK = wsp<unsigned>(F, WS_MASK); bf16* HX = wsp<bf16>(F, WS_HX);
    const v4u *WUKF = wsp<v4u>(F, WS_WUKF), *WUVF = wsp<v4u>(F, WS_WUVF);
    typedef unsigned u32x4_t __attribute__((ext_vector_type(4)));
    const int lane = F.lane, q = lane & 31, hi = lane >> 5, h = F.wave, tid = F.tid;
    constexpr int BUFB = 10496;
    const unsigned ra0 = rowread_addr<16>(lane, 0), ra1 = rowread_addr<16>(lane, 1);
    const unsigned ta0 = trread_addr<16>(lane, 0, 0, 0), ta1 = trread_addr<16>(lane, 0, 0, 1);
    const unsigned rra = 8192 + hi * 528 + q * 16;
    const unsigned wcs = off_img<16>(tid >> 4, tid & 15), wrs = 8192 + (tid & 3) * 528 + ((tid >> 2) & 31) * 16;
    const bool rl = tid < 128;
#define DSA_BIAS(Sv, mword, mref) do { const unsigned nm_ = ~((mword) >> (4 * hi)), nmr_ = __float_as_uint(-(mref)); \
        _Pragma("unroll") for (int r = 0; r < 16; ++r) { int e_; asm("v_bfe_i32 %0, %1, %2, 1" : "=v"(e_) : "v"(nm_), "n"((r & 3) + 8 * (r >> 2))); \
            Sv[r] = __uint_as_float(((unsigned)e_ & 0xff800000u) | (~(unsigned)e_ & nmr_)); } } while (0)
#define DSA_QK(Sv, buf, mword, mref) do { bf16x8 kfa_[10]; \
        _Pragma("unroll") for (int ks = 0; ks < 8; ++ks) kfa_[ks] = *(const LAS bf16x8*)((buf) + ((ks & 1) ? ra1 : ra0) + 512 * (ks >> 1)); \
        _Pragma("unroll") for (int ks = 0; ks < 2; ++ks) kfa_[8 + ks] = *(const LAS bf16x8*)((buf) + rra + 1056 * ks); \
        __builtin_amdgcn_sched_barrier(0); \
        DSA_BIAS(Sv, mword, mref); \
        _Pragma("unroll") for (int ks = 0; ks < 10; ++ks) Sv = MFMA32(kfa_[ks], qf[ks], Sv); } while (0)
#define DSA_LD(cv, rv, t) do { const int t_ = ((t) <= j) ? (t) : j; const GAS bf16* ct_ = cbb + (size_t)t_ * 32 * 128; const GAS bf16* rt_ = rbb + (size_t)t_ * 32 * 32; LAUNDER_G(ct_); LAUNDER_G(rt_); cv = *(const GAS v4u*)(ct_ + cbo); rv = *(const GAS v4u*)(rt_ + rbo); } while (0)
#define DSA_TILE(i, cw, rw, cl, rl_) do { \
        const int b1 = (bi == 2) ? 0 : bi + 1, b2 = (b1 == 2) ? 0 : b1 + 1; \
        LAS unsigned char* cur = F.lds + bi * BUFB; \
        DSA_LD(cl, rl_, (i) + 3); \
        const unsigned mw2 = *(const LAS unsigned*)(mimg + 4 * (((i) + 2 <= j) ? (i) + 2 : j)); \
        f32x16 S = Sn; \
        const unsigned mcur = mw >> (4 * hi); \
        float mt = 0.f; \
        if (VAR == 0) { \
        mt = fmax3(fmax3(S[0], S[1], S[2]), fmax3(S[3], S[4], S[5]), fmax3(S[6], S[7], S[8])); \
        mt = fmax3(mt, fmax3(S[9], S[10], S[11]), fmax3(S[12], S[13], fmax3(S[14], S[15], S[15]))); } \
        const float mb = mbn; mbn = m; \
        if (VAR < 3) DSA_QK(Sn, F.lds + b1 * BUFB, mw1, mbn); \
        bf16x8 pf[2]; \
        if (VAR == 0) { \
        { auto rrx = __builtin_amdgcn_permlane32_swap(__float_as_uint(mt), __float_as_uint(mt), false, false); mt = fmax3(__uint_as_float(rrx[0]), __uint_as_float(rrx[1]), mt); } \
        softmax_tile_rel<4>(S, mt, mb, m, l, seen, o, pf); \
        } else { typedef unsigned u32x4_t2 __attribute__((ext_vector_type(4))); u32x4_t2 w0_, w1_; w0_.x = cvtpk(S[0], S[1]); w0_.y = cvtpk(S[2], S[3]); w0_.z = cvtpk(S[4], S[5]); w0_.w = cvtpk(S[6], S[7]); w1_.x = cvtpk(S[8], S[9]); w1_.y = cvtpk(S[10], S[11]); w1_.z = cvtpk(S[12], S[13]); w1_.w = cvtpk(S[14], S[15]); \
            pf[0] = __builtin_bit_cast(bf16x8, w0_); pf[1] = __builtin_bit_cast(bf16x8, w1_); l += S[0] + (float)(mcur & 1u); } \
        if (VAR < 2) { \
        _Pragma("unroll") for (int dt = 0; dt < 4; ++dt) \
            _Pragma("unroll") for (int ks = 0; ks < 2; ++ks) { const bf16x8 vf = trfrag(cur + ta0 + 4096 * ks + 512 * dt, cur + ta1 + 4096 * ks + 512 * dt); o[dt] = MFMA32(vf, pf[ks], o[dt]); } \
        } else { o[0][0] += __builtin_bit_cast(float, pf[0][0] | (pf[1][1] << 16)); } \
        { LAS unsigned char* nx = F.lds + b2 * BUFB; *(LAS v4u*)(nx + wcs) = cw; if (rl) *(LAS v4u*)(nx + wrs) = rw; } \
        mw = mw1; mw1 = mw2; bi = b1; \
        asm volatile("s_waitcnt lgkmcnt(0)" ::: "memory"); __builtin_amdgcn_s_barrier(); asm volatile("" ::: "memory"); } while (0)
    for (int c = blockIdx.x; c < 256; c += gridDim.x) {
        for (int ui = 0; ui < 8; ++ui) {
            const int b = unit_batch(c, ui), j = unit_qtile(c, ui); const size_t tok0 = (size_t)b * SEQ + 32 * j;
#define UPTR(ty, nm, ex) const GAS ty* nm = (const GAS ty*)(ex); LAUNDER_G(nm)
            UPTR(bf16, qlb, QL + tok0 * 512 + h * 64); UPTR(bf16, qrb, QR + tok0 * 256 + h * 32); UPTR(v4u, wkb, WUKF + h * 1024); UPTR(unsigned, mrb, MASK + tok0 * 64);
            UPTR(bf16, cbb, CKV + (size_t)b * SEQ * 128); UPTR(bf16, rbb, KR + (size_t)b * SEQ * 32);
            const int qo = q * 512 + 8 * hi, ro = q * 256 + 8 * hi;
            bf16x8 qf[10];
            {
              bf16x8 qn[4];
#pragma unroll
              for (int ks = 0; ks < 4; ++ks) qn[ks] = *(const GAS bf16x8*)(qlb + qo + 16 * ks);
#pragma unroll
              for (int ct = 0; ct < 4; ++ct) { f32x16 X = (f32x16){};
#pragma unroll
                  for (int ks = 0; ks < 4; ++ks) { const bf16x8 wf = __builtin_bit_cast(bf16x8, wkb[(ct * 4 + ks) * 64 + lane]); X = MFMA32(wf, qn[ks], X); }
                  u32x4_t w0, w1; w0.x = cvtpk(X[0], X[1]); w0.y = cvtpk(X[2], X[3]); w0.z = cvtpk(X[4], X[5]); w0.w = cvtpk(X[6], X[7]); w1.x = cvtpk(X[8], X[9]); w1.y = cvtpk(X[10], X[11]); w1.z = cvtpk(X[12], X[13]); w1.w = cvtpk(X[14], X[15]);
                  qf[2 * ct] = __builtin_bit_cast(bf16x8, w0); qf[2 * ct + 1] = __builtin_bit_cast(bf16x8, w1); } }
#pragma unroll
            for (int ks = 0; ks < 2; ++ks) qf[8 + ks] = *(const GAS bf16x8*)(qrb + ro + 16 * ks);
            f32x16 o[4];
#pragma unroll
            for (int d = 0; d < 4; ++d) o[d] = (f32x16){};
            float m = 0.f, l = 0.f, mbn = 0.f; bool seen = false;
            const int cbo = 8 * tid, rbo = 8 * (tid & 127); LAS unsigned char* mimg = F.lds + 32768 + q * 260;
            v4u cA, rA, cB, rB;
            { v4u c0, r0, c1, r1; DSA_LD(c0, r0, 0); DSA_LD(c1, r1, 1); DSA_LD(cA, rA, 2);
              *(LAS v4u*)(F.lds + wcs) = c0; if (rl) *(LAS v4u*)(F.lds + wrs) = r0; *(LAS v4u*)(F.lds + BUFB + wcs) = c1; if (rl) *(LAS v4u*)(F.lds + BUFB + wrs) = r1; }
            { const v4u mq = *(const GAS v4u*)(mrb + 4 * tid); LAS unsigned* md = (LAS unsigned*)(F.lds + 32768 + (tid >> 4) * 260 + (tid & 15) * 16);
              md[0] = mq.x; md[1] = mq.y; md[2] = mq.z; md[3] = mq.w; }
#pragma unroll
            for (int ks = 0; ks < 10; ++ks) asm volatile("" : "+v"(qf[ks]));
            asm volatile("s_waitcnt lgkmcnt(0)" ::: "memory"); __builtin_amdgcn_s_barrier(); asm volatile("" ::: "memory");
            unsigned mw = *(const LAS unsigned*)mimg, mw1 = *(const LAS unsigned*)(mimg + 4 * ((1 <= j) ? 1 : j));
            f32x16 Sn; DSA_QK(Sn, F.lds, mw, mbn);
            asm volatile("s_nop 15\n\ts_nop 7" : "+v"(Sn));
            int bi = 0;
            for (int i = 0; i <= j; i += 2) {
                DSA_TILE(i, cA, rA, cB, rB);
                if (i + 1 <= j) DSA_TILE(i + 1, cB, rB, cA, rA);
            }
            l += __shfl_xor(l, 32); const float il = 1.0f / l;
            UPTR(v4u, wvb, WUVF + h * 1024); UPTR(bf16, hxb, HX + tok0 * KOUT + h * 64);
            f32x16 oa[2]; oa[0] = (f32x16){}; oa[1] = (f32x16){};
#pragma unroll
            for (int dt = 0; dt < 4; ++dt) {
                u32x4_t w0, w1; w0.x = cvtpk(o[dt][0] * il, o[dt][1] * il); w0.y = cvtpk(o[dt][2] * il, o[dt][3] * il); w0.z = cvtpk(o[dt][4] * il, o[dt][5] * il); w0.w = cvtpk(o[dt][6] * il, o[dt][7] * il);
                w1.x = cvtpk(o[dt][8] * il, o[dt][9] * il); w1.y = cvtpk(o[dt][10] * il, o[dt][11] * il); w1.z = cvtpk(o[dt][12] * il, o[dt][13] * il); w1.w = cvtpk(o[dt][14] * il, o[dt][15] * il);
                const bf16x8 of0 = __builtin_bit_cast(bf16x8, w0), of1 = __builtin_bit_cast(bf16x8, w1);
#pragma unroll
                for (int vt = 0; vt < 2; ++vt) { oa[vt] = MFMA32(__builtin_bit_cast(bf16x8, wvb[((vt * 4 + dt) * 2 + 0) * 64 + lane]), of0, oa[vt]);
                                                 oa[vt] = MFMA32(__builtin_bit_cast(bf16x8, wvb[((vt * 4 + dt) * 2 + 1) * 64 + lane]), of1, oa[vt]); }
            }
            { LAS unsigned char* ob = F.lds + 49152 + h * 4608;
#pragma unroll
              for (int vt = 0; vt < 2; ++vt)
#pragma unroll
                  for (int g = 0; g < 4; ++g) { v2u w; w.x = cvtpk(oa[vt][4 * g], oa[vt][4 * g + 1]); w.y = cvtpk(oa[vt][4 * g + 2], oa[vt][4 * g + 3]); *(LAS v2u*)(ob + q * 144 + (32 * vt + 8 * g + 4 * hi) * 2) = w; }
#pragma unroll
              for (int pss = 0; pss < 4; ++pss) { const int rw = 8 * pss + (lane >> 3); const v4u val = *(const LAS v4u*)(ob + rw * 144 + (lane & 7) * 16); *(GAS v4u*)((GAS bf16*)hxb + rw * KOUT + (lane & 7) * 8) = val; } }
            asm volatile("s_waitcnt lgkmcnt(0)" ::: "memory"); __builtin_amdgcn_s_barrier(); asm volatile("" ::: "memory");
        }
    }
#undef DSA_QK
#undef DSA_LD
#undef DSA_TILE
#undef UPTR
}
__device__ __forceinline__ void p3_dilated_mfma2(Frame& F) {
    const bf16 *QB = wsp<bf16>(F, WS_QB), *KB = wsp<bf16>(F, WS_KB), *VB = wsp<bf16>(F, WS_VB); bf16* HX = wsp<bf16>(F, WS_HX);
    const int lane = F.lane, q = lane & 31, hi = lane >> 5, h = F.wave;
    LAS unsigned char* kimg = F.lds + F.wave * 16384; LAS unsigned char* vimg = kimg + 4096;
    const unsigned ra0 = rowread_addr<8>(lane, 0), ra1 = rowread_addr<8>(lane, 1);
    const unsigned ta0 = trread_addr<8>(lane, 0, 0, 0), ta1 = trread_addr<8>(lane, 0, 0, 1);
    const unsigned wa_e = off_img<8>(lane >> 3, lane & 7), wa_o = off_img<8>((lane >> 3) + 8, lane & 7) - 1024;
    const int grow0 = (lane >> 3) * 512 + (lane & 7) * 8;
    float bfar[16]; unsigned m4bits = 0u;
#pragma unroll
    for (int r = 0; r < 16; ++r) { const int d0 = q - crow(r, hi); bfar[r] = ((d0 & 15) == 0) ? 0.f : -INFINITY; m4bits |= (((d0 & 3) == 0) ? 1u : 0u) << r; }
    for (int c = blockIdx.x; c < 256; c += gridDim.x) {
        const int sl = c >> 3;
        for (int ui = 0; ui < 4; ++ui) {
            const int b = 4 * (c & 7) + ui, jj = (ui & 1) ? 31 - sl : sl; const size_t tok0 = (size_t)b * SEQ + 64 * jj;
            bf16x8 qf[2][4];
#pragma unroll
            for (int t = 0; t < 2; ++t)
#pragma unroll
                for (int ks = 0; ks < 4; ++ks) qf[t][ks] = *(const bf16x8*)(QB + (tok0 + 32 * t + q) * 512 + h * 64 + 16 * ks + 8 * hi);
            f32x16 o[2][2];
#pragma unroll
            for (int t = 0; t < 2; ++t) { o[t][0] = (f32x16){}; o[t][1] = (f32x16){}; }
            float m[2] = {-1e30f, -1e30f}, l[2] = {0.f, 0.f};
            const bf16* kb = KB + (size_t)b * SEQ * 512 + h * 64; const bf16* vb = VB + (size_t)b * SEQ * 512 + h * 64;
            const int nt = 2 * jj + 2;
            v4u kr[4], vr[4];
#pragma unroll
            for (int p = 0; p < 4; ++p) { const GAS bf16* kt = (const GAS bf16*)kb; const GAS bf16* vt = (const GAS bf16*)vb; LAUNDER_G(kt); LAUNDER_G(vt); kr[p] = *(const GAS v4u*)(kt + grow0 + 4096 * p); vr[p] = *(const GAS v4u*)(vt + grow0 + 4096 * p); }
#pragma unroll
            for (int t = 0; t < 2; ++t)
#pragma unroll
                for (int ks = 0; ks < 4; ++ks) asm volatile("" : "+v"(qf[t][ks]));
            for (int i = 0; i < nt; ++i) {
#pragma unroll
                for (int p = 0; p < 4; ++p) { *(LAS v4u*)(kimg + ((p & 1) ? wa_o : wa_e) + 1024 * p) = kr[p]; *(LAS v4u*)(vimg + ((p & 1) ? wa_o : wa_e) + 1024 * p) = vr[p]; }
                { const int i1 = (i + 1 < nt) ? i + 1 : i; const GAS bf16* kt = (const GAS bf16*)(kb + (size_t)i1 * 32 * 512); const GAS bf16* vt = (const GAS bf16*)(vb + (size_t)i1 * 32 * 512);
                  LAUNDER_G(kt); LAUNDER_G(vt);
#pragma unroll
                  for (int p = 0; p < 4; ++p) { kr[p] = *(const GAS v4u*)(kt + grow0 + 4096 * p); vr[p] = *(const GAS v4u*)(vt + grow0 + 4096 * p); } }
                f32x16 S[2]; bf16x8 pf[2][2];
#pragma unroll
                for (int t = 0; t < 2; ++t) {
                    const int dlt = 32 * (2 * jj + t - i);
                    if (dlt > 512) {
#pragma unroll
                        for (int r = 0; r < 16; ++r) S[t][r] = bfar[r];
                    } else if (dlt >= 192 && dlt < 512) {
#pragma unroll
                        for (int r = 0; r < 16; ++r) S[t][r] = (bfar[r] == 0.f) ? 1.f : (((m4bits >> r) & 1u) ? 0.f : -INFINITY);
                    } else {
#pragma unroll
                        for (int r = 0; r < 16; ++r) { const int df = dlt + q - crow(r, hi);
                            int w = (df <= 128 ? 1 : 0) + ((((df & 3) == 0) && df <= 512) ? 1 : 0) + (((df & 15) == 0) ? 1 : 0); if (df < 0) w = 0;
                            S[t][r] = (w == 0) ? -INFINITY : (w == 1) ? 0.f : (w == 2) ? 1.f : 1.5849625007211562f; }
                    }
                }
#pragma unroll
                for (int ks = 0; ks < 4; ++ks) { const bf16x8 kf = *(const LAS bf16x8*)(kimg + ((ks & 1) ? ra1 : ra0) + 512 * (ks >> 1)); S[0] = MFMA32(kf, qf[0][ks], S[0]); S[1] = MFMA32(kf, qf[1][ks], S[1]); }
#pragma unroll
                for (int t = 0; t < 2; ++t) {
                    softmax_tile<2>(S[t], m[t], l[t], o[t], pf[t]);
                }
#pragma unroll
                for (int dt = 0; dt < 2; ++dt)
#pragma unroll
                    for (int ks = 0; ks < 2; ++ks) { const bf16x8 vf = trfrag(vimg + ta0 + 2048 * ks + 512 * dt, vimg + ta1 + 2048 * ks + 512 * dt);
                        o[0][dt] = MFMA32(vf, pf[0][ks], o[0][dt]); o[1][dt] = MFMA32(vf, pf[1][ks], o[1][dt]); }
            }
#pragma unroll
            for (int t = 0; t < 2; ++t) {
                float lt = l[t]; lt += __shfl_xor(lt, 32); const float il = 1.0f / lt;
                bf16* orow = HX + (tok0 + 32 * t + q) * KOUT + 512 + h * 64 + 4 * hi;
#pragma unroll
                for (int dt = 0; dt < 2; ++dt)
#pragma unroll
                    for (int g = 0; g < 4; ++g) { v2u w; w.x = cvtpk(o[t][dt][4 * g] * il, o[t][dt][4 * g + 1] * il); w.y = cvtpk(o[t][dt][4 * g + 2] * il, o[t][dt][4 * g + 3] * il); *(v2u*)(orow + 32 * dt + 8 * g) = w; }
            }
        }
    }
}

template <int PHASE> __device__ __forceinline__ void p3_dilated_v4(Frame& F) {
    const bf16 *QB = wsp<bf16>(F, WS_QB), *KB = wsp<bf16>(F, WS_KB), *VB = wsp<bf16>(F, WS_VB); bf16* HX = wsp<bf16>(F, WS_HX); bf16* PB = wsp<bf16>(F, WS_PB); float* ML = wsp<float>(F, WS_ML);
    const int lane = F.lane, q = lane & 31, hi = lane >> 5, h = F.wave;
    LAS unsigned char* kimg = F.lds + F.wave * 16384; LAS unsigned char* vimg = kimg + 4096;
    const unsigned ra0 = rowread_addr<8>(lane, 0), ra1 = rowread_addr<8>(lane, 1);
    const unsigned ta0 = trread_addr<8>(lane, 0, 0, 0), ta1 = trread_addr<8>(lane, 0, 0, 1);
    const unsigned wa_e = off_img<8>(lane >> 3, lane & 7), wa_o = off_img<8>((lane >> 3) + 8, lane & 7) - 1024;
    float bdiag[16]; unsigned eqbits = 0u;
#pragma unroll
    for (int r = 0; r < 16; ++r) { const int d0 = q - crow(r, hi); bdiag[r] = (d0 >= 0) ? 0.f : -INFINITY; eqbits |= ((d0 == 0) ? 1u : 0u) << r; }
    for (int c = blockIdx.x; c < 256; c += gridDim.x) {
        const int sl = c >> 3;
#define DIL_PAR(uu_, b_, s_, r_, v_, md_) do { b_ = 4 * (c & 7) + (PHASE == 0 ? ((uu_) >> 1) : (uu_)); \
            if (PHASE == 0) { if (((uu_) & 1) == 0) { s_ = 16; r_ = sl >> 1; v_ = 64 * (sl & 1); md_ = 0; } else { s_ = 4; r_ = sl >> 3; v_ = 64 * (sl & 7); md_ = 1; } } \
            else { s_ = 1; r_ = 0; v_ = 64 * sl; md_ = 2; } } while (0)
#define DIL_LDQ(b_, s_, r_, v_) do { _Pragma("unroll") for (int t = 0; t < 2; ++t) _Pragma("unroll") for (int ks = 0; ks < 4; ++ks) \
            qf[t][ks] = *(const bf16x8*)(QB + ((size_t)(b_) * SEQ + (r_) + (size_t)(s_) * ((v_) + 32 * t + q)) * 512 + h * 64 + 16 * ks + 8 * hi); } while (0)
#define DIL_LDKV(b_, s_, r_, it_) do { const GAS bf16* kt = (const GAS bf16*)(KB + ((size_t)(b_) * SEQ + (r_) + (size_t)(it_) * 32 * (s_)) * 512 + h * 64); const GAS bf16* vt = (const GAS bf16*)(VB + ((size_t)(b_) * SEQ + (r_) + (size_t)(it_) * 32 * (s_)) * 512 + h * 64); \
            LAUNDER_G(kt); LAUNDER_G(vt); const int g0_ = (lane >> 3) * (s_) * 512 + (lane & 7) * 8, gs_ = 4096 * (s_); \
            _Pragma("unroll") for (int p = 0; p < 4; ++p) { kr[p] = *(const GAS v4u*)(kt + g0_ + gs_ * p); vr[p] = *(const GAS v4u*)(vt + g0_ + gs_ * p); } } while (0)
        constexpr int NU = (PHASE == 0 ? 8 : 4);
        bf16x8 qf[2][4]; v4u kr[4], vr[4];
        { int b, s, r0, vq0, mode; DIL_PAR(0, b, s, r0, vq0, mode); DIL_LDQ(b, s, r0, vq0); const int jt0 = vq0 >> 5; DIL_LDKV(b, s, r0, (jt0 > 4) ? jt0 - 4 : 0); (void)mode; }
        for (int uu = 0; uu < NU; ++uu) {
            int b, s, r0, vq0, mode; DIL_PAR(uu, b, s, r0, vq0, mode);
            int bn = b, sn = s, rn = r0, vn = vq0, mdn = mode; if (uu + 1 < NU) DIL_PAR(uu + 1, bn, sn, rn, vn, mdn);
            const int jn0 = vn >> 5, in0 = (jn0 > 4) ? jn0 - 4 : 0;
            const size_t tokb = (size_t)b * SEQ;
            f32x16 o[2][2];
#pragma unroll
            for (int t = 0; t < 2; ++t) { o[t][0] = (f32x16){}; o[t][1] = (f32x16){}; }
            float m[2] = {-1e30f, -1e30f}, l[2] = {0.f, 0.f};
            const int jt0 = vq0 >> 5, i0 = (jt0 > 4) ? jt0 - 4 : 0, i1 = jt0 + 1;
#pragma unroll
            for (int t = 0; t < 2; ++t)
#pragma unroll
                for (int ks = 0; ks < 4; ++ks) asm volatile("" : "+v"(qf[t][ks]));
            for (int i = i0; i <= i1; ++i) {
#pragma unroll
                for (int p = 0; p < 4; ++p) { *(LAS v4u*)(kimg + ((p & 1) ? wa_o : wa_e) + 1024 * p) = kr[p]; *(LAS v4u*)(vimg + ((p & 1) ? wa_o : wa_e) + 1024 * p) = vr[p]; }
                if (i < i1) DIL_LDKV(b, s, r0, i + 1); else DIL_LDKV(bn, sn, rn, in0);
                f32x16 S[2]; bf16x8 pf[2][2];
#pragma unroll
                for (int t = 0; t < 2; ++t) {
                    const int dt_ = jt0 + t - i;
                    if (dt_ >= 1 && dt_ <= 3) { S[t] = (f32x16){}; }
                    else if (dt_ == 0) {
#pragma unroll
                        for (int r = 0; r < 16; ++r) S[t][r] = bdiag[r];
                    } else if (dt_ == 4) {
#pragma unroll
                        for (int r = 0; r < 16; ++r) S[t][r] = (bdiag[r] != 0.f || ((eqbits >> r) & 1u)) ? 0.f : -INFINITY;
                    } else {
#pragma unroll
                        for (int r = 0; r < 16; ++r) S[t][r] = -INFINITY;
                    }
                }
#pragma unroll
                for (int ks = 0; ks < 4; ++ks) { const bf16x8 kf = *(const LAS bf16x8*)(kimg + ((ks & 1) ? ra1 : ra0) + 512 * (ks >> 1)); S[0] = MFMA32(kf, qf[0][ks], S[0]); S[1] = MFMA32(kf, qf[1][ks], S[1]); }
#pragma unroll
                for (int t = 0; t < 2; ++t) {
                    softmax_tile<2>(S[t], m[t], l[t], o[t], pf[t]);
                }
#pragma unroll
                for (int dt = 0; dt < 2; ++dt)
#pragma unroll
                    for (int ks = 0; ks < 2; ++ks) { const bf16x8 vf = trfrag(vimg + ta0 + 2048 * ks + 512 * dt, vimg + ta1 + 2048 * ks + 512 * dt);
                        o[0][dt] = MFMA32(vf, pf[0][ks], o[0][dt]); o[1][dt] = MFMA32(vf, pf[1][ks], o[1][dt]); }
            }
            if (uu + 1 < NU) DIL_LDQ(bn, sn, rn, vn);
            int ln_ = lane; asm volatile("" : "+v"(ln_));
            const int q_ = ln_ & 31, hi_ = ln_ >> 5;
#pragma unroll
            for (int t = 0; t < 2; ++t) {
                const size_t posq = r0 + (size_t)s * (vq0 + 32 * t + q_);
                float lt = l[t]; lt += __shfl_xor(lt, 32);
                float c1 = 1.0f, c3 = 0.f, c2 = 0.f;
                if (PHASE == 0) { if (hi_ == 0) *(f32x2*)(ML + ((((size_t)mode * NB + b) * 8 + h) * SEQ + (size_t)r0 * (SEQ / s) + (vq0 + 32 * t + q_)) * 2) = (f32x2){m[t], lt}; }
                else {
                    const f32x2 ml3 = *(const f32x2*)(ML + (((size_t)b * 8 + h) * SEQ + (posq & 15) * 128 + (posq >> 4)) * 2), ml2 = *(const f32x2*)(ML + ((((size_t)NB + b) * 8 + h) * SEQ + (posq & 3) * 512 + (posq >> 2)) * 2);
                    const float M = fmaxf(m[t], fmaxf(ml3[0], ml2[0]));
                    const float a1 = __builtin_amdgcn_exp2f(m[t] - M), a3 = __builtin_amdgcn_exp2f(ml3[0] - M), a2 = __builtin_amdgcn_exp2f(ml2[0] - M);
                    const float il = 1.0f / (a1 * lt + a3 * ml3[1] + a2 * ml2[1]);
                    c1 = a1 * il; c3 = a3 * il; c2 = a2 * il;
                }
                LAS unsigned char* tb = kimg + t * 4608;
#pragma unroll
                for (int dt = 0; dt < 2; ++dt)
#pragma unroll
                    for (int g = 0; g < 4; ++g) { v2u wv; wv.x = cvtpk(o[t][dt][4 * g] * c1, o[t][dt][4 * g + 1] * c1); wv.y = cvtpk(o[t][dt][4 * g + 2] * c1, o[t][dt][4 * g + 3] * c1);
                        *(LAS v2u*)(tb + q_ * 144 + (32 * dt + 8 * g + 4 * hi_) * 2) = wv; }
                if (PHASE != 0) { *(LAS f32x2*)(kimg + 9216 + t * 512 + q_ * 16 + hi_ * 8) = (f32x2){c3, c2}; }
            }
#pragma unroll
            for (int t = 0; t < 2; ++t)
#pragma unroll
                for (int pss = 0; pss < 4; ++pss) {
                    const int rw = 8 * pss + (ln_ >> 3), ch = ln_ & 7;
                    const size_t posr = r0 + (size_t)s * (vq0 + 32 * t + rw), tokr = tokb + posr;
                    v4u val = *(const LAS v4u*)(kimg + t * 4608 + rw * 144 + ch * 16);
                    bf16* hrow = HX + tokr * KOUT + 512 + h * 64 + ch * 8; bf16* prow = PB + tokr * 512 + h * 64 + ch * 8;
                    if (PHASE == 0) { *(v4u*)((mode == 0) ? prow : hrow) = val; }
                    else {
                        const f32x2 cw = *(const LAS f32x2*)(kimg + 9216 + t * 512 + rw * 16);
                        const v4u x3 = *(const v4u*)prow, x2 = *(const v4u*)hrow;
                        v4u y;
                        y.x = cvtpk(bflo(val.x) + cw[0] * bflo(x3.x) + cw[1] * bflo(x2.x), bfhi(val.x) + cw[0] * bfhi(x3.x) + cw[1] * bfhi(x2.x));
                        y.y = cvtpk(bflo(val.y) + cw[0] * bflo(x3.y) + cw[1] * bflo(x2.y), bfhi(val.y) + cw[0] * bfhi(x3.y) + cw[1] * bfhi(x2.y));
                        y.z = cvtpk(bflo(val.z) + cw[0] * bflo(x3.z) + cw[1] * bflo(x2.z), bfhi(val.z) + cw[0] * bfhi(x3.z) + cw[1] * bfhi(x2.z));
                        y.w = cvtpk(bflo(val.w) + cw[0] * bflo(x3.w) + cw[1] * bflo(x2.w), bfhi(val.w) + cw[0] * bfhi(x3.w) + cw[1] * bfhi(x2.w));
                        *(v4u*)hrow = y;
                    }
                }
            asm volatile("s_waitcnt lgkmcnt(0)" ::: "memory");
        }
    }
#undef DIL_PAR
#undef DIL_LDQ
#undef DIL_LDKV
}

typedef float f32x4v __attribute__((ext_vector_type(4)));
__device__ __forceinline__ void p2_index_mfma2(Frame& F) {
    const bf16 *QI = wsp<bf16>(F, WS_QI), *KI = wsp<bf16>(F, WS_KI); const float* WI = wsp<float>(F, WS_WI); unsigned* MASK = wsp<unsigned>(F, WS_MASK);
    unsigned* SC = wsp<unsigned>(F, WS_SC) + (size_t)blockIdx.x * (32 * 2048);
    const int lane = F.lane, w = F.wave, qh = w & 1, kg = w >> 1, ql = lane & 15, kq = lane >> 4;
    LAS unsigned char* kimg = F.lds + F.wave * 16384;
    LAS unsigned long long* lm = (LAS unsigned long long*)(kimg + 8192);
    const unsigned rra = kq * 528 + ql * 16;
    unsigned wa[4];
#pragma unroll
    for (int p = 0; p < 4; ++p) { const int e = lane + 64 * p; wa[p] = (e & 7) * 528 + (e >> 3) * 16; }
    for (int c = blockIdx.x; c < 256; c += gridDim.x) {
        for (int ui = 0; ui < 8; ++ui) {
            const int b = unit_batch(c, ui), j = unit_qtile(c, ui); const size_t tok0 = (size_t)b * SEQ + 32 * j;
            if (kg <= j) {
                const int qloc = 16 * qh + ql, qpos = 32 * j + qloc;
                const GAS bf16* qb_ = (const GAS bf16*)(QI + tok0 * 512); LAUNDER_G(qb_);
                bf16x8 qf[8][2];
#pragma unroll
                for (int hh = 0; hh < 8; ++hh)
#pragma unroll
                    for (int ks = 0; ks < 2; ++ks) qf[hh][ks] = *(const GAS bf16x8*)(qb_ + qloc * 512 + hh * 64 + 32 * ks + 8 * kq);
                const GAS float* wb_ = (const GAS float*)(WI + tok0 * 8); LAUNDER_G(wb_);
                const f32x4 wva = *(const GAS f32x4*)(wb_ + qloc * 8), wvb = *(const GAS f32x4*)(wb_ + qloc * 8 + 4);
                const float wq[8] = {wva[0], wva[1], wva[2], wva[3], wvb[0], wvb[1], wvb[2], wvb[3]};
                const bf16* kbase = KI + (size_t)b * SEQ * 64;
                v4u kr[4];
                { const GAS bf16* kt = (const GAS bf16*)(kbase + (size_t)kg * 32 * 64); LAUNDER_G(kt);
#pragma unroll
                  for (int p = 0; p < 4; ++p) kr[p] = *(const GAS v4u*)(kt + 8 * lane + 512 * p); }
#pragma unroll
                for (int hh = 0; hh < 8; ++hh) { asm volatile("" : "+v"(qf[hh][0])); asm volatile("" : "+v"(qf[hh][1])); }
                for (int i = kg; i <= j; i += 4) {
#pragma unroll
                    for (int p = 0; p < 4; ++p) *(LAS v4u*)(kimg + wa[p]) = kr[p];
                    { const int i1 = (i + 4 <= j) ? i + 4 : i; const GAS bf16* kt = (const GAS bf16*)(kbase + (size_t)i1 * 32 * 64); LAUNDER_G(kt);
#pragma unroll
                      for (int p = 0; p < 4; ++p) kr[p] = *(const GAS v4u*)(kt + 8 * lane + 512 * p); }
#pragma unroll
                    for (int kb = 0; kb < 2; ++kb) {
                        const bf16x8 k0 = *(const LAS bf16x8*)(kimg + rra + kb * 256), k1 = *(const LAS bf16x8*)(kimg + rra + 2112 + kb * 256);
                        f32x4v idx = (f32x4v){0.f, 0.f, 0.f, 0.f};
#pragma unroll
                        for (int hh = 0; hh < 8; ++hh) {
                            f32x4v S = __builtin_amdgcn_mfma_f32_16x16x32_bf16(k0, qf[hh][0], (f32x4v){0.f, 0.f, 0.f, 0.f}, 0, 0, 0);
                            S = __builtin_amdgcn_mfma_f32_16x16x32_bf16(k1, qf[hh][1], S, 0, 0, 0);
#pragma unroll
                            for (int e = 0; e < 4; ++e) idx[e] = fmaf(__builtin_amdgcn_fmed3f(S[e], 0.f, __builtin_inff()), wq[hh], idx[e]);
                        }
                        v4u kv;
#pragma unroll
                        for (int e = 0; e < 4; ++e) { const int s = 32 * i + 16 * kb + 4 * kq + e; unsigned ord = __float_as_uint(idx[e]); ord ^= (ord >> 31) ? 0xFFFFFFFFu : 0x80000000u;
                            kv[e] = (s <= qpos) ? ((ord & 0xFFFFF800u) | (unsigned)(SEQ - 1 - s)) : 0u; }
                        { GAS unsigned* sct = (GAS unsigned*)(SC + 32 * i + 16 * kb); LAUNDER_G(sct); *(GAS v4u*)(sct + qloc * 2048 + 4 * kq) = kv; }
                    }
                }
            }
            __syncthreads();
#define SEL_LOAD(K, n) do { const GAS unsigned* sr = (const GAS unsigned*)(SC + (size_t)(4 * w + (n)) * 2048); LAUNDER_G(sr); \
                _Pragma("unroll") for (int r = 0; r < 32; ++r) K[r] = sr[r * 64 + lane]; } while (0)
#define SEL_RUN(K, n) do { const int qq = 4 * w + (n), qp = 32 * j + qq, nr = (qp >> 6) + 1; const size_t t = tok0 + qq; \
                _Pragma("unroll") for (int r = 0; r < 32; ++r) K[r] = (r * 64 + lane <= qp) ? K[r] : 0u; \
                unsigned thr = 1u; \
                if (qp >= 256) { \
                    unsigned lo = 0u; \
                    _Pragma("unroll 1") for (int bit = 31; bit >= 0; --bit) { \
                        const unsigned cand = lo | (1u << bit); int cnt = 0; \
                        _Pragma("unroll") for (int g = 0; g < 4; ++g) if (8 * g < nr) { \
                            unsigned long long m0, m1, m2, m3, m4, m5, m6, m7; \
                            asm volatile("v_cmp_ge_u32_e64 %0, %8, %16\n\tv_cmp_ge_u32_e64 %1, %9, %16\n\tv_cmp_ge_u32_e64 %2, %10, %16\n\tv_cmp_ge_u32_e64 %3, %11, %16\n\t" \
                                         "v_cmp_ge_u32_e64 %4, %12, %16\n\tv_cmp_ge_u32_e64 %5, %13, %16\n\tv_cmp_ge_u32_e64 %6, %14, %16\n\tv_cmp_ge_u32_e64 %7, %15, %16" \
                                         : "=&s"(m0), "=&s"(m1), "=&s"(m2), "=&s"(m3), "=&s"(m4), "=&s"(m5), "=&s"(m6), "=&s"(m7) \
                                         : "v"(K[8 * g]), "v"(K[8 * g + 1]), "v"(K[8 * g + 2]), "v"(K[8 * g + 3]), "v"(K[8 * g + 4]), "v"(K[8 * g + 5]), "v"(K[8 * g + 6]), "v"(K[8 * g + 7]), "s"(cand)); \
                            cnt += (__popcll(m0) + __popcll(m1)) + (__popcll(m2) + __popcll(m3)) + (__popcll(m4) + __popcll(m5)) + (__popcll(m6) + __popcll(m7)); } \
                        if (cnt >= 256) lo = cand; \
                        if (cnt == 256) break; \
                    } \
                    thr = lo; \
                } \
                  \
                thr = (thr < 1u) ? 1u : thr; unsigned mlo = 0u, mhi = 0u; \
                _Pragma("unroll") for (int r = 0; r < 32; ++r) { const unsigned long long bm = __ballot(K[r] >= thr); \
                    asm volatile("s_nop 4\n\tv_writelane_b32 %0, %2, %4\n\tv_writelane_b32 %1, %3, %4" : "+v"(mlo), "+v"(mhi) : "s"((unsigned)bm), "s"((unsigned)(bm >> 32)), "n"(r)); } \
                { GAS unsigned* mb_ = (GAS unsigned*)(MASK + t * 64); LAUNDER_G(mb_); if (lane < 32) { v2u mv_; mv_.x = mlo; mv_.y = mhi; *(GAS v2u*)(mb_ + 2 * lane) = mv_; } } \
                LDS_WAIT(); } while (0)
            { unsigned kA[32], kB[32];
              SEL_LOAD(kA, 0);
              SEL_LOAD(kB, 1); SEL_RUN(kA, 0);
              SEL_LOAD(kA, 2); SEL_RUN(kB, 1);
              SEL_LOAD(kB, 3); SEL_RUN(kA, 2);
              SEL_RUN(kB, 3); }
#undef SEL_LOAD
#undef SEL_RUN
            __syncthreads();
        }
    }
}

__device__ __forceinline__ void p10_final(Frame& F) {
    const float* parts = wsp<float>(F, WS_P3); const float* g = inp(F, 16); const bf16* XB = wsp<bf16>(F, WS_XB);
    f32x4 gv[4];
#pragma unroll
    for (int j = 0; j < 4; ++j) gv[j] = *((const f32x4*)g + F.lane + 64 * j);
    for (int r0 = F.gw; r0 < T; r0 += 4 * F.NGW) {
        v2u w[4][4]; float rs[4];
#pragma unroll
        for (int u = 0; u < 4; ++u) { const int r = r0 + u * F.NGW; const v2u* xi = (const v2u*)(XB + (size_t)r * DM) + F.lane;
#pragma unroll
            for (int j = 0; j < 4; ++j) w[u][j] = xi[64 * j];
            rs[u] = rstd_from_parts(parts, r); }
#pragma unroll
        for (int u = 0; u < 4; ++u) { const int r = r0 + u * F.NGW; f32x4* o = (f32x4*)(outp(F) + (size_t)r * DM) + F.lane;
#pragma unroll
            for (int j = 0; j < 4; ++j) __builtin_nontemporal_store((f32x4){bflo(w[u][j].x), bfhi(w[u][j].x), bflo(w[u][j].y), bfhi(w[u][j].y)} * rs[u] * gv[j], o + 64 * j); }
    }
}

#define RLX_AGENT __ATOMIC_RELAXED, __HIP_MEMORY_SCOPE_AGENT
#define XB_TMO      128
#define XB_XCNT(j)  (256  + 64 * (j))
#define XB_XSUB(j)  (1280 + 64 * (j))
#define XB_XGEN(j)  (2304 + 64 * (j))
#define XB_TOP      3328
#define XB_TOPGEN   3392
#define XCD_BAR_WORDS 3456
#define XB_SPIN_CAP (1u << 18)

__device__ __forceinline__ unsigned xb_ld(unsigned* p)              { return __hip_atomic_load(p, __ATOMIC_RELAXED, __HIP_MEMORY_SCOPE_AGENT); }
__device__ __forceinline__ unsigned xb_add(unsigned* p, unsigned v) { return __hip_atomic_fetch_add(p, v, __ATOMIC_RELAXED, __HIP_MEMORY_SCOPE_AGENT); }
__device__ __forceinline__ unsigned xb_xcc_id() { return (unsigned)__builtin_amdgcn_s_getreg((3 << 11) | 20) & 0xFu; }
#define XB_SPIN(cond, bar) do { unsigned _sp = 0; while (cond) { __builtin_amdgcn_s_sleep(1); \
    if ((++_sp & 255u) == 0u) { if (xb_ld(&(bar)[XB_TMO])) break; if (_sp > XB_SPIN_CAP) { atomicAdd(&(bar)[XB_TMO], 1u); break; } } } } while (0)

struct XcdBarrier {
    unsigned* bar; unsigned x;
    volatile LAS unsigned* st;
};

__device__ __forceinline__ XcdBarrier xcd_barrier_post(unsigned* bar, volatile LAS unsigned* st) {
    XcdBarrier b; b.bar = bar; b.x = xb_xcc_id(); b.st = st;
    if (threadIdx.x == 0) (void)xb_add(&bar[XB_XCNT(b.x)], 1u);
    return b;
}
__device__ __forceinline__ void xcd_barrier_complete(unsigned* bar, unsigned x, unsigned& nloc, unsigned& nx) {
    const unsigned G = gridDim.x * gridDim.y * gridDim.z;
    unsigned sum, cnt, mine, sp = 0u;
    for (;;) {
        sum = 0u; cnt = 0u; mine = 0u;
#pragma unroll
        for (unsigned j = 0; j < 16; ++j) { const unsigned c = xb_ld(&bar[XB_XCNT(j)]); sum += c; cnt += (c > 0u) ? 1u : 0u; mine = (j == x) ? c : mine; }
        if (sum == G) break;
        __builtin_amdgcn_s_sleep(1);
        if ((++sp & 255u) == 0u) { if (xb_ld(&bar[XB_TMO])) break; if (sp > XB_SPIN_CAP) { atomicAdd(&bar[XB_TMO], 1u); break; } }
    }
    nloc = mine > 0u ? mine : 1u; nx = cnt > 0u ? cnt : 1u;
}

__device__ __forceinline__ void xcd_barrier(const XcdBarrier& b, const bool t0) {
    asm volatile("s_waitcnt vmcnt(0)" ::: "memory");
    __syncthreads();
    if (t0) {
        unsigned* bar = b.bar;
        __builtin_amdgcn_s_waitcnt(0);
        unsigned nloc = b.st[0], nx = b.st[1];
        if (nloc == 0u) { xcd_barrier_complete(bar, b.x, nloc, nx); b.st[0] = nloc; b.st[1] = nx; }
        const unsigned old = xb_add(&bar[XB_XSUB(b.x)], 1u);
        const unsigned gen = old / nloc;
        if (old + 1u == (gen + 1u) * nloc) {
            __builtin_amdgcn_fence(__ATOMIC_RELEASE, "agent");
            asm volatile("s_waitcnt vmcnt(0)" ::: "memory");
            const unsigned og = xb_add(&bar[XB_TOP], 1u);
            const unsigned tg = og / nx;
            if (og + 1u == (tg + 1u) * nx) xb_add(&bar[XB_TOPGEN], 1u);
            else XB_SPIN(xb_ld(&bar[XB_TOPGEN]) == tg, bar);
            __builtin_amdgcn_fence(__ATOMIC_ACQUIRE, "agent");
            xb_add(&bar[XB_XGEN(b.x)], 1u);
            asm volatile("s_waitcnt vmcnt(0)" ::: "memory");
        } else {
            XB_SPIN(xb_ld(&bar[XB_XGEN(b.x)]) == gen, bar);
            __builtin_amdgcn_fence(__ATOMIC_ACQUIRE, "agent");
            asm volatile("s_waitcnt vmcnt(0)" ::: "memory");
        }
    }
    __syncthreads();
}

__device__ __forceinline__ void stagger_delay(int ticks100mhz) {
    if (ticks100mhz > 0) { const unsigned long long t0 = __builtin_amdgcn_s_memrealtime(); while (__builtin_amdgcn_s_memrealtime() - t0 < (unsigned long long)ticks100mhz) __builtin_amdgcn_s_sleep(32); }
}
struct Args { const float* in[17]; float* out; unsigned char* ws; int ph_lo, ph_hi; };
__global__ void __launch_bounds__(NWAVES * 64, 2) fwd_kernel(Args args) {
    extern __shared__ __attribute__((aligned(16))) unsigned char lds[];
    cg::grid_group grid = cg::this_grid();
    Frame F;
    F.lds = (LAS unsigned char*)lds;
    F.kargs = (const __attribute__((address_space(4))) char*)__builtin_amdgcn_kernarg_segment_ptr();
    F.out = args.out; F.ws = args.ws; F.wave_s = __builtin_amdgcn_readfirstlane((int)threadIdx.x >> 6); phase_ctx(F);
    volatile LAS unsigned* MISC = (volatile LAS unsigned*)(F.lds + 131072 + 64);
    if (threadIdx.x < 16) MISC[threadIdx.x] = 0u;
    __syncthreads();
    XcdBarrier bar = xcd_barrier_post((unsigned*)(args.ws + WS_CTL) + 1024, MISC + 8);
    const int lo = args.ph_lo, hi = args.ph_hi;
    if (hi < 0) grid.sync();
#define IN(k) (((PH_MASK >> (k)) & 1) && lo <= (k) && (k) < hi)
#define SEAM(k) do { if (IN(k) && IN((k) + 1)) { phase_ctx(F); xcd_barrier(bar, F.tid == 0); } phase_ctx(F); } while (0)
    LAS unsigned char* ring = (LAS unsigned char*)lds;

    if (IN(0)) { p0_prologue(F); if (DUP_MASK & 1) p0_prologue(F); }
    SEAM(0);
    if (IN(1)) for (int rep_ = 0; rep_ < ((DUP_MASK & 2) ? 2 : 1); ++rep_) {
        { pg8::Gemm g{wsp<bf16>(F, WS_XB), wsp<bf16>(F, WS_WIN), T, NIN, DM, DM, DM}; pg8::StaticOrder S; S.init(g, F.G, (int)blockIdx.x);
          EpiInProj E{wsp<unsigned char>(F, 0)};
          pg8::gemm_phase<EpiInProj, pg8::StaticOrder, true, true>(ring, g, S, E, F.wave); }
        { pg8::Gemm g{wsp<bf16>(F, WS_MEMB), wsp<bf16>(F, WS_WKV), TM, 2048, DM, DM, DM}; pg8::StaticOrder S; S.init(g, F.G, (int)blockIdx.x);
          EpiRowScale<0> E{wsp<bf16>(F, WS_KVC), 2048, wsp<float>(F, WS_RSTDM), nullptr, 1.0f, F.lds + LDS_TP + F.wave * 2048};
          pg8::gemm_phase<EpiRowScale<0>, pg8::StaticOrder, true, true>(ring, g, S, E, F.wave); }
    }
    SEAM(1);
    if (IN(2)) { p2_ckv_norm(F); p2_index_mfma2(F); if (DUP_MASK & 4) { __syncthreads(); p2_index_mfma2(F); } __syncthreads(); phase_ctx(F); p3_dilated_v4<0>(F); if (DUP_MASK & 32) p3_dilated_v4<0>(F); }
    SEAM(2);
    if (IN(3)) { if (DUP_MASK & 0x1000) p3_dsa_mfma5<1>(F); if (DUP_MASK & 0x2000) p3_dsa_mfma5<2>(F); if (DUP_MASK & 0x4000) p3_dsa_mfma5<3>(F); p3_dsa_mfma5<0>(F); if (DUP_MASK & 8) p3_dsa_mfma5<0>(F); p3_dilated_v4<1>(F); if (DUP_MASK & 16) p3_dilated_v4<1>(F); }
    SEAM(3);
    if (IN(4)) {
        int k256 = 256; asm volatile("" : "+s"(k256));
        { pg8::Gemm g{wsp<bf16>(F, WS_KVC), wsp<bf16>(F, WS_WQ), TM, DM, k256, 2048, DM};
          PreOrderA S{(int)blockIdx.x, (const char*)wsp<bf16>(F, WS_KVC), (const char*)wsp<bf16>(F, WS_WQ)};
          EpiRowScale<2> E{wsp<bf16>(F, WS_MT), DM, nullptr, nullptr, 1.0f, F.lds + LDS_TP + F.wave * 2048};
          pg8::gemm_phase<EpiRowScale<2>, PreOrderA, true, true>(ring, g, S, E, F.wave); }
        __syncthreads(); phase_ctx(F);
        { pg8::Gemm g{wsp<bf16>(F, WS_WO), wsp<bf16>(F, WS_KVC), DM, TM, k256, DM, 2048};
          PreOrderB S{(int)blockIdx.x, (const char*)wsp<bf16>(F, WS_KVC), (const char*)wsp<bf16>(F, WS_WO)};
          EpiRowScale<2> E{wsp<bf16>(F, WS_MT), DM, nullptr, nullptr, 1.0f, F.lds + LDS_TP + F.wave * 2048};
          pg8::gemm_phase<EpiRowScale<2>, PreOrderB, true, true>(ring, g, S, E, F.wave); }
        __syncthreads(); phase_ctx(F);
        { pg8::Gemm g{wsp<bf16>(F, WS_HX), wsp<bf16>(F, WS_WOUT), T, DM, KOUT, KOUT, KOUT}; pg8::StaticOrder S; S.init(g, F.G, (int)blockIdx.x);
          EpiResid E{wsp<bf16>(F, WS_XB), wsp<float>(F, WS_P1)};
          pg8::gemm_phase<EpiResid, pg8::StaticOrder, true, true>(ring, g, S, E, F.wave); }
    }
    SEAM(4);
    if (IN(5)) for (int rep_ = 0; rep_ < ((DUP_MASK & 32) ? 2 : 1); ++rep_) {
        pg8::Gemm g{wsp<bf16>(F, WS_XB), wsp<bf16>(F, WS_MT), T, DM, DM, DM, DM}; BatchOrder S; S.so.init(g, F.G, (int)blockIdx.x); S.bstride = (size_t)DM * DM * 2;
        EpiSoftmaxP E{wsp<bf16>(F, WS_QC), (LAS float*)(F.lds + 131072 + 1024), wsp<float>(F, WS_P1)};
        pg8::gemm_phase<EpiSoftmaxP, BatchOrder, true, true>(ring, g, S, E, F.wave);
    }
    SEAM(5);
    if (IN(6)) {
        pg8::Gemm g{wsp<bf16>(F, WS_QC), wsp<bf16>(F, WS_MT) + (size_t)32768 * DM, T, DM, DM, DM, DM}; BatchOrder S; S.so.init(g, F.G, (int)blockIdx.x); S.bstride = (size_t)DM * DM * 2;
        EpiResid E{wsp<bf16>(F, WS_XB), wsp<float>(F, WS_P2)};
        pg8::gemm_phase<EpiResid, BatchOrder, true, true>(ring, g, S, E, F.wave);
    }
    SEAM(6);
    if (IN(7)) for (int rep_ = 0; rep_ < ((DUP_MASK & 64) ? 2 : 1); ++rep_) {
        pg8::Gemm g{wsp<bf16>(F, WS_XB), wsp<bf16>(F, WS_WUP), T, FF, DM, DM, DM}; pg8::StaticOrder S; S.init(g, F.G, (int)blockIdx.x);
        EpiRowScale<1> E{wsp<bf16>(F, WS_HID), FF, nullptr, wsp<float>(F, WS_P2), 1.0f, F.lds + LDS_TP + F.wave * 2048};
        pg8::gemm_phase<EpiRowScale<1>, pg8::StaticOrder, true, true>(ring, g, S, E, F.wave);
    }
    SEAM(7);
    if (IN(8)) {
        pg8::Gemm g{wsp<bf16>(F, WS_HID), wsp<bf16>(F, WS_WDN), T, DM, FF, FF, FF}; pg8::StaticOrder S; S.init(g, F.G, (int)blockIdx.x);
        EpiResid E{wsp<bf16>(F, WS_XB), wsp<float>(F, WS_P3)};
        pg8::gemm_phase<EpiResid, pg8::StaticOrder, true, true>(ring, g, S, E, F.wave);
    }
    SEAM(8);
    if (IN(9)) { p10_final(F); }
#undef IN
#undef SEAM
}

#ifndef N_LAUNCH_SPLIT
#define N_LAUNCH_SPLIT 0
#endif
extern "C" void kernel_launch(void* const* d_in, const int* in_sizes, int n_in, void* d_out, int out_size, void* d_ws, size_t ws_size, hipStream_t stream) {
    static int grid = 0;
    if (grid == 0) {
        if (n_in != 17 || out_size != T * DM || ws_size < WS_END) { fprintf(stderr, "kernel_launch: unexpected shapes: n_in %d out %d ws %zu\n", n_in, out_size, ws_size); grid = -1; return; }
        int dev = 0, cus = 0, per_cu = 0;
        if (hipGetDevice(&dev) != hipSuccess || hipDeviceGetAttribute(&cus, hipDeviceAttributeMultiprocessorCount, dev) != hipSuccess) { grid = -1; return; }
        if (hipFuncSetAttribute((const void*)fwd_kernel, hipFuncAttributeMaxDynamicSharedMemorySize, LDS_BYTES) != hipSuccess) { fprintf(stderr, "hipFuncSetAttribute failed\n"); grid = -1; return; }
        if (hipOccupancyMaxActiveBlocksPerMultiprocessor(&per_cu, (const void*)fwd_kernel, NWAVES * 64, LDS_BYTES) != hipSuccess || per_cu < 1) { fprintf(stderr, "occupancy query: %d\n", per_cu); per_cu = 1; }
        (void)hipGetLastError();
        grid = cus;
        fprintf(stderr, "kernel_launch: cus %d per_cu %d grid %d ws %zu\n", cus, per_cu, grid, ws_size);
    }
    if (grid < 0) return;
    if (hipMemsetAsync((char*)d_ws + WS_CTL, 0, 65536, stream) != hipSuccess) { fprintf(stderr, "memset failed\n"); return; }
    Args a{};
    for (int i = 0; i < 17; ++i) a.in[i] = (const float*)d_in[i];
    a.out = (float*)d_out; a.ws = (unsigned char*)d_ws;
#if N_LAUNCH_SPLIT
    for (int p = 0; p < 10; ++p) { a.ph_lo = p; a.ph_hi = p + 1; void* kargs[] = {&a};
        hipError_t e = hipLaunchCooperativeKernel((const void*)fwd_kernel, dim3(grid), dim3(NWAVES * 64), kargs, LDS_BYTES, stream);
        if (e != hipSuccess) { fprintf(stderr, "launch %d failed: %s\n", p, hipGetErrorString(e)); break; } }
#else
    a.ph_lo = 0; a.ph_hi = 10; void* kargs[] = {&a};
    hipError_t e = hipLaunchCooperativeKernel((const void*)fwd_kernel, dim3(grid), dim3(NWAVES * 64), kargs, LDS_BYTES, stream);
    if (e != hipSuccess) fprintf(stderr, "cooperative launch failed: %s (grid %d)\n", hipGetErrorString(e), grid);
#endif
}
```

```cpp
#include <hip/hip_runtime.h>
#include <hip/hip_cooperative_groups.h>
#include <cstdio>
#include <cstdint>
namespace cg = cooperative_groups;
namespace pg8 {
#define PG8_LAS __attribute__((address_space(3)))
typedef unsigned short bf16_t;
typedef short bf16x8 __attribute__((ext_vector_type(8)));
typedef float f32x4 __attribute__((ext_vector_type(4)));
typedef unsigned u32x4 __attribute__((ext_vector_type(4)));
constexpr int BM = 256, BK = 64, HALF = 128, HTB = HALF * BK * 2  , STAGE_BYTES = 8 * HTB, NXCD = 8, WGM = 8;

__host__ __device__ __forceinline__ int lds_byte(int r, int c) { const int st = (r >> 4) * 2 + (c >> 5), rr = r & 15, cc = c & 31, ob = rr * 64 + cc * 2; return st * 1024 + (ob ^ (((ob >> 9) & 1) << 5)); }
__host__ __device__ __forceinline__ void stage_rc(int b, int& R, int& C) { const int st = b / 1024, sb = b % 1024, swz = sb ^ (((sb >> 9) & 1) << 5); R = (st >> 1) * 16 + swz / 64; C = (st & 1) * 32 + (swz % 64) / 2; }
__host__ __device__ __forceinline__ int perm32(int rho) { const int n = rho >> 4, i = rho & 15; return 8 * (i >> 2) + 4 * n + (i & 3); }

struct Unit { int pm, pn; const char* pa; const char* pb; };
struct Gemm { const bf16_t* A; const bf16_t* Bt; int M, N, K, lda, ldb; };

struct StaticOrder {
    int nM, nN, nwg, G, c; const char* A; const char* B; size_t ta, tb;
    __host__ __device__ void init(const Gemm& g, int G_, int c_) { nM = g.M / BM; nN = g.N / BM; nwg = nM * nN; G = G_; c = c_; A = (const char*)g.A; B = (const char*)g.Bt; ta = (size_t)BM * g.lda * 2; tb = (size_t)BM * g.ldb * 2; }
    __host__ __device__ bool next(int i, Unit& u) const {
        const long L = (long)i * G + c; if (L >= nwg) return false;
        int wgid = (int)L; { const int q = nwg / NXCD, r = nwg % NXCD, xcd = wgid % NXCD, off = wgid / NXCD; wgid = (xcd < r ? xcd * (q + 1) : r * (q + 1) + (xcd - r) * q) + off; }
        const int nig = WGM * nN, gid = wgid / nig, fm = gid * WGM, gsz = (nM - fm) < WGM ? (nM - fm) : WGM;
        u.pm = fm + ((wgid % nig) % gsz); u.pn = (wgid % nig) / gsz; u.pa = A + (size_t)u.pm * ta; u.pb = B + (size_t)u.pn * tb; return true;
    }
    __device__ __forceinline__ void a_ready(const Unit&) const {}
    __device__ __forceinline__ void done(const Unit&) const {}
};


template <class Epi, class Sched, bool ALIGN_EPI = false, bool SP2 = false>
__device__ __forceinline__ void gemm_phase(PG8_LAS unsigned char* lds, const Gemm g, const Sched& S, const Epi& E, int wave_id) {
    unsigned ones_ = ~0u; asm volatile("" : "+s"(ones_));
    int tid_ = wave_id * 64 + (int)__builtin_amdgcn_mbcnt_hi(ones_, __builtin_amdgcn_mbcnt_lo(ones_, 0u)); asm volatile("" : "+v"(tid_));
    const int tid = tid_, wid = __builtin_amdgcn_readfirstlane(tid >> 6), lane = tid & 63, wr = wid >> 2, wc = wid & 3, fr = lane & 15, fq = lane >> 4;
    const int K = g.K, nt = K / BK;
    unsigned voffA[2], voffB[2];
#pragma unroll
    for (int i = 0; i < 2; ++i) { int R, C; stage_rc(tid * 16 + i * 8192, R, C); const int Rb = Epi::PERM ? (Epi::ADJ ? ((R >> 5) * 64 + perm32(R & 31)) : ((R & ~31) + perm32(R & 31))) : R;
        voffA[i] = (unsigned)(R * g.lda + C) * 2u; voffB[i] = (unsigned)(Rb * g.ldb + C) * 2u; }
    const size_t kstep = (size_t)(BK * 2);
    const size_t hstepA = (size_t)HALF * g.lda * 2, hstepB = (size_t)(Epi::ADJ ? 32 : HALF) * g.ldb * 2;
    const unsigned ldsw = (unsigned)wid * 1024u;
    const int aoff = lds_byte(wr * 64 + fr, fq * 8), boff = lds_byte(wc * 32 + fr, fq * 8);
#define PG8_SA(b, h) (((b) * 2 + (h)) * HTB)
#define PG8_SB(b, h) ((4 + (b) * 2 + (h)) * HTB)
#define PG8_STAGE(bufoff, gbase, voff) do { _Pragma("unroll") for (int _i = 0; _i < 2; ++_i) \
        __builtin_amdgcn_global_load_lds((const unsigned*)((const char*)(gbase) + (voff)[_i]), (PG8_LAS unsigned*)(lds + (bufoff) + ldsw + _i * 8192), 16, 0, 0); } while (0)
#define PG8_LDA(dst, b, h) do { _Pragma("unroll") for (int m = 0; m < 4; ++m) _Pragma("unroll") for (int k = 0; k < 2; ++k) dst[m][k] = *(const PG8_LAS bf16x8*)(lds + PG8_SA(b, h) + aoff + m * 2048 + k * 1024); } while (0)
#define PG8_LDB(dst, b, h) do { _Pragma("unroll") for (int n = 0; n < 2; ++n) _Pragma("unroll") for (int k = 0; k < 2; ++k) dst[n][k] = *(const PG8_LAS bf16x8*)(lds + PG8_SB(b, h) + boff + n * 2048 + k * 1024); } while (0)
#define PG8_MMA(ai, bj, At, Bt) do { __builtin_amdgcn_s_setprio(1); _Pragma("unroll") for (int m = 0; m < 4; ++m) _Pragma("unroll") for (int n = 0; n < 2; ++n) _Pragma("unroll") for (int k = 0; k < 2; ++k) \
        acc[ai][bj][m][n] = __builtin_amdgcn_mfma_f32_16x16x32_bf16(Bt[n][k], At[m][k], acc[ai][bj][m][n], 0, 0, 0); __builtin_amdgcn_s_setprio(0); } while (0)
#define PG8_WAIT_V(n) asm volatile("s_waitcnt vmcnt(" #n ")" ::: "memory")
#define PG8_WAIT_L(n) asm volatile("s_waitcnt lgkmcnt(" #n ")" ::: "memory")
#define PG8_BAR __builtin_amdgcn_s_barrier()
#define PG8_SCHED __builtin_amdgcn_sched_barrier(0)
    Unit cur, nxt; int ui = 0;
    if (!S.next(0, cur)) return;
    f32x4 acc[2][2][4][2];
#pragma unroll
    for (int a = 0; a < 2; ++a)
#pragma unroll
        for (int b = 0; b < 2; ++b)
#pragma unroll
            for (int m = 0; m < 4; ++m)
#pragma unroll
                for (int n = 0; n < 2; ++n) acc[a][b][m][n] = (f32x4){0.f, 0.f, 0.f, 0.f};
    bf16x8 At[4][2], B0[2][2], B1[2][2];
    const char* cA = cur.pa; const char* cB = cur.pb;
    S.a_ready(cur);
    if constexpr (SP2) {
        PG8_STAGE(PG8_SB(0, 0), cB, voffB); PG8_STAGE(PG8_SB(0, 1), cB + hstepB, voffB); PG8_STAGE(PG8_SA(0, 0), cA, voffA); PG8_STAGE(PG8_SA(0, 1), cA + hstepA, voffA);
        if (wr == 1) PG8_BAR;
        PG8_WAIT_V(2); PG8_BAR;
        PG8_STAGE(PG8_SB(1, 0), cB + kstep, voffB); PG8_STAGE(PG8_SA(1, 0), cA + kstep, voffA); PG8_STAGE(PG8_SB(1, 1), cB + hstepB + kstep, voffB);
        PG8_WAIT_V(6); PG8_BAR;
    } else {
        PG8_STAGE(PG8_SB(0, 0), cB, voffB); PG8_STAGE(PG8_SA(0, 0), cA, voffA); PG8_STAGE(PG8_SB(0, 1), cB + hstepB, voffB); PG8_STAGE(PG8_SA(0, 1), cA + hstepA, voffA);
        if (wr == 1) PG8_BAR;
        PG8_WAIT_V(4); PG8_BAR;
        PG8_STAGE(PG8_SB(1, 0), cB + kstep, voffB); PG8_STAGE(PG8_SA(1, 0), cA + kstep, voffA); PG8_STAGE(PG8_SB(1, 1), cB + hstepB + kstep, voffB);
        PG8_WAIT_V(6); PG8_BAR;
    }
    for (;;) {
        const bool has_next = S.next(ui + 1, nxt);
        const char* nA = has_next ? nxt.pa : cA; const char* nB = has_next ? nxt.pb : cB;
        for (int t = 0; t < nt; t += 2) {
            const bool last = (t == nt - 2);
            const char* a1 = cA + (size_t)(t + 1) * kstep;
            const char* a2 = last ? nA : cA + (size_t)(t + 2) * kstep; const char* b2 = last ? nB : cB + (size_t)(t + 2) * kstep;
            const char* a3 = a2 + kstep; const char* b3 = b2 + kstep;
            if (last && has_next) S.a_ready(nxt);
            if constexpr (SP2) {
            PG8_LDB(B0, 0, 0); PG8_LDB(B1, 0, 1); PG8_SCHED; PG8_LDA(At, 0, 0); PG8_STAGE(PG8_SA(1, 1), a1 + hstepA, voffA);
            PG8_WAIT_V(8); PG8_WAIT_L(0); PG8_BAR; PG8_MMA(0, 0, At, B0); PG8_MMA(0, 1, At, B1); PG8_BAR; PG8_SCHED;
            PG8_LDA(At, 0, 1); PG8_STAGE(PG8_SB(0, 0), b2, voffB); PG8_STAGE(PG8_SB(0, 1), b2 + hstepB, voffB); PG8_STAGE(PG8_SA(0, 0), a2, voffA);
            PG8_WAIT_V(8); PG8_WAIT_L(0); PG8_BAR; PG8_MMA(1, 0, At, B0); PG8_MMA(1, 1, At, B1); PG8_BAR; PG8_SCHED;
            PG8_LDB(B0, 1, 0); PG8_LDB(B1, 1, 1); PG8_SCHED; PG8_LDA(At, 1, 0); PG8_STAGE(PG8_SA(0, 1), a2 + hstepA, voffA);
            PG8_WAIT_V(8); PG8_WAIT_L(0); PG8_BAR; PG8_MMA(0, 0, At, B0); PG8_MMA(0, 1, At, B1); PG8_BAR; PG8_SCHED;
            PG8_LDA(At, 1, 1); PG8_STAGE(PG8_SB(1, 0), b3, voffB); PG8_STAGE(PG8_SB(1, 1), b3 + hstepB, voffB); PG8_STAGE(PG8_SA(1, 0), a3, voffA);
            PG8_WAIT_V(8); PG8_WAIT_L(0); PG8_BAR; PG8_MMA(1, 0, At, B0); PG8_MMA(1, 1, At, B1); PG8_BAR; PG8_SCHED;
            } else {
            PG8_LDB(B0, 0, 0); PG8_SCHED; PG8_LDA(At, 0, 0); PG8_STAGE(PG8_SA(1, 1), a1 + hstepA, voffA);
            PG8_WAIT_L(8); PG8_BAR; PG8_WAIT_L(0); PG8_MMA(0, 0, At, B0); PG8_BAR; PG8_SCHED;
            PG8_LDB(B1, 0, 1); PG8_STAGE(PG8_SB(0, 0), b2, voffB);
            PG8_BAR; PG8_WAIT_L(0); PG8_MMA(0, 1, At, B1); PG8_BAR;
            PG8_LDA(At, 0, 1); PG8_STAGE(PG8_SA(0, 0), a2, voffA);
            PG8_BAR; PG8_WAIT_L(0); PG8_MMA(1, 0, At, B0); PG8_BAR; PG8_SCHED;
            PG8_STAGE(PG8_SB(0, 1), b2 + hstepB, voffB);
            PG8_WAIT_V(6); PG8_BAR; PG8_MMA(1, 1, At, B1); PG8_BAR;
            PG8_LDB(B0, 1, 0); PG8_SCHED; PG8_LDA(At, 1, 0); PG8_STAGE(PG8_SA(0, 1), a2 + hstepA, voffA);
            PG8_WAIT_L(8); PG8_BAR; PG8_WAIT_L(0); PG8_MMA(0, 0, At, B0); PG8_BAR; PG8_SCHED;
            PG8_LDB(B1, 1, 1); PG8_STAGE(PG8_SB(1, 0), b3, voffB);
            PG8_BAR; PG8_WAIT_L(0); PG8_MMA(0, 1, At, B1); PG8_BAR;
            PG8_LDA(At, 1, 1); PG8_STAGE(PG8_SA(1, 0), a3, voffA);
            PG8_BAR; PG8_WAIT_L(0); PG8_MMA(1, 0, At, B0); PG8_BAR; PG8_SCHED;
            PG8_STAGE(PG8_SB(1, 1), b3 + hstepB, voffB);
            PG8_WAIT_V(6); PG8_BAR; PG8_MMA(1, 1, At, B1); PG8_BAR;
            }
        }
        if constexpr (ALIGN_EPI) { if (wr == 0) PG8_BAR; }
        if constexpr (!Epi::AFTER_DRAIN) { E(acc, cur, wr, wc, fr, fq); S.done(cur); }
        if (!has_next) break;
#pragma unroll
        for (int a = 0; a < 2; ++a)
#pragma unroll
            for (int b = 0; b < 2; ++b)
#pragma unroll
                for (int m = 0; m < 4; ++m)
#pragma unroll
                    for (int n = 0; n < 2; ++n) acc[a][b][m][n] = (f32x4){0.f, 0.f, 0.f, 0.f};
        cur = nxt; cA = nA; cB = nB; ++ui;
        if constexpr (ALIGN_EPI) { if (wr == 1) PG8_BAR; }
    }
    PG8_WAIT_V(0);
    if constexpr (!ALIGN_EPI) { if (wr == 0) PG8_BAR; }
    PG8_BAR;
    if constexpr (Epi::AFTER_DRAIN) { E.fused(acc, cur, wr, wc, fr, fq, lds, wid, lane); S.done(cur); }
#undef PG8_SA
#undef PG8_SB
#undef PG8_STAGE
#undef PG8_LDA
#undef PG8_LDB
#undef PG8_MMA
#undef PG8_WAIT_V
#undef PG8_WAIT_L
#undef PG8_BAR
#undef PG8_SCHED
}
}

#ifndef PH_MASK
#define PH_MASK 0x3ff
#endif
#ifndef STAG_TICKS
#define STAG_TICKS 800
#endif
#ifndef DUP_MASK
#define DUP_MASK 0
#endif

constexpr int NB = 32, SEQ = 2048, DM = 1024, T = NB * SEQ, MEMT = 256, TM = NB * MEMT, FF = 4096;
constexpr int NIN = 3072;
constexpr int KOUT = 1024;
constexpr int W_IN_COLS = 3048;
constexpr float EPS = 1e-6f, LOG2E = 1.4426950408889634f;
constexpr float SCALE_A = 0.10206207261596577f * LOG2E;
constexpr float SCALE_B = 0.125f * LOG2E;
constexpr float SCALE_C = 0.0625f * LOG2E;
constexpr float IDX_W = 0.044194173824159216f;
constexpr int NWAVES = 8;
constexpr float RESCALE_THR = 8.0f;

constexpr size_t MiB = 1u << 20;
constexpr size_t WS_CTL = 0, WS_TAB64 = 1 * MiB, WS_TAB32 = 1 * MiB + 512 * 1024, WS_RSTD1 = 2 * MiB, WS_RSTDM = 2 * MiB + 512 * 1024;
constexpr size_t WS_WUKF = 3 * MiB, WS_WUVF = 3 * MiB + 256 * 1024;
constexpr size_t WS_P1 = 4 * MiB, WS_P2 = 8 * MiB, WS_P3 = 12 * MiB;
constexpr size_t WS_WIN = 16 * MiB, WS_WOUT = 24 * MiB, WS_WQ = 28 * MiB, WS_WKV = 30 * MiB, WS_WO = 34 * MiB, WS_WUP = 36 * MiB, WS_WDN = 44 * MiB;
constexpr size_t WS_XB = 52 * MiB, WS_MEMB = 180 * MiB, WS_KVC = 196 * MiB, WS_MASK = 228 * MiB, WS_HX = 244 * MiB;
constexpr size_t WS_QL = 436 * MiB, WS_QR = 564 * MiB, WS_CKVF = 596 * MiB, WS_CKV = 628 * MiB, WS_KR = 644 * MiB, WS_KI = 648 * MiB, WS_WI = 656 * MiB, WS_QI = 658 * MiB;
constexpr size_t WS_QB = 722 * MiB, WS_KB = 786 * MiB, WS_VB = 850 * MiB;
constexpr size_t WS_ML = 4 * MiB  , WS_PB = 372 * MiB  , WS_SC = 948 * MiB  ;
constexpr size_t WS_QC = 436 * MiB, WS_MT = 692 * MiB  , WS_HID = 436 * MiB, WS_END = 1012 * MiB;

constexpr int LDS_TP = 131072 + 9216;
constexpr int LDS_BYTES = LDS_TP + 16384;

#define GAS __attribute__((address_space(1)))
#define LAS __attribute__((address_space(3)))
typedef unsigned short bf16;
typedef unsigned v4u __attribute__((ext_vector_type(4)));
typedef unsigned v2u __attribute__((ext_vector_type(2)));
typedef float f32x4 __attribute__((ext_vector_type(4)));
typedef float f32x2 __attribute__((ext_vector_type(2)));
#define LDS_WAIT() asm volatile("s_waitcnt lgkmcnt(0)" ::: "memory")

__device__ __forceinline__ unsigned f2bf(float f) { unsigned u = __builtin_bit_cast(unsigned, f); return (u + 0x7fffu + ((u >> 16) & 1u)) >> 16; }
__device__ __forceinline__ unsigned pk2(float lo, float hi) { return f2bf(lo) | (f2bf(hi) << 16); }
__device__ __forceinline__ float bflo(unsigned w) { return __uint_as_float(w << 16); }
__device__ __forceinline__ float bfhi(unsigned w) { return __uint_as_float(w & 0xffff0000u); }
__device__ __forceinline__ float wave_sum(float v) {
#pragma unroll
    for (int o = 1; o < 64; o <<= 1) v += __shfl_xor(v, o);
    return v;
}
__device__ __forceinline__ float wave_max(float v) {
#pragma unroll
    for (int o = 1; o < 64; o <<= 1) v = fmaxf(v, __shfl_xor(v, o));
    return v;
}

struct Frame {
    LAS unsigned char* lds;
    int tid, lane, wave, G, gw, NGW;
    int wave_s;
    const __attribute__((address_space(4))) char* kargs;
    float* out;
    unsigned char* ws;
    size_t z;
};
__device__ __forceinline__ const float* inp(const Frame& F, int i) {
    const __attribute__((address_space(4))) char* p = F.kargs; asm volatile("" : "+s"(p));
    const float* r_ = *(const float* const __attribute__((address_space(4)))*)(p + 8 * i);
    return (const float*)(const __attribute__((address_space(1))) float*)r_;
}
#define LAUNDER_G(p) asm volatile("" : "+s"(p))
template <class TT> __device__ __forceinline__ TT* wsp(const Frame& F, size_t off) { return (TT*)(F.ws + F.z + off); }
__device__ __forceinline__ float* outp(const Frame& F) { return (float*)((unsigned char*)F.out + F.z); }
__device__ __forceinline__ void phase_ctx(Frame& F) {
    size_t z = 0; asm volatile("" : "+s"(z)); F.z = z;
    int ws_ = F.wave_s; asm volatile("" : "+s"(ws_));
    unsigned ones_ = ~0u; asm volatile("" : "+s"(ones_));
    const int lane_ = (int)__builtin_amdgcn_mbcnt_hi(ones_, __builtin_amdgcn_mbcnt_lo(ones_, 0u));
    F.tid = ws_ * 64 + lane_; F.lane = lane_; F.wave = ws_; F.G = gridDim.x; F.gw = blockIdx.x * NWAVES + F.wave; F.NGW = F.G * NWAVES;
}

__device__ __forceinline__ float rstd_from_parts(const float* part, int row) {
    const f32x4* p = (const f32x4*)(part + (size_t)row * 16);
    const f32x4 a = p[0], b = p[1], c = p[2], d = p[3];
    const float s = ((a[0] + a[1]) + (a[2] + a[3])) + ((b[0] + b[1]) + (b[2] + b[3])) + ((c[0] + c[1]) + (c[2] + c[3])) + ((d[0] + d[1]) + (d[2] + d[3]));
    return 1.0f / sqrtf(s * (1.0f / DM) + EPS);
}
__device__ __forceinline__ f32x4 rope4(f32x4 v, f32x4 cs) { return (f32x4){v[0] * cs[0] - v[1] * cs[1], v[1] * cs[0] + v[0] * cs[1], v[2] * cs[2] - v[3] * cs[3], v[3] * cs[2] + v[2] * cs[3]}; }
typedef float f32x2_e __attribute__((ext_vector_type(2)));
typedef __bf16 bf16x2_e __attribute__((ext_vector_type(2)));
__device__ __forceinline__ unsigned cvtpk_e(float lo, float hi) { f32x2_e v = {lo, hi}; bf16x2_e b = __builtin_convertvector(v, bf16x2_e); return __builtin_bit_cast(unsigned, b); }
__device__ __forceinline__ v4u pack8(f32x4 a, f32x4 b) { v4u w; w.x = cvtpk_e(a[0], a[1]); w.y = cvtpk_e(a[2], a[3]); w.z = cvtpk_e(b[0], b[1]); w.w = cvtpk_e(b[2], b[3]); return w; }

struct TrStore {
    LAS unsigned char* tp; unsigned wo, ro, rf[2]; int rr, pp, r8, P8;
    __device__ __forceinline__ void init(LAS unsigned char* tp_, int fr, int fq) {
        tp = tp_; const int ln = fq * 16 + fr; rr = ln >> 2; pp = ln & 3;
        const unsigned zw = ((fr >> 1) & 3) | ((fr & 1) << 2), zr = ((rr >> 1) & 3) | ((rr & 1) << 2);
        wo = fr * 128 + ((fq ^ zw) << 4); ro = rr * 128 + ((pp ^ zr) << 4);
        r8 = ln >> 3; P8 = ln & 7;
#pragma unroll
        for (int s = 0; s < 2; ++s) { const int r = 8 * s + r8; const unsigned z = ((r >> 1) & 3) | ((r & 1) << 2); rf[s] = r * 128 + ((P8 ^ z) << 4); }
    }
    __device__ __forceinline__ void xpose_rows(const v4u w0, const v4u w1, v4u& t0, v4u& t1) const {
        *(LAS v4u*)(tp + wo) = w0; *(LAS v4u*)(tp + (wo ^ 64u)) = w1;
        t0 = *(const LAS v4u*)(tp + rf[0]); t1 = *(const LAS v4u*)(tp + rf[1]);
    }
    __device__ __forceinline__ void xpose(const v4u w0, const v4u w1, v4u& t0, v4u& t1) const {
        *(LAS v4u*)(tp + wo) = w0; *(LAS v4u*)(tp + (wo ^ 64u)) = w1;
        t0 = *(const LAS v4u*)(tp + ro); t1 = *(const LAS v4u*)(tp + (ro ^ 64u));
    }
};
struct EpiInProj {
    static constexpr bool PERM = true, ADJ = false, AFTER_DRAIN = false;
    unsigned char* wsb;
    __device__ __forceinline__ void operator()(const pg8::f32x4 (&acc)[2][2][4][2], const pg8::Unit& u, int wr, int wc, int fr_in, int fq_in) const {
        int fr = fr_in, fq = fq_in; asm volatile("" : "+v"(fr), "+v"(fq));
        const float* rstd = (const float*)(wsb + WS_RSTD1); const float* tab64 = (const float*)(wsb + WS_TAB64); const float* tab32 = (const float*)(wsb + WS_TAB32);
        bf16 *QL = (bf16*)(wsb + WS_QL), *QR = (bf16*)(wsb + WS_QR), *KR = (bf16*)(wsb + WS_KR), *KI = (bf16*)(wsb + WS_KI), *QI = (bf16*)(wsb + WS_QI), *QB = (bf16*)(wsb + WS_QB), *KB = (bf16*)(wsb + WS_KB), *VB = (bf16*)(wsb + WS_VB);
        float *CKVF = (float*)(wsb + WS_CKVF), *WI = (float*)(wsb + WS_WI);
        const int pn = u.pn;
        float rsv[8];
#pragma unroll
        for (int i = 0; i < 8; ++i) rsv[i] = rstd[u.pm * 256 + (i >> 2) * 128 + wr * 64 + (i & 3) * 16 + fr];
        const bool r32 = (pn == 2) || (pn == 3 && wc == 0), r64 = (pn >= 4 && pn < 10) || (pn == 3 && (wc == 1 || wc == 2));
        const int tb64 = ((pn == 3) ? 16 * (wc - 1) : 16 * (wc & 1)) + 4 * fq;
        f32x4 c0n = (f32x4){0.f, 0.f, 0.f, 0.f}, c1n = c0n;
#define INPROJ_TAB(s_) do { if (r32 || r64) { const int pos_ = (u.pm * 256 + ((s_) >> 2) * 128 + wr * 64 + ((s_) & 3) * 16 + fr) & (SEQ - 1); \
                    const float* tp = r32 ? tab32 + ((size_t)pos_ * 16 + 4 * fq) * 2 : tab64 + ((size_t)pos_ * 32 + tb64) * 2; \
                    c0n = *(const f32x4*)tp; c1n = *(const f32x4*)(tp + 4); } } while (0)
        INPROJ_TAB(0);
#pragma unroll
        for (int ah = 0; ah < 8; ++ah) {
            const int ai = ah >> 2;
            const f32x4 cs0 = c0n, cs1 = c1n;
            if (ah + 1 < 8) INPROJ_TAB(ah + 1);
            {
                const int m = ah & 3;
                const int row = u.pm * 256 + ai * 128 + wr * 64 + m * 16 + fr;
                const float rs = rsv[ai * 4 + m];
                if (pn < 2) {
#pragma unroll
                    for (int bj = 0; bj < 2; ++bj) { const f32x4 a = acc[ai][bj][m][0] * (rs * SCALE_A), b = acc[ai][bj][m][1] * (rs * SCALE_A);
                        __builtin_nontemporal_store(pack8(a, b), (v4u*)(QL + (size_t)row * 512 + pn * 256 + bj * 128 + wc * 32 + 8 * fq)); }
                } else if (pn == 2) {
#pragma unroll
                    for (int bj = 0; bj < 2; ++bj) { const f32x4 a = rope4(acc[ai][bj][m][0] * (rs * SCALE_A), cs0), b = rope4(acc[ai][bj][m][1] * (rs * SCALE_A), cs1);
                        __builtin_nontemporal_store(pack8(a, b), (v4u*)(QR + (size_t)row * 256 + bj * 128 + wc * 32 + 8 * fq)); }
                } else if (pn == 3) {
                    { const f32x4 a = acc[ai][0][m][0] * rs, b = acc[ai][0][m][1] * rs; float* o = CKVF + (size_t)row * 128 + wc * 32 + 8 * fq; __builtin_nontemporal_store(a, (f32x4*)o); __builtin_nontemporal_store(b, (f32x4*)(o + 4)); }
                    if (wc == 0) {
                        const f32x4 a = rope4(acc[ai][1][m][0] * rs, cs0), b = rope4(acc[ai][1][m][1] * rs, cs1);
                        __builtin_nontemporal_store(pack8(a, b), (v4u*)(KR + (size_t)row * 32 + 8 * fq));
                    } else if (wc < 3) {
                        const f32x4 a = rope4(acc[ai][1][m][0] * rs, cs0), b = rope4(acc[ai][1][m][1] * rs, cs1);
                        __builtin_nontemporal_store(pack8(a, b), (v4u*)(KI + (size_t)row * 64 + 32 * (wc - 1) + 8 * fq));
                    } else if (fq == 0) {
                        const f32x4 a = acc[ai][1][m][0] * (rs * IDX_W), b = acc[ai][1][m][1] * (rs * IDX_W); float* o = WI + (size_t)row * 8; __builtin_nontemporal_store(a, (f32x4*)o); __builtin_nontemporal_store(b, (f32x4*)(o + 4));
                    }
                } else if (pn < 10) {
                    const float sc = (pn == 6 || pn == 7) ? rs * SCALE_B : rs;
                    const size_t eoff = (size_t)row * 512 + (pn & 1) * 256 + wc * 32 + 8 * fq;
#pragma unroll
                    for (int bj = 0; bj < 2; ++bj) { const f32x4 a = rope4(acc[ai][bj][m][0] * sc, cs0), b = rope4(acc[ai][bj][m][1] * sc, cs1); const v4u w = pack8(a, b);
                        if (pn < 6) __builtin_nontemporal_store(w, (v4u*)(QI + eoff + bj * 128)); else if (pn < 8) __builtin_nontemporal_store(w, (v4u*)(QB + eoff + bj * 128)); else __builtin_nontemporal_store(w, (v4u*)(KB + eoff + bj * 128)); }
                } else {
#pragma unroll
                    for (int bj = 0; bj < 2; ++bj) { const f32x4 a = acc[ai][bj][m][0] * rs, b = acc[ai][bj][m][1] * rs;
                        __builtin_nontemporal_store(pack8(a, b), (v4u*)(VB + (size_t)row * 512 + (pn & 1) * 256 + bj * 128 + wc * 32 + 8 * fq)); }
                }
            }
        }
    }
};
template <int ACT  > struct EpiRowScale {
    static constexpr bool PERM = true, ADJ = true, AFTER_DRAIN = false;
    bf16* O; int ldc; const float* rstd_direct; const float* parts; float cs; LAS unsigned char* tp;
    __device__ __forceinline__ void operator()(const pg8::f32x4 (&acc)[2][2][4][2], const pg8::Unit& u, int wr, int wc, int fr, int fq) const {
        TrStore X; X.init(tp, fr, fq);
        float rs[8];
        if (ACT == 2) {
#pragma unroll
            for (int i = 0; i < 8; ++i) rs[i] = 1.0f;
        } else if (parts) {
            f32x4 pv[8];
#pragma unroll
            for (int i = 0; i < 8; ++i) { const int row = u.pm * 256 + (i >> 2) * 128 + wr * 64 + (i & 3) * 16 + fr; pv[i] = *(const f32x4*)(parts + (size_t)row * 16 + 4 * fq); }
#pragma unroll
            for (int i = 0; i < 8; ++i) { float t = (pv[i][0] + pv[i][1]) + (pv[i][2] + pv[i][3]); t += __shfl_xor(t, 16); t += __shfl_xor(t, 32); rs[i] = cs / sqrtf(t * (1.0f / DM) + EPS); }
        } else {
#pragma unroll
            for (int i = 0; i < 8; ++i) { const int row = u.pm * 256 + (i >> 2) * 128 + wr * 64 + (i & 3) * 16 + fr; rs[i] = rstd_direct[row]; }
#pragma unroll
            for (int i = 0; i < 8; ++i) rs[i] *= cs;
        }
        v4u tq[2]; size_t oq = 0;
#pragma unroll
        for (int s = 0; s < 8; ++s) { const int ai = s >> 2, m = s & 3;
            const float r_ = rs[s];
            v4u w[2];
#pragma unroll
            for (int bj = 0; bj < 2; ++bj) { f32x4 a = acc[ai][bj][m][0] * r_, b = acc[ai][bj][m][1] * r_;
                if (ACT == 1) {
#pragma unroll
                    for (int e = 0; e < 4; ++e) { const float x = fmaxf(a[e], 0.f), y = fmaxf(b[e], 0.f); a[e] = x * x; b[e] = y * y; } }
                w[bj] = pack8(a, b); }
            if (s > 0) {
#pragma unroll
                for (int bj = 0; bj < 2; ++bj) { v4u* dst_ = (v4u*)(O + oq + (size_t)(8 * bj) * ldc); __builtin_nontemporal_store(tq[bj], dst_); } }
            X.xpose_rows(w[0], w[1], tq[0], tq[1]);
            oq = (size_t)(u.pm * 256 + ai * 128 + wr * 64 + m * 16 + X.r8) * ldc + u.pn * 256 + wc * 64 + 8 * X.P8;
        }
#pragma unroll
        for (int bj = 0; bj < 2; ++bj) { v4u* dst_ = (v4u*)(O + oq + (size_t)(8 * bj) * ldc); __builtin_nontemporal_store(tq[bj], dst_); }
    }
};
struct EpiResid {
    static constexpr bool PERM = true, ADJ = true, AFTER_DRAIN = false;
    bf16* XBio; float* parts;
    __device__ __forceinline__ void operator()(const pg8::f32x4 (&acc)[2][2][4][2], const pg8::Unit& u, int wr, int wc, int fr, int fq) const {
#pragma unroll
        for (int ai = 0; ai < 2; ++ai) {
            v4u rw[2][4][2];
#pragma unroll
            for (int m = 0; m < 4; ++m)
#pragma unroll
                for (int bj = 0; bj < 2; ++bj) rw[ai][m][bj] = *(const v4u*)(XBio + (size_t)(u.pm * 256 + ai * 128 + wr * 64 + m * 16 + fr) * DM + u.pn * 256 + wc * 64 + bj * 32 + 8 * fq);
#pragma unroll
            for (int m = 0; m < 4; ++m) {
                const int row = u.pm * 256 + ai * 128 + wr * 64 + m * 16 + fr;
                float ss = 0.f;
#pragma unroll
                for (int bj = 0; bj < 2; ++bj) { const size_t off = (size_t)row * DM + u.pn * 256 + wc * 64 + bj * 32 + 8 * fq; const v4u r_ = rw[ai][m][bj];
                    const f32x4 a = (f32x4){bflo(r_.x), bfhi(r_.x), bflo(r_.y), bfhi(r_.y)} + acc[ai][bj][m][0], b = (f32x4){bflo(r_.z), bfhi(r_.z), bflo(r_.w), bfhi(r_.w)} + acc[ai][bj][m][1];
                    __builtin_nontemporal_store(pack8(a, b), (v4u*)(XBio + off));
                    ss += (a[0] * a[0] + a[1] * a[1]) + (a[2] * a[2] + a[3] * a[3]) + (b[0] * b[0] + b[1] * b[1]) + (b[2] * b[2] + b[3] * b[3]); }
                ss += __shfl_xor(ss, 16); ss += __shfl_xor(ss, 32);
                if (fq == 0) parts[(size_t)row * 16 + u.pn * 4 + wc] = ss;
            }
        }
    }
};

struct PreOrderA {
    int c; const char* kv; const char* wqn;
    __device__ __forceinline__ bool next(int i, pg8::Unit& u) const {
        if (i >= 2) return false;
        const int L = (c & 7) * 64 + i * 32 + (c >> 3), b = L >> 4, h = (L >> 2) & 3, pn = L & 3;
        u.pm = b * 4 + h; u.pn = pn; u.pa = kv + ((size_t)(b * 256) * 2048 + h * 256) * 2; u.pb = wqn + ((size_t)pn * 256 * DM + h * 256) * 2; return true;
    }
    __device__ __forceinline__ void a_ready(const pg8::Unit&) const {}
    __device__ __forceinline__ void done(const pg8::Unit&) const {}
};
struct PreOrderB {
    int c; const char* kv; const char* wo;
    __device__ __forceinline__ bool next(int i, pg8::Unit& u) const {
        if (i >= 2) return false;
        const int L = (c & 7) * 64 + i * 32 + (c >> 3), b = L >> 4, h = (L >> 2) & 3, pmo = L & 3;
        u.pm = 128 + b * 4 + pmo; u.pn = h; u.pa = wo + ((size_t)pmo * 256 * DM + h * 256) * 2; u.pb = kv + ((size_t)(b * 256) * 2048 + 1024 + h * 256) * 2; return true;
    }
    __device__ __forceinline__ void a_ready(const pg8::Unit&) const {}
    __device__ __forceinline__ void done(const pg8::Unit&) const {}
};
struct BatchOrder {
    pg8::StaticOrder so; size_t bstride;
    __device__ __forceinline__ bool next(int i, pg8::Unit& u) const { if (!so.next(i, u)) return false; u.pb += (size_t)(u.pm >> 3) * bstride; return true; }
    __device__ __forceinline__ void a_ready(const pg8::Unit&) const {}
    __device__ __forceinline__ void done(const pg8::Unit&) const {}
};
struct EpiSoftmaxP {
    static constexpr bool PERM = true, ADJ = true, AFTER_DRAIN = false;
    bf16* P; LAS float* xch; const float* parts;
    __device__ __forceinline__ void operator()(const pg8::f32x4 (&acc_)[2][2][4][2], const pg8::Unit& u, int wr, int wc, int fr, int fq) const {
        pg8::f32x4 (&acc)[2][2][4][2] = const_cast<pg8::f32x4 (&)[2][2][4][2]>(acc_);
        LAS float* xb = xch + (wr * 64 + fr) * 8; asm volatile("" : "+v"(xb));
        float rs[8];
        { f32x4 pv[8];
#pragma unroll
          for (int i = 0; i < 8; ++i) { const int row = u.pm * 256 + (i >> 2) * 128 + wr * 64 + (i & 3) * 16 + fr; pv[i] = *(const f32x4*)(parts + (size_t)row * 16 + 4 * fq); }
#pragma unroll
          for (int i = 0; i < 8; ++i) { float t = (pv[i][0] + pv[i][1]) + (pv[i][2] + pv[i][3]); t += __shfl_xor(t, 16); t += __shfl_xor(t, 32); rs[i] = 1.0f / sqrtf(t * (1.0f / DM) + EPS); } }
#pragma unroll
        for (int ai = 0; ai < 2; ++ai)
#pragma unroll
            for (int m = 0; m < 4; ++m) {
                float v = -INFINITY; const float r_ = rs[ai * 4 + m];
#pragma unroll
                for (int bj = 0; bj < 2; ++bj)
#pragma unroll
                    for (int n = 0; n < 2; ++n) { const f32x4 x = acc[ai][bj][m][n]; v = fmaxf(v, fmaxf(fmaxf(x[0], x[1]), fmaxf(x[2], x[3]))); }
                v = fmaxf(v, __shfl_xor(v, 16)); v = fmaxf(v, __shfl_xor(v, 32));
                v *= r_;
                float s = 0.f;
#pragma unroll
                for (int bj = 0; bj < 2; ++bj)
#pragma unroll
                    for (int n = 0; n < 2; ++n) { f32x4 x = acc[ai][bj][m][n];
#pragma unroll
                        for (int e = 0; e < 4; ++e) { x[e] = __builtin_amdgcn_exp2f(fmaf(x[e], r_, -v)); s += x[e]; }
                        acc[ai][bj][m][n] = x; }
                s += __shfl_xor(s, 16); s += __shfl_xor(s, 32);
                if (fq == 0) *(LAS f32x2*)(xb + (ai * 128 + m * 16) * 8 + wc * 2) = (f32x2){v, s};
            }
        asm volatile("s_waitcnt lgkmcnt(0)" ::: "memory"); __builtin_amdgcn_s_barrier(); asm volatile("" ::: "memory");
#pragma unroll
        for (int ai = 0; ai < 2; ++ai)
#pragma unroll
            for (int m = 0; m < 4; ++m) {
                const int rl = ai * 128 + wr * 64 + m * 16 + fr, row = u.pm * 256 + rl;
                const f32x4 a = *(const LAS f32x4*)(xb + (ai * 128 + m * 16) * 8), b = *(const LAS f32x4*)(xb + (ai * 128 + m * 16) * 8 + 4);
                const float M = fmaxf(fmaxf(a[0], a[2]), fmaxf(b[0], b[2]));
                const float L = a[1] * __builtin_amdgcn_exp2f(a[0] - M) + a[3] * __builtin_amdgcn_exp2f(a[2] - M) + b[1] * __builtin_amdgcn_exp2f(b[0] - M) + b[3] * __builtin_amdgcn_exp2f(b[2] - M);
                const float mown = (wc == 0) ? a[0] : (wc == 1) ? a[2] : (wc == 2) ? b[0] : b[2];
                const float sc = __builtin_amdgcn_exp2f(mown - M) / L;
#pragma unroll
                for (int bj = 0; bj < 2; ++bj) __builtin_nontemporal_store(pack8(acc[ai][bj][m][0] * sc, acc[ai][bj][m][1] * sc), (v4u*)(P + (size_t)row * DM + u.pn * 256 + wc * 64 + bj * 32 + 8 * fq));
                __builtin_amdgcn_sched_barrier(0);
            }
        asm volatile("s_waitcnt lgkmcnt(0)" ::: "memory"); __builtin_amdgcn_s_barrier(); asm volatile("" ::: "memory");
    }
};

struct RowOwner {
    int pm, nN; const char* A; const char* B; size_t ta, tb;
    __device__ __forceinline__ void init(const pg8::Gemm& g, int pm_) { pm = pm_; nN = g.N / 256; A = (const char*)g.A; B = (const char*)g.Bt; ta = (size_t)256 * g.lda * 2; tb = (size_t)256 * g.ldb * 2; }
    __device__ __forceinline__ bool next(int i, pg8::Unit& u) const { if (i >= nN) return false; u.pm = pm; u.pn = i; u.pa = A + (size_t)pm * ta; u.pb = B + (size_t)i * tb; return true; }
    __device__ __forceinline__ void a_ready(const pg8::Unit&) const {}
    __device__ __forceinline__ void done(const pg8::Unit&) const {}
};
struct CrossOwner {
    int pm; const char* A; const char* B; size_t bstride, hstride;
    __device__ __forceinline__ bool next(int i, pg8::Unit& u) const {
        if (i >= 4) return false;
        u.pm = pm; u.pn = i; u.pa = A + ((size_t)pm * 256 * DM + i * 256) * 2; u.pb = B + (size_t)(pm >> 3) * bstride + (size_t)i * hstride; return true;
    }
    __device__ __forceinline__ void a_ready(const pg8::Unit&) const {}
    __device__ __forceinline__ void done(const pg8::Unit&) const {}
};

template <class Map>
__device__ __forceinline__ void transpose_item(const float* W, int srcN, const float* g, bf16* WT, int ldk, int koff, LAS float* scr, int k0, int n0, int lane, const Map& map) {
    const int sc = map(n0 + (lane & 31));
#pragma unroll 8
    for (int i = 0; i < 32; ++i) { const int kk = 2 * i + (lane >> 5); float v = (sc >= 0) ? W[(size_t)(k0 + kk) * srcN + sc] : 0.f; if (g) v *= g[k0 + kk]; scr[kk * 33 + (lane & 31)] = v; }
    LDS_WAIT(); asm volatile("" ::: "memory");
    const int c = lane & 7;
#pragma unroll
    for (int j = 0; j < 4; ++j) { const int n = (lane >> 3) + 8 * j; const LAS float* s = scr + (8 * c) * 33 + n;
        v4u o; o.x = pk2(s[0 * 33], s[1 * 33]); o.y = pk2(s[2 * 33], s[3 * 33]); o.z = pk2(s[4 * 33], s[5 * 33]); o.w = pk2(s[6 * 33], s[7 * 33]);
        *(v4u*)(WT + (size_t)(n0 + n) * ldk + koff + k0 + 8 * c) = o; }
    LDS_WAIT(); asm volatile("" ::: "memory");
}
struct MapId { __device__ __forceinline__ int operator()(int n) const { return n; } };
__device__ __forceinline__ void transpose_item_v4(const float* W, int srcN, const float* g, bf16* WT, int ldk, int koff, LAS float* scr, int k0, int n0, int lane) {
    f32x4 v[8];
#pragma unroll
    for (int i = 0; i < 8; ++i) v[i] = *(const f32x4*)(W + (size_t)(k0 + 8 * i + (lane >> 3)) * srcN + n0 + (lane & 7) * 4);
#pragma unroll
    for (int i = 0; i < 8; ++i) { const int kk = 8 * i + (lane >> 3); f32x4 x = v[i]; if (g) x = x * g[k0 + kk];
        LAS float* d = scr + kk * 33 + (lane & 7) * 4; d[0] = x[0]; d[1] = x[1]; d[2] = x[2]; d[3] = x[3]; }
    LDS_WAIT(); asm volatile("" ::: "memory");
    const int c = lane & 7;
#pragma unroll
    for (int j = 0; j < 4; ++j) { const int n = (lane >> 3) + 8 * j; const LAS float* s_ = scr + (8 * c) * 33 + n;
        v4u o; o.x = pk2(s_[0 * 33], s_[1 * 33]); o.y = pk2(s_[2 * 33], s_[3 * 33]); o.z = pk2(s_[4 * 33], s_[5 * 33]); o.w = pk2(s_[6 * 33], s_[7 * 33]);
        *(v4u*)(WT + (size_t)(n0 + n) * ldk + koff + k0 + 8 * c) = o; }
    LDS_WAIT(); asm volatile("" ::: "memory");
}

__device__ __forceinline__ int il64(int p) { return (p >> 1) + 32 * (p & 1); }
__device__ __forceinline__ int il32(int p) { return (p >> 1) + 16 * (p & 1); }
struct MapIn {
    __device__ __forceinline__ int operator()(int nn) const {
        if (nn < 512) return nn;
        int n = nn - 512;
        if (n < 256) return 512 + (n >> 5) * 32 + il32(n & 31);
        n -= 256;
        if (n < 256) { if (n < 128) return 768 + n; if (n < 160) return 896 + il32(n - 128); if (n < 224) return 1440 + il64(n - 160); if (n < 232) return 1504 + (n - 224); return -1; }
        n -= 256;
        if (n < 512) return 928 + (n >> 6) * 64 + il64(n & 63);
        n -= 512;
        if (n < 512) return 1512 + (n >> 6) * 64 + il64(n & 63);
        n -= 512;
        if (n < 512) return 2024 + (n >> 6) * 64 + il64(n & 63);
        n -= 512;
        return 2536 + n;
    }
};

__device__ __forceinline__ void p0_prologue(Frame& F) {
    LAS float* scr = (LAS float*)(F.lds + F.wave * 16384);
    const int gw = F.gw, NGW = F.NGW, lane = F.lane;
    const float *x = inp(F, 0), *mem = inp(F, 1), *g_mix = inp(F, 2), *w_in = inp(F, 3), *w_uk = inp(F, 5), *w_uv = inp(F, 6), *w_out = inp(F, 7), *g_cross = inp(F, 8), *g_mem = inp(F, 9);
    const float *w_q = inp(F, 10), *w_kv = inp(F, 11), *w_o = inp(F, 12), *g_mlp = inp(F, 13), *w_up = inp(F, 14), *w_dn = inp(F, 15);
    bf16 *WIN = wsp<bf16>(F, WS_WIN), *WOUT = wsp<bf16>(F, WS_WOUT), *WQ = wsp<bf16>(F, WS_WQ), *WKV = wsp<bf16>(F, WS_WKV), *WO = wsp<bf16>(F, WS_WO), *WUP = wsp<bf16>(F, WS_WUP), *WDN = wsp<bf16>(F, WS_WDN);
    constexpr int I_IN = 16 * (3072 / 32), I_OUT2 = 16 * 32, I_Q = 16 * 32, I_KV = 16 * 64, I_O = 16 * 32, I_UP = 16 * 128, I_DN = 64 * 32;
    constexpr int NIT = I_IN + I_OUT2 + I_Q + I_KV + I_O + I_UP + I_DN;
    for (int it = gw; it < NIT; it += NGW) {
        int r = it;
        if (r < I_IN) { const int nb = r % 96, kb = r / 96; transpose_item(w_in, W_IN_COLS, g_mix, WIN, DM, 0, scr, 64 * kb, 32 * nb, lane, MapIn()); continue; } r -= I_IN;
        if (r < I_OUT2) { const int nb = r % 32, kb = r / 32; transpose_item_v4(w_out, DM, nullptr, WOUT, KOUT, 0, scr, 64 * kb, 32 * nb, lane); continue; } r -= I_OUT2;
        if (r < I_Q) {
#pragma unroll
            for (int rr = 0; rr < 2; ++rr) { const int d = 2 * r + rr; const float gs = g_cross[d] * SCALE_C; const f32x4* src = (const f32x4*)(w_q + (size_t)d * DM) + 4 * lane;
                const f32x4 a0 = src[0], a1 = src[1], a2 = src[2], a3 = src[3];
                v4u o0, o1; o0.x = pk2(a0[0] * gs, a0[1] * gs); o0.y = pk2(a0[2] * gs, a0[3] * gs); o0.z = pk2(a1[0] * gs, a1[1] * gs); o0.w = pk2(a1[2] * gs, a1[3] * gs);
                o1.x = pk2(a2[0] * gs, a2[1] * gs); o1.y = pk2(a2[2] * gs, a2[3] * gs); o1.z = pk2(a3[0] * gs, a3[1] * gs); o1.w = pk2(a3[2] * gs, a3[3] * gs);
                v4u* dst = (v4u*)(WQ + (size_t)d * DM) + 2 * lane; dst[0] = o0; dst[1] = o1; }
            continue; } r -= I_Q;
        if (r < I_KV) { const int nb = r % 64, kb = r / 64; transpose_item_v4(w_kv, 2048, g_mem, WKV, DM, 0, scr, 64 * kb, 32 * nb, lane); continue; } r -= I_KV;
        if (r < I_O) { const int nb = r % 32, kb = r / 32; transpose_item_v4(w_o, DM, nullptr, WO, DM, 0, scr, 64 * kb, 32 * nb, lane); continue; } r -= I_O;
        if (r < I_UP) { const int nb = r % 128, kb = r / 128; transpose_item_v4(w_up, FF, g_mlp, WUP, DM, 0, scr, 64 * kb, 32 * nb, lane); continue; } r -= I_UP;
        { const int nb = r % 32, kb = r / 32; transpose_item_v4(w_dn, DM, nullptr, WDN, FF, 0, scr, 64 * kb, 32 * nb, lane); }
    }
    { v4u* WUKF = wsp<v4u>(F, WS_WUKF); v4u* WUVF = wsp<v4u>(F, WS_WUVF);
      for (int e = gw * 64 + lane; e < 2 * 8192; e += NGW * 64) {
          const int ln = e & 63, r32 = ln & 31, hi = ln >> 5; float v[8];
          if (e < 8192) { const int ks = (e >> 6) & 3, ct = (e >> 8) & 3, h = e >> 10;
#pragma unroll
              for (int j = 0; j < 8; ++j) v[j] = w_uk[((size_t)h * 64 + 16 * ks + 8 * hi + j) * 128 + 32 * ct + r32];
              v4u o; o.x = pk2(v[0], v[1]); o.y = pk2(v[2], v[3]); o.z = pk2(v[4], v[5]); o.w = pk2(v[6], v[7]); WUKF[e] = o; }
          else { const int e2 = e - 8192, sx = (e2 >> 6) & 1, dt = (e2 >> 7) & 3, vt = (e2 >> 9) & 1, h = e2 >> 10;
#pragma unroll
              for (int j = 0; j < 8; ++j) v[j] = w_uv[((size_t)h * 128 + 32 * dt + 16 * sx + 8 * hi + j) * 64 + 32 * vt + r32];
              v4u o; o.x = pk2(v[0], v[1]); o.y = pk2(v[2], v[3]); o.z = pk2(v[4], v[5]); o.w = pk2(v[6], v[7]); WUVF[e2] = o; }
      } }
    bf16 *XB = wsp<bf16>(F, WS_XB), *MEMB = wsp<bf16>(F, WS_MEMB); float *R1 = wsp<float>(F, WS_RSTD1), *RM = wsp<float>(F, WS_RSTDM);
    for (int m0 = gw; m0 < T + TM; m0 += 4 * NGW) {
        f32x4 v[4][4]; float ssq[4];
#pragma unroll
        for (int u = 0; u < 4; ++u) { const int m = m0 + u * NGW; const bool ok = m < T + TM; const bool isx = m < T; const int r = isx ? m : m - T;
            const f32x4* xr = (const f32x4*)((isx ? x : mem) + (size_t)(ok ? r : 0) * DM) + lane;
#pragma unroll
            for (int j = 0; j < 4; ++j) v[u][j] = __builtin_nontemporal_load(xr + 64 * j); }
#pragma unroll
        for (int u = 0; u < 4; ++u) { float s = 0.f;
#pragma unroll
            for (int j = 0; j < 4; ++j) s += (v[u][j][0] * v[u][j][0] + v[u][j][1] * v[u][j][1]) + (v[u][j][2] * v[u][j][2] + v[u][j][3] * v[u][j][3]);
            ssq[u] = wave_sum(s); }
#pragma unroll
        for (int u = 0; u < 4; ++u) { const int m = m0 + u * NGW; if (m < T + TM) { const bool isx = m < T; const int r = isx ? m : m - T;
            if (lane == 0) (isx ? R1 : RM)[r] = 1.0f / sqrtf(ssq[u] * (1.0f / DM) + EPS);
            v2u* o8 = (v2u*)((isx ? XB : MEMB) + (size_t)r * DM) + lane;
#pragma unroll
            for (int j = 0; j < 4; ++j) { v2u w; w.x = pk2(v[u][j][0], v[u][j][1]); w.y = pk2(v[u][j][2], v[u][j][3]); o8[64 * j] = w; } } }
    }
    float *T64 = wsp<float>(F, WS_TAB64), *T32 = wsp<float>(F, WS_TAB32);
    for (int e = gw * 64 + lane; e < SEQ * 32; e += NGW * 64) {
        const int pos = e >> 5, t = e & 31;
        const float inv = exp2f(-(float)t * (13.287712379549449f / 32.0f));
        const float ang = (float)pos * inv;
        const double rev = (double)ang * 0.15915494309189535; const float fr = (float)(rev - floor(rev));
        const float c = __builtin_amdgcn_cosf(fr), s = __builtin_amdgcn_sinf(fr);
        T64[2 * e] = c; T64[2 * e + 1] = s;
        if ((t & 1) == 0) { T32[2 * (pos * 16 + (t >> 1))] = c; T32[2 * (pos * 16 + (t >> 1)) + 1] = s; }
    }
}

__device__ __forceinline__ void p2_ckv_norm(Frame& F) {
    const float* CKVF = wsp<float>(F, WS_CKVF); bf16* CKV = wsp<bf16>(F, WS_CKV); const float* g = inp(F, 4);
    const int hl = F.lane & 31, hh = F.lane >> 5, c0_ = 4 * hl;
    const f32x4 gv = *(const f32x4*)(g + c0_);
    const int cpos = (c0_ & ~12) | ((c0_ & 4) << 1) | ((c0_ & 8) >> 1);
    for (int r0 = F.gw * 2 + hh; r0 < T; r0 += 16 * F.NGW) {
        f32x4 v[8]; float ss[8];
#pragma unroll
        for (int u = 0; u < 8; ++u) v[u] = *(const f32x4*)(CKVF + (size_t)(r0 + u * 2 * F.NGW) * 128 + c0_);
#pragma unroll
        for (int u = 0; u < 8; ++u) { float t = (v[u][0] * v[u][0] + v[u][1] * v[u][1]) + (v[u][2] * v[u][2] + v[u][3] * v[u][3]);
#pragma unroll
            for (int o = 1; o < 32; o <<= 1) t += __shfl_xor(t, o);
            ss[u] = t; }
#pragma unroll
        for (int u = 0; u < 8; ++u) { const float rs = 1.0f / sqrtf(ss[u] * (1.0f / 128.0f) + EPS);
            v2u w; w.x = pk2(v[u][0] * rs * gv[0], v[u][1] * rs * gv[1]); w.y = pk2(v[u][2] * rs * gv[2], v[u][3] * rs * gv[3]);
            *(v2u*)(CKV + (size_t)(r0 + u * 2 * F.NGW) * 128 + cpos) = w; }
    }
}
typedef short bf16x8 __attribute__((ext_vector_type(8)));
typedef float f32x16 __attribute__((ext_vector_type(16)));
typedef short v4i16_t __attribute__((ext_vector_type(4)));
typedef float f32x2_t __attribute__((ext_vector_type(2)));
typedef __bf16 bf16x2_t __attribute__((ext_vector_type(2)));
__device__ __forceinline__ unsigned cvtpk(float lo, float hi) { f32x2_t v = {lo, hi}; bf16x2_t b = __builtin_convertvector(v, bf16x2_t); return __builtin_bit_cast(unsigned, b); }
__device__ __forceinline__ int crow(int r, int hi) { return (r & 3) + 8 * (r >> 2) + 4 * hi; }
template <int NCH> __device__ __forceinline__ unsigned off_img(unsigned row, unsigned ch) { return (NCH * 128u) * (row >> 3) + 512u * (ch >> 2) + 64u * (row & 7) + 16u * ((ch & 3) ^ ((row >> 2) & 3)); }
template <int NCH> __device__ __forceinline__ unsigned rowread_addr(unsigned lane, unsigned s) { return off_img<NCH>(lane & 31, 2 * s + (lane >> 5)); }
template <int NCH> __device__ __forceinline__ unsigned trread_addr(unsigned lane, unsigned c, unsigned ks, unsigned t) {
    const unsigned h = lane >> 5, blk = (lane >> 4) & 1, q = (lane & 15) >> 2, p = lane & 3;
    return off_img<NCH>(16 * ks + 8 * t + 4 * h + q, 4 * c + 2 * blk + (p >> 1)) + 8 * (p & 1);
}
__device__ __forceinline__ bf16x8 trfrag(LAS unsigned char* p0, LAS unsigned char* p1) {
    const v4i16_t lo = __builtin_amdgcn_ds_read_tr16_b64_v4i16((LAS v4i16_t*)p0), hi = __builtin_amdgcn_ds_read_tr16_b64_v4i16((LAS v4i16_t*)p1);
    return (bf16x8){lo[0], lo[1], lo[2], lo[3], hi[0], hi[1], hi[2], hi[3]};
}
#define MFMA32(a, b, c) __builtin_amdgcn_mfma_f32_32x32x16_bf16((a), (b), (c), 0, 0, 0)
template <int NDT> __device__ __forceinline__ void softmax_tile(f32x16& S, float& m, float& l, f32x16 (&o)[NDT], bf16x8 (&pf)[2]) {
    float mt = fmaxf(fmaxf(fmaxf(S[0], S[1]), fmaxf(S[2], S[3])), fmaxf(fmaxf(S[4], S[5]), fmaxf(S[6], S[7])));
    mt = fmaxf(mt, fmaxf(fmaxf(fmaxf(S[8], S[9]), fmaxf(S[10], S[11])), fmaxf(fmaxf(S[12], S[13]), fmaxf(S[14], S[15]))));
    mt = fmaxf(mt, __shfl_xor(mt, 32));
    if (__any(mt > m + RESCALE_THR)) {
        const float mn = fmaxf(m, mt), al = __builtin_amdgcn_exp2f(m - mn);
        l *= al; m = mn;
#pragma unroll
        for (int d = 0; d < NDT; ++d) o[d] = o[d] * al;
    }
    float s = 0.f;
#pragma unroll
    for (int r = 0; r < 16; ++r) { S[r] = __builtin_amdgcn_exp2f(S[r] - m); s += S[r]; }
    l += s;
    typedef unsigned u32x4_t __attribute__((ext_vector_type(4)));
    u32x4_t w0, w1;
    w0.x = cvtpk(S[0], S[1]); w0.y = cvtpk(S[2], S[3]); w0.z = cvtpk(S[4], S[5]); w0.w = cvtpk(S[6], S[7]);
    w1.x = cvtpk(S[8], S[9]); w1.y = cvtpk(S[10], S[11]); w1.z = cvtpk(S[12], S[13]); w1.w = cvtpk(S[14], S[15]);
    pf[0] = __builtin_bit_cast(bf16x8, w0); pf[1] = __builtin_bit_cast(bf16x8, w1);
}
__device__ __forceinline__ int unit_batch(int c, int ui) { return 4 * (c & 7) + (ui >> 1); }
__device__ __forceinline__ int unit_qtile(int c, int ui) { const int s = c >> 3; return (ui & 1) ? 63 - s : s; }

__device__ __forceinline__ float fmax3(float a, float b, float c) { float r; asm("v_max3_f32 %0, %1, %2, %3" : "=v"(r) : "v"(a), "v"(b), "v"(c)); return r; }
template <int NDT> __device__ __forceinline__ void softmax_tile_m(f32x16& S, float mt, float& m, float& l, f32x16 (&o)[NDT], bf16x8 (&pf)[2]) {
    if (__any(mt > m + RESCALE_THR)) {
        const float mn = fmaxf(m, mt), al = __builtin_amdgcn_exp2f(m - mn);
        l *= al; m = mn;
#pragma unroll
        for (int d = 0; d < NDT; ++d) o[d] = o[d] * al;
    }
    float s = 0.f;
#pragma unroll
    for (int r = 0; r < 16; ++r) { S[r] = __builtin_amdgcn_exp2f(S[r] - m); s += S[r]; }
    l += s;
    typedef unsigned u32x4_t __attribute__((ext_vector_type(4)));
    u32x4_t w0, w1;
    w0.x = cvtpk(S[0], S[1]); w0.y = cvtpk(S[2], S[3]); w0.z = cvtpk(S[4], S[5]); w0.w = cvtpk(S[6], S[7]);
    w1.x = cvtpk(S[8], S[9]); w1.y = cvtpk(S[10], S[11]); w1.z = cvtpk(S[12], S[13]); w1.w = cvtpk(S[14], S[15]);
    pf[0] = __builtin_bit_cast(bf16x8, w0); pf[1] = __builtin_bit_cast(bf16x8, w1);
}
template <int NDT> __device__ __forceinline__ void softmax_tile_rel(f32x16& S, float mt, const float mb, float& m, float& l, bool& seen, f32x16 (&o)[NDT], bf16x8 (&pf)[2]) {
    if (__any(mb != m)) { const float d = mb - m; mt += d;
#pragma unroll
        for (int r = 0; r < 16; ++r) S[r] += d; }
    const bool fin = mt > -INFINITY;
    if (__any((mt > RESCALE_THR) || (fin && !seen))) {
        const float inc = seen ? fmaxf(mt, 0.f) : (fin ? mt : 0.f), al = seen ? __builtin_amdgcn_exp2f(-inc) : 1.0f;
        seen = seen || fin;
        l *= al; m += inc;
#pragma unroll
        for (int d = 0; d < NDT; ++d) o[d] = o[d] * al;
#pragma unroll
        for (int r = 0; r < 16; ++r) S[r] -= inc;
    }
    float s = 0.f;
#pragma unroll
    for (int r = 0; r < 16; ++r) { S[r] = __builtin_amdgcn_exp2f(S[r]); s += S[r]; }
    l += s;
    typedef unsigned u32x4_t __attribute__((ext_vector_type(4)));
    u32x4_t w0, w1;
    w0.x = cvtpk(S[0], S[1]); w0.y = cvtpk(S[2], S[3]); w0.z = cvtpk(S[4], S[5]); w0.w = cvtpk(S[6], S[7]);
    w1.x = cvtpk(S[8], S[9]); w1.y = cvtpk(S[10], S[11]); w1.z = cvtpk(S[12], S[13]); w1.w = cvtpk(S[14], S[15]);
    pf[0] = __builtin_bit_cast(bf16x8, w0); pf[1] = __builtin_bit_cast(bf16x8, w1);
}
template <int VAR> __device__ __forceinline__ void p3_dsa_mfma5(Frame& F) {
    const bf16 *QL = wsp<bf16>(F, WS_QL), *QR = wsp<bf16>(F, WS_QR), *CKV = wsp<bf16>(F, WS_CKV), *KR = wsp<bf16>(F, WS_KR); const unsigned* MASK = wsp<unsigned>(F, WS_MASK); bf16* HX = wsp<bf16>(F, WS_HX);
    const v4u *WUKF = wsp<v4u>(F, WS_WUKF), *WUVF = wsp<v4u>(F, WS_WUVF);
    typedef unsigned u32x4_t __attribute__((ext_vector_type(4)));
    const int lane = F.lane, q = lane & 31, hi = lane >> 5, h = F.wave, tid = F.tid;
    constexpr int BUFB = 10496;
    const unsigned ra0 = rowread_addr<16>(lane, 0), ra1 = rowread_addr<16>(lane, 1);
    const unsigned ta0 = trread_addr<16>(lane, 0, 0, 0), ta1 = trread_addr<16>(lane, 0, 0, 1);
    const unsigned rra = 8192 + hi * 528 + q * 16;
    const unsigned wcs = off_img<16>(tid >> 4, tid & 15), wrs = 8192 + (tid & 3) * 528 + ((tid >> 2) & 31) * 16;
    const bool rl = tid < 128;
#define DSA_BIAS(Sv, mword, mref) do { const unsigned nm_ = ~((mword) >> (4 * hi)), nmr_ = __float_as_uint(-(mref)); \
        _Pragma("unroll") for (int r = 0; r < 16; ++r) { int e_; asm("v_bfe_i32 %0, %1, %2, 1" : "=v"(e_) : "v"(nm_), "n"((r & 3) + 8 * (r >> 2))); \
            Sv[r] = __uint_as_float(((unsigned)e_ & 0xff800000u) | (~(unsigned)e_ & nmr_)); } } while (0)
#define DSA_QK(Sv, buf, mword, mref) do { bf16x8 kfa_[10]; \
        _Pragma("unroll") for (int ks = 0; ks < 8; ++ks) kfa_[ks] = *(const LAS bf16x8*)((buf) + ((ks & 1) ? ra1 : ra0) + 512 * (ks >> 1)); \
        _Pragma("unroll") for (int ks = 0; ks < 2; ++ks) kfa_[8 + ks] = *(const LAS bf16x8*)((buf) + rra + 1056 * ks); \
        __builtin_amdgcn_sched_barrier(0); \
        DSA_BIAS(Sv, mword, mref); \
        _Pragma("unroll") for (int ks = 0; ks < 10; ++ks) Sv = MFMA32(kfa_[ks], qf[ks], Sv); } while (0)
#define DSA_LD(cv, rv, t) do { const int t_ = ((t) <= j) ? (t) : j; const GAS bf16* ct_ = cbb + (size_t)t_ * 32 * 128; const GAS bf16* rt_ = rbb + (size_t)t_ * 32 * 32; LAUNDER_G(ct_); LAUNDER_G(rt_); cv = *(const GAS v4u*)(ct_ + cbo); rv = *(const GAS v4u*)(rt_ + rbo); } while (0)
#define DSA_TILE(i, cw, rw, cl, rl_) do { \
        const int b1 = (bi == 2) ? 0 : bi + 1, b2 = (b1 == 2) ? 0 : b1 + 1; \
        LAS unsigned char* cur = F.lds + bi * BUFB; \
        DSA_LD(cl, rl_, (i) + 3); \
        const unsigned mw2 = *(const LAS unsigned*)(mimg + 4 * (((i) + 2 <= j) ? (i) + 2 : j)); \
        f32x16 S = Sn; \
        const unsigned mcur = mw >> (4 * hi); \
        float mt = 0.f; \
        if (VAR == 0) { \
        mt = fmax3(fmax3(S[0], S[1], S[2]), fmax3(S[3], S[4], S[5]), fmax3(S[6], S[7], S[8])); \
        mt = fmax3(mt, fmax3(S[9], S[10], S[11]), fmax3(S[12], S[13], fmax3(S[14], S[15], S[15]))); } \
        const float mb = mbn; mbn = m; \
        if (VAR < 3) DSA_QK(Sn, F.lds + b1 * BUFB, mw1, mbn); \
        bf16x8 pf[2]; \
        if (VAR == 0) { \
        { auto rrx = __builtin_amdgcn_permlane32_swap(__float_as_uint(mt), __float_as_uint(mt), false, false); mt = fmax3(__uint_as_float(rrx[0]), __uint_as_float(rrx[1]), mt); } \
        softmax_tile_rel<4>(S, mt, mb, m, l, seen, o, pf); \
        } else { typedef unsigned u32x4_t2 __attribute__((ext_vector_type(4))); u32x4_t2 w0_, w1_; w0_.x = cvtpk(S[0], S[1]); w0_.y = cvtpk(S[2], S[3]); w0_.z = cvtpk(S[4], S[5]); w0_.w = cvtpk(S[6], S[7]); w1_.x = cvtpk(S[8], S[9]); w1_.y = cvtpk(S[10], S[11]); w1_.z = cvtpk(S[12], S[13]); w1_.w = cvtpk(S[14], S[15]); \
            pf[0] = __builtin_bit_cast(bf16x8, w0_); pf[1] = __builtin_bit_cast(bf16x8, w1_); l += S[0] + (float)(mcur & 1u); } \
        if (VAR < 2) { \
        _Pragma("unroll") for (int dt = 0; dt < 4; ++dt) \
            _Pragma("unroll") for (int ks = 0; ks < 2; ++ks) { const bf16x8 vf = trfrag(cur + ta0 + 4096 * ks + 512 * dt, cur + ta1 + 4096 * ks + 512 * dt); o[dt] = MFMA32(vf, pf[ks], o[dt]); } \
        } else { o[0][0] += __builtin_bit_cast(float, pf[0][0] | (pf[1][1] << 16)); } \
        { LAS unsigned char* nx = F.lds + b2 * BUFB; *(LAS v4u*)(nx + wcs) = cw; if (rl) *(LAS v4u*)(nx + wrs) = rw; } \
        mw = mw1; mw1 = mw2; bi = b1; \
        asm volatile("s_waitcnt lgkmcnt(0)" ::: "memory"); __builtin_amdgcn_s_barrier(); asm volatile("" ::: "memory"); } while (0)
    const int qo = q * 512 + 8 * hi, ro = q * 256 + 8 * hi, cbo = 8 * tid, rbo = 8 * (tid & 127);
#define DSA_PRE_Q(u_) do { const int b_ = unit_batch(c, (u_)), j_ = unit_qtile(c, (u_)); const size_t t_ = (size_t)b_ * SEQ + 32 * j_; \
        const GAS bf16* ql_ = (const GAS bf16*)(QL + t_ * 512 + h * 64); LAUNDER_G(ql_); const GAS bf16* qr_ = (const GAS bf16*)(QR + t_ * 256 + h * 32); LAUNDER_G(qr_); \
        _Pragma("unroll") for (int ks = 0; ks < 4; ++ks) pqn[ks] = *(const GAS bf16x8*)(ql_ + qo + 16 * ks); \
        _Pragma("unroll") for (int ks = 0; ks < 2; ++ks) pqr[ks] = *(const GAS bf16x8*)(qr_ + ro + 16 * ks); \
        const GAS unsigned* mr_ = (const GAS unsigned*)(MASK + t_ * 64); LAUNDER_G(mr_); pmq = *(const GAS v4u*)(mr_ + 4 * tid); } while (0)
#define DSA_PRE_T(u_) do { const int b_ = unit_batch(c, (u_)), j_ = unit_qtile(c, (u_)); \
        const GAS bf16* cb_ = (const GAS bf16*)(CKV + (size_t)b_ * SEQ * 128); LAUNDER_G(cb_); const GAS bf16* rb_ = (const GAS bf16*)(KR + (size_t)b_ * SEQ * 32); LAUNDER_G(rb_); \
        const int t1_ = (1 <= j_) ? 1 : j_, t2_ = (2 <= j_) ? 2 : j_; \
        pc0 = *(const GAS v4u*)(cb_ + cbo); pr0 = *(const GAS v4u*)(rb_ + rbo); \
        pc1 = *(const GAS v4u*)(cb_ + (size_t)t1_ * 32 * 128 + cbo); pr1 = *(const GAS v4u*)(rb_ + (size_t)t1_ * 32 * 32 + rbo); \
        cA = *(const GAS v4u*)(cb_ + (size_t)t2_ * 32 * 128 + cbo); rA = *(const GAS v4u*)(rb_ + (size_t)t2_ * 32 * 32 + rbo); } while (0)
    for (int c = blockIdx.x; c < 256; c += gridDim.x) {
        bf16x8 pqn[4], pqr[2]; v4u pmq, pc0, pr0, pc1, pr1, cA, rA;
        DSA_PRE_Q(0); DSA_PRE_T(0);
        for (int ui = 0; ui < 8; ++ui) {
            const int b = unit_batch(c, ui), j = unit_qtile(c, ui); const size_t tok0 = (size_t)b * SEQ + 32 * j;
#define UPTR(ty, nm, ex) const GAS ty* nm = (const GAS ty*)(ex); LAUNDER_G(nm)
            UPTR(bf16, qlb, QL + tok0 * 512 + h * 64); UPTR(bf16, qrb, QR + tok0 * 256 + h * 32); UPTR(v4u, wkb, WUKF + h * 1024); UPTR(unsigned, mrb, MASK + tok0 * 64);
            UPTR(bf16, cbb, CKV + (size_t)b * SEQ * 128); UPTR(bf16, rbb, KR + (size_t)b * SEQ * 32);
            v4u cB, rB;
            { *(LAS v4u*)(F.lds + wcs) = pc0; if (rl) *(LAS v4u*)(F.lds + wrs) = pr0; *(LAS v4u*)(F.lds + BUFB + wcs) = pc1; if (rl) *(LAS v4u*)(F.lds + BUFB + wrs) = pr1; }
            { const v4u mq = pmq; LAS unsigned* md = (LAS unsigned*)(F.lds + 32768 + (tid >> 4) * 260 + (tid & 15) * 16);
              md[0] = mq.x; md[1] = mq.y; md[2] = mq.z; md[3] = mq.w; }
            bf16x8 qf[10];
            {
              bf16x8 qn[4];
#pragma unroll
              for (int ks = 0; ks < 4; ++ks) qn[ks] = pqn[ks];
#pragma unroll
              for (int ct = 0; ct < 4; ++ct) { f32x16 X = (f32x16){};
#pragma unroll
                  for (int ks = 0; ks < 4; ++ks) { const bf16x8 wf = __builtin_bit_cast(bf16x8, wkb[(ct * 4 + ks) * 64 + lane]); X = MFMA32(wf, qn[ks], X); }
                  u32x4_t w0, w1; w0.x = cvtpk(X[0], X[1]); w0.y = cvtpk(X[2], X[3]); w0.z = cvtpk(X[4], X[5]); w0.w = cvtpk(X[6], X[7]); w1.x = cvtpk(X[8], X[9]); w1.y = cvtpk(X[10], X[11]); w1.z = cvtpk(X[12], X[13]); w1.w = cvtpk(X[14], X[15]);
                  qf[2 * ct] = __builtin_bit_cast(bf16x8, w0); qf[2 * ct + 1] = __builtin_bit_cast(bf16x8, w1); } }
#pragma unroll
            for (int ks = 0; ks < 2; ++ks) qf[8 + ks] = pqr[ks];
            f32x16 o[4];
#pragma unroll
            for (int d = 0; d < 4; ++d) o[d] = (f32x16){};
            float m = 0.f, l = 0.f, mbn = 0.f; bool seen = false;
            LAS unsigned char* mimg = F.lds + 32768 + q * 260;
#pragma unroll
            for (int ks = 0; ks < 10; ++ks) asm volatile("" : "+v"(qf[ks]));
            asm volatile("s_waitcnt lgkmcnt(0)" ::: "memory"); __builtin_amdgcn_s_barrier(); asm volatile("" ::: "memory");
            unsigned mw = *(const LAS unsigned*)mimg, mw1 = *(const LAS unsigned*)(mimg + 4 * ((1 <= j) ? 1 : j));
            f32x16 Sn; DSA_QK(Sn, F.lds, mw, mbn);
            asm volatile("s_nop 15\n\ts_nop 7" : "+v"(Sn));
            int bi = 0;
            for (int i = 0; i <= j; i += 2) {
                DSA_TILE(i, cA, rA, cB, rB);
                if (i + 1 <= j) DSA_TILE(i + 1, cB, rB, cA, rA);
            }
            DSA_PRE_T((ui + 1 < 8) ? ui + 1 : ui);
            DSA_PRE_Q((ui + 1 < 8) ? ui + 1 : ui);
            l += __shfl_xor(l, 32); const float il = 1.0f / l;
            UPTR(v4u, wvb, WUVF + h * 1024); UPTR(bf16, hxb, HX + tok0 * KOUT + h * 64);
            f32x16 oa[2]; oa[0] = (f32x16){}; oa[1] = (f32x16){};
#pragma unroll
            for (int dt = 0; dt < 4; ++dt) {
                u32x4_t w0, w1; w0.x = cvtpk(o[dt][0] * il, o[dt][1] * il); w0.y = cvtpk(o[dt][2] * il, o[dt][3] * il); w0.z = cvtpk(o[dt][4] * il, o[dt][5] * il); w0.w = cvtpk(o[dt][6] * il, o[dt][7] * il);
                w1.x = cvtpk(o[dt][8] * il, o[dt][9] * il); w1.y = cvtpk(o[dt][10] * il, o[dt][11] * il); w1.z = cvtpk(o[dt][12] * il, o[dt][13] * il); w1.w = cvtpk(o[dt][14] * il, o[dt][15] * il);
                const bf16x8 of0 = __builtin_bit_cast(bf16x8, w0), of1 = __builtin_bit_cast(bf16x8, w1);
#pragma unroll
                for (int vt = 0; vt < 2; ++vt) { oa[vt] = MFMA32(__builtin_bit_cast(bf16x8, wvb[((vt * 4 + dt) * 2 + 0) * 64 + lane]), of0, oa[vt]);
                                                 oa[vt] = MFMA32(__builtin_bit_cast(bf16x8, wvb[((vt * 4 + dt) * 2 + 1) * 64 + lane]), of1, oa[vt]); }
            }
            { LAS unsigned char* ob = F.lds + 49152 + h * 4608;
#pragma unroll
              for (int vt = 0; vt < 2; ++vt)
#pragma unroll
                  for (int g = 0; g < 4; ++g) { v2u w; w.x = cvtpk(oa[vt][4 * g], oa[vt][4 * g + 1]); w.y = cvtpk(oa[vt][4 * g + 2], oa[vt][4 * g + 3]); *(LAS v2u*)(ob + q * 144 + (32 * vt + 8 * g + 4 * hi) * 2) = w; }
#pragma unroll
              for (int pss = 0; pss < 4; ++pss) { const int rw = 8 * pss + (lane >> 3); const v4u val = *(const LAS v4u*)(ob + rw * 144 + (lane & 7) * 16); *(GAS v4u*)((GAS bf16*)hxb + rw * KOUT + (lane & 7) * 8) = val; } }
            asm volatile("s_waitcnt lgkmcnt(0)" ::: "memory"); __builtin_amdgcn_s_barrier(); asm volatile("" ::: "memory");
        }
    }
#undef DSA_QK
#undef DSA_PRE_Q
#undef DSA_PRE_T
#undef DSA_LD
#undef DSA_TILE
#undef UPTR
}
__device__ __forceinline__ void p3_dilated_mfma2(Frame& F) {
    const bf16 *QB = wsp<bf16>(F, WS_QB), *KB = wsp<bf16>(F, WS_KB), *VB = wsp<bf16>(F, WS_VB); bf16* HX = wsp<bf16>(F, WS_HX);
    const int lane = F.lane, q = lane & 31, hi = lane >> 5, h = F.wave;
    LAS unsigned char* kimg = F.lds + F.wave * 16384; LAS unsigned char* vimg = kimg + 4096;
    const unsigned ra0 = rowread_addr<8>(lane, 0), ra1 = rowread_addr<8>(lane, 1);
    const unsigned ta0 = trread_addr<8>(lane, 0, 0, 0), ta1 = trread_addr<8>(lane, 0, 0, 1);
    const unsigned wa_e = off_img<8>(lane >> 3, lane & 7), wa_o = off_img<8>((lane >> 3) + 8, lane & 7) - 1024;
    const int grow0 = (lane >> 3) * 512 + (lane & 7) * 8;
    float bfar[16]; unsigned m4bits = 0u;
#pragma unroll
    for (int r = 0; r < 16; ++r) { const int d0 = q - crow(r, hi); bfar[r] = ((d0 & 15) == 0) ? 0.f : -INFINITY; m4bits |= (((d0 & 3) == 0) ? 1u : 0u) << r; }
    for (int c = blockIdx.x; c < 256; c += gridDim.x) {
        const int sl = c >> 3;
        for (int ui = 0; ui < 4; ++ui) {
            const int b = 4 * (c & 7) + ui, jj = (ui & 1) ? 31 - sl : sl; const size_t tok0 = (size_t)b * SEQ + 64 * jj;
            bf16x8 qf[2][4];
#pragma unroll
            for (int t = 0; t < 2; ++t)
#pragma unroll
                for (int ks = 0; ks < 4; ++ks) qf[t][ks] = *(const bf16x8*)(QB + (tok0 + 32 * t + q) * 512 + h * 64 + 16 * ks + 8 * hi);
            f32x16 o[2][2];
#pragma unroll
            for (int t = 0; t < 2; ++t) { o[t][0] = (f32x16){}; o[t][1] = (f32x16){}; }
            float m[2] = {-1e30f, -1e30f}, l[2] = {0.f, 0.f};
            const bf16* kb = KB + (size_t)b * SEQ * 512 + h * 64; const bf16* vb = VB + (size_t)b * SEQ * 512 + h * 64;
            const int nt = 2 * jj + 2;
            v4u kr[4], vr[4];
#pragma unroll
            for (int p = 0; p < 4; ++p) { const GAS bf16* kt = (const GAS bf16*)kb; const GAS bf16* vt = (const GAS bf16*)vb; LAUNDER_G(kt); LAUNDER_G(vt); kr[p] = *(const GAS v4u*)(kt + grow0 + 4096 * p); vr[p] = *(const GAS v4u*)(vt + grow0 + 4096 * p); }
#pragma unroll
            for (int t = 0; t < 2; ++t)
#pragma unroll
                for (int ks = 0; ks < 4; ++ks) asm volatile("" : "+v"(qf[t][ks]));
            for (int i = 0; i < nt; ++i) {
#pragma unroll
                for (int p = 0; p < 4; ++p) { *(LAS v4u*)(kimg + ((p & 1) ? wa_o : wa_e) + 1024 * p) = kr[p]; *(LAS v4u*)(vimg + ((p & 1) ? wa_o : wa_e) + 1024 * p) = vr[p]; }
                { const int i1 = (i + 1 < nt) ? i + 1 : i; const GAS bf16* kt = (const GAS bf16*)(kb + (size_t)i1 * 32 * 512); const GAS bf16* vt = (const GAS bf16*)(vb + (size_t)i1 * 32 * 512);
                  LAUNDER_G(kt); LAUNDER_G(vt);
#pragma unroll
                  for (int p = 0; p < 4; ++p) { kr[p] = *(const GAS v4u*)(kt + grow0 + 4096 * p); vr[p] = *(const GAS v4u*)(vt + grow0 + 4096 * p); } }
                f32x16 S[2]; bf16x8 pf[2][2];
#pragma unroll
                for (int t = 0; t < 2; ++t) {
                    const int dlt = 32 * (2 * jj + t - i);
                    if (dlt > 512) {
#pragma unroll
                        for (int r = 0; r < 16; ++r) S[t][r] = bfar[r];
                    } else if (dlt >= 192 && dlt < 512) {
#pragma unroll
                        for (int r = 0; r < 16; ++r) S[t][r] = (bfar[r] == 0.f) ? 1.f : (((m4bits >> r) & 1u) ? 0.f : -INFINITY);
                    } else {
#pragma unroll
                        for (int r = 0; r < 16; ++r) { const int df = dlt + q - crow(r, hi);
                            int w = (df <= 128 ? 1 : 0) + ((((df & 3) == 0) && df <= 512) ? 1 : 0) + (((df & 15) == 0) ? 1 : 0); if (df < 0) w = 0;
                            S[t][r] = (w == 0) ? -INFINITY : (w == 1) ? 0.f : (w == 2) ? 1.f : 1.5849625007211562f; }
                    }
                }
#pragma unroll
                for (int ks = 0; ks < 4; ++ks) { const bf16x8 kf = *(const LAS bf16x8*)(kimg + ((ks & 1) ? ra1 : ra0) + 512 * (ks >> 1)); S[0] = MFMA32(kf, qf[0][ks], S[0]); S[1] = MFMA32(kf, qf[1][ks], S[1]); }
#pragma unroll
                for (int t = 0; t < 2; ++t) {
                    softmax_tile<2>(S[t], m[t], l[t], o[t], pf[t]);
                }
#pragma unroll
                for (int dt = 0; dt < 2; ++dt)
#pragma unroll
                    for (int ks = 0; ks < 2; ++ks) { const bf16x8 vf = trfrag(vimg + ta0 + 2048 * ks + 512 * dt, vimg + ta1 + 2048 * ks + 512 * dt);
                        o[0][dt] = MFMA32(vf, pf[0][ks], o[0][dt]); o[1][dt] = MFMA32(vf, pf[1][ks], o[1][dt]); }
            }
#pragma unroll
            for (int t = 0; t < 2; ++t) {
                float lt = l[t]; lt += __shfl_xor(lt, 32); const float il = 1.0f / lt;
                bf16* orow = HX + (tok0 + 32 * t + q) * KOUT + 512 + h * 64 + 4 * hi;
#pragma unroll
                for (int dt = 0; dt < 2; ++dt)
#pragma unroll
                    for (int g = 0; g < 4; ++g) { v2u w; w.x = cvtpk(o[t][dt][4 * g] * il, o[t][dt][4 * g + 1] * il); w.y = cvtpk(o[t][dt][4 * g + 2] * il, o[t][dt][4 * g + 3] * il); *(v2u*)(orow + 32 * dt + 8 * g) = w; }
            }
        }
    }
}

template <int PHASE> __device__ __forceinline__ void p3_dilated_v4(Frame& F) {
    const bf16 *QB = wsp<bf16>(F, WS_QB), *KB = wsp<bf16>(F, WS_KB), *VB = wsp<bf16>(F, WS_VB); bf16* HX = wsp<bf16>(F, WS_HX); bf16* PB = wsp<bf16>(F, WS_PB); float* ML = wsp<float>(F, WS_ML);
    const int lane = F.lane, q = lane & 31, hi = lane >> 5, h = F.wave;
    LAS unsigned char* kimg = F.lds + F.wave * 16384; LAS unsigned char* vimg = kimg + 4096;
    const unsigned ra0 = rowread_addr<8>(lane, 0), ra1 = rowread_addr<8>(lane, 1);
    const unsigned ta0 = trread_addr<8>(lane, 0, 0, 0), ta1 = trread_addr<8>(lane, 0, 0, 1);
    const unsigned wa_e = off_img<8>(lane >> 3, lane & 7), wa_o = off_img<8>((lane >> 3) + 8, lane & 7) - 1024;
    float bdiag[16]; unsigned eqbits = 0u;
#pragma unroll
    for (int r = 0; r < 16; ++r) { const int d0 = q - crow(r, hi); bdiag[r] = (d0 >= 0) ? 0.f : -INFINITY; eqbits |= ((d0 == 0) ? 1u : 0u) << r; }
    for (int c = blockIdx.x; c < 256; c += gridDim.x) {
        const int sl = c >> 3;
        for (int uu = 0; uu < (PHASE == 0 ? 8 : 4); ++uu) {
            const int b = 4 * (c & 7) + (PHASE == 0 ? (uu >> 1) : uu);
            const size_t tokb = (size_t)b * SEQ;
            int s, r0, vq0, mode;
            if (PHASE == 0) { if ((uu & 1) == 0) { s = 16; r0 = sl >> 1; vq0 = 64 * (sl & 1); mode = 0; } else { s = 4; r0 = sl >> 3; vq0 = 64 * (sl & 7); mode = 1; } }
            else { s = 1; r0 = 0; vq0 = 64 * sl; mode = 2; }
            bf16x8 qf[2][4];
#pragma unroll
            for (int t = 0; t < 2; ++t)
#pragma unroll
                for (int ks = 0; ks < 4; ++ks) qf[t][ks] = *(const bf16x8*)(QB + (tokb + r0 + (size_t)s * (vq0 + 32 * t + q)) * 512 + h * 64 + 16 * ks + 8 * hi);
            f32x16 o[2][2];
#pragma unroll
            for (int t = 0; t < 2; ++t) { o[t][0] = (f32x16){}; o[t][1] = (f32x16){}; }
            float m[2] = {-1e30f, -1e30f}, l[2] = {0.f, 0.f};
            const bf16* kb = KB + (tokb + r0) * 512 + h * 64; const bf16* vb = VB + (tokb + r0) * 512 + h * 64;
            const int jt0 = vq0 >> 5, i0 = (jt0 > 4) ? jt0 - 4 : 0, i1 = jt0 + 1;
            const int grow0 = (lane >> 3) * s * 512 + (lane & 7) * 8, gstep = 4096 * s;
            v4u kr[4], vr[4];
            { const GAS bf16* kt = (const GAS bf16*)(kb + (size_t)i0 * 32 * s * 512); const GAS bf16* vt = (const GAS bf16*)(vb + (size_t)i0 * 32 * s * 512); LAUNDER_G(kt); LAUNDER_G(vt);
#pragma unroll
              for (int p = 0; p < 4; ++p) { kr[p] = *(const GAS v4u*)(kt + grow0 + gstep * p); vr[p] = *(const GAS v4u*)(vt + grow0 + gstep * p); } }
#pragma unroll
            for (int t = 0; t < 2; ++t)
#pragma unroll
                for (int ks = 0; ks < 4; ++ks) asm volatile("" : "+v"(qf[t][ks]));
            for (int i = i0; i <= i1; ++i) {
#pragma unroll
                for (int p = 0; p < 4; ++p) { *(LAS v4u*)(kimg + ((p & 1) ? wa_o : wa_e) + 1024 * p) = kr[p]; *(LAS v4u*)(vimg + ((p & 1) ? wa_o : wa_e) + 1024 * p) = vr[p]; }
                { const int in = (i + 1 <= i1) ? i + 1 : i; const GAS bf16* kt = (const GAS bf16*)(kb + (size_t)in * 32 * s * 512); const GAS bf16* vt = (const GAS bf16*)(vb + (size_t)in * 32 * s * 512);
                  LAUNDER_G(kt); LAUNDER_G(vt);
#pragma unroll
                  for (int p = 0; p < 4; ++p) { kr[p] = *(const GAS v4u*)(kt + grow0 + gstep * p); vr[p] = *(const GAS v4u*)(vt + grow0 + gstep * p); } }
                f32x16 S[2]; bf16x8 pf[2][2];
#pragma unroll
                for (int t = 0; t < 2; ++t) {
                    const int dt_ = jt0 + t - i;
                    if (dt_ >= 1 && dt_ <= 3) { S[t] = (f32x16){}; }
                    else if (dt_ == 0) {
#pragma unroll
                        for (int r = 0; r < 16; ++r) S[t][r] = bdiag[r];
                    } else if (dt_ == 4) {
#pragma unroll
                        for (int r = 0; r < 16; ++r) S[t][r] = (bdiag[r] != 0.f || ((eqbits >> r) & 1u)) ? 0.f : -INFINITY;
                    } else {
#pragma unroll
                        for (int r = 0; r < 16; ++r) S[t][r] = -INFINITY;
                    }
                }
#pragma unroll
                for (int ks = 0; ks < 4; ++ks) { const bf16x8 kf = *(const LAS bf16x8*)(kimg + ((ks & 1) ? ra1 : ra0) + 512 * (ks >> 1)); S[0] = MFMA32(kf, qf[0][ks], S[0]); S[1] = MFMA32(kf, qf[1][ks], S[1]); }
#pragma unroll
                for (int t = 0; t < 2; ++t) {
                    softmax_tile<2>(S[t], m[t], l[t], o[t], pf[t]);
                }
#pragma unroll
                for (int dt = 0; dt < 2; ++dt)
#pragma unroll
                    for (int ks = 0; ks < 2; ++ks) { const bf16x8 vf = trfrag(vimg + ta0 + 2048 * ks + 512 * dt, vimg + ta1 + 2048 * ks + 512 * dt);
                        o[0][dt] = MFMA32(vf, pf[0][ks], o[0][dt]); o[1][dt] = MFMA32(vf, pf[1][ks], o[1][dt]); }
            }
            int ln_ = lane; asm volatile("" : "+v"(ln_));
            const int q_ = ln_ & 31, hi_ = ln_ >> 5;
#pragma unroll
            for (int t = 0; t < 2; ++t) {
                const size_t posq = r0 + (size_t)s * (vq0 + 32 * t + q_);
                float lt = l[t]; lt += __shfl_xor(lt, 32);
                float c1 = 1.0f, c3 = 0.f, c2 = 0.f;
                if (PHASE == 0) { if (hi_ == 0) *(f32x2*)(ML + ((((size_t)mode * NB + b) * 8 + h) * SEQ + (size_t)r0 * (SEQ / s) + (vq0 + 32 * t + q_)) * 2) = (f32x2){m[t], lt}; }
                else {
                    const f32x2 ml3 = *(const f32x2*)(ML + (((size_t)b * 8 + h) * SEQ + (posq & 15) * 128 + (posq >> 4)) * 2), ml2 = *(const f32x2*)(ML + ((((size_t)NB + b) * 8 + h) * SEQ + (posq & 3) * 512 + (posq >> 2)) * 2);
                    const float M = fmaxf(m[t], fmaxf(ml3[0], ml2[0]));
                    const float a1 = __builtin_amdgcn_exp2f(m[t] - M), a3 = __builtin_amdgcn_exp2f(ml3[0] - M), a2 = __builtin_amdgcn_exp2f(ml2[0] - M);
                    const float il = 1.0f / (a1 * lt + a3 * ml3[1] + a2 * ml2[1]);
                    c1 = a1 * il; c3 = a3 * il; c2 = a2 * il;
                }
                LAS unsigned char* tb = kimg + t * 4608;
#pragma unroll
                for (int dt = 0; dt < 2; ++dt)
#pragma unroll
                    for (int g = 0; g < 4; ++g) { v2u wv; wv.x = cvtpk(o[t][dt][4 * g] * c1, o[t][dt][4 * g + 1] * c1); wv.y = cvtpk(o[t][dt][4 * g + 2] * c1, o[t][dt][4 * g + 3] * c1);
                        *(LAS v2u*)(tb + q_ * 144 + (32 * dt + 8 * g + 4 * hi_) * 2) = wv; }
                if (PHASE != 0) { *(LAS f32x2*)(kimg + 9216 + t * 512 + q_ * 16 + hi_ * 8) = (f32x2){c3, c2}; }
            }
#pragma unroll
            for (int t = 0; t < 2; ++t)
#pragma unroll
                for (int pss = 0; pss < 4; ++pss) {
                    const int rw = 8 * pss + (ln_ >> 3), ch = ln_ & 7;
                    const size_t posr = r0 + (size_t)s * (vq0 + 32 * t + rw), tokr = tokb + posr;
                    v4u val = *(const LAS v4u*)(kimg + t * 4608 + rw * 144 + ch * 16);
                    bf16* hrow = HX + tokr * KOUT + 512 + h * 64 + ch * 8; bf16* prow = PB + tokr * 512 + h * 64 + ch * 8;
                    if (PHASE == 0) { *(v4u*)((mode == 0) ? prow : hrow) = val; }
                    else {
                        const f32x2 cw = *(const LAS f32x2*)(kimg + 9216 + t * 512 + rw * 16);
                        const v4u x3 = *(const v4u*)prow, x2 = *(const v4u*)hrow;
                        v4u y;
                        y.x = cvtpk(bflo(val.x) + cw[0] * bflo(x3.x) + cw[1] * bflo(x2.x), bfhi(val.x) + cw[0] * bfhi(x3.x) + cw[1] * bfhi(x2.x));
                        y.y = cvtpk(bflo(val.y) + cw[0] * bflo(x3.y) + cw[1] * bflo(x2.y), bfhi(val.y) + cw[0] * bfhi(x3.y) + cw[1] * bfhi(x2.y));
                        y.z = cvtpk(bflo(val.z) + cw[0] * bflo(x3.z) + cw[1] * bflo(x2.z), bfhi(val.z) + cw[0] * bfhi(x3.z) + cw[1] * bfhi(x2.z));
                        y.w = cvtpk(bflo(val.w) + cw[0] * bflo(x3.w) + cw[1] * bflo(x2.w), bfhi(val.w) + cw[0] * bfhi(x3.w) + cw[1] * bfhi(x2.w));
                        *(v4u*)hrow = y;
                    }
                }
            asm volatile("s_waitcnt lgkmcnt(0)" ::: "memory");
        }
    }
}

typedef float f32x4v __attribute__((ext_vector_type(4)));
__device__ __forceinline__ void p2_index_mfma2(Frame& F) {
    const bf16 *QI = wsp<bf16>(F, WS_QI), *KI = wsp<bf16>(F, WS_KI); const float* WI = wsp<float>(F, WS_WI); unsigned* MASK = wsp<unsigned>(F, WS_MASK);
    unsigned* SC = wsp<unsigned>(F, WS_SC) + (size_t)blockIdx.x * (32 * 2048);
    const int lane = F.lane, w = F.wave, qh = w & 1, kg = w >> 1, ql = lane & 15, kq = lane >> 4;
    LAS unsigned char* kimg = F.lds + F.wave * 16384;
    LAS unsigned long long* lm = (LAS unsigned long long*)(kimg + 8192);
    const unsigned rra = kq * 528 + ql * 16;
    unsigned wa[4];
#pragma unroll
    for (int p = 0; p < 4; ++p) { const int e = lane + 64 * p; wa[p] = (e & 7) * 528 + (e >> 3) * 16; }
    for (int c = blockIdx.x; c < 256; c += gridDim.x) {
        for (int ui = 0; ui < 8; ++ui) {
            const int b = unit_batch(c, ui), j = unit_qtile(c, ui); const size_t tok0 = (size_t)b * SEQ + 32 * j;
            if (kg <= j) {
                const int qloc = 16 * qh + ql, qpos = 32 * j + qloc;
                const GAS bf16* qb_ = (const GAS bf16*)(QI + tok0 * 512); LAUNDER_G(qb_);
                bf16x8 qf[8][2];
#pragma unroll
                for (int hh = 0; hh < 8; ++hh)
#pragma unroll
                    for (int ks = 0; ks < 2; ++ks) qf[hh][ks] = *(const GAS bf16x8*)(qb_ + qloc * 512 + hh * 64 + 32 * ks + 8 * kq);
                const GAS float* wb_ = (const GAS float*)(WI + tok0 * 8); LAUNDER_G(wb_);
                const f32x4 wva = *(const GAS f32x4*)(wb_ + qloc * 8), wvb = *(const GAS f32x4*)(wb_ + qloc * 8 + 4);
                const float wq[8] = {wva[0], wva[1], wva[2], wva[3], wvb[0], wvb[1], wvb[2], wvb[3]};
                const bf16* kbase = KI + (size_t)b * SEQ * 64;
                v4u kr[4];
                { const GAS bf16* kt = (const GAS bf16*)(kbase + (size_t)kg * 32 * 64); LAUNDER_G(kt);
#pragma unroll
                  for (int p = 0; p < 4; ++p) kr[p] = *(const GAS v4u*)(kt + 8 * lane + 512 * p); }
#pragma unroll
                for (int hh = 0; hh < 8; ++hh) { asm volatile("" : "+v"(qf[hh][0])); asm volatile("" : "+v"(qf[hh][1])); }
                for (int i = kg; i <= j; i += 4) {
#pragma unroll
                    for (int p = 0; p < 4; ++p) *(LAS v4u*)(kimg + wa[p]) = kr[p];
                    { const int i1 = (i + 4 <= j) ? i + 4 : i; const GAS bf16* kt = (const GAS bf16*)(kbase + (size_t)i1 * 32 * 64); LAUNDER_G(kt);
#pragma unroll
                      for (int p = 0; p < 4; ++p) kr[p] = *(const GAS v4u*)(kt + 8 * lane + 512 * p); }
#pragma unroll
                    for (int kb = 0; kb < 2; ++kb) {
                        const bf16x8 k0 = *(const LAS bf16x8*)(kimg + rra + kb * 256), k1 = *(const LAS bf16x8*)(kimg + rra + 2112 + kb * 256);
                        f32x4v idx = (f32x4v){0.f, 0.f, 0.f, 0.f};
#pragma unroll
                        for (int hh = 0; hh < 8; ++hh) {
                            f32x4v S = __builtin_amdgcn_mfma_f32_16x16x32_bf16(k0, qf[hh][0], (f32x4v){0.f, 0.f, 0.f, 0.f}, 0, 0, 0);
                            S = __builtin_amdgcn_mfma_f32_16x16x32_bf16(k1, qf[hh][1], S, 0, 0, 0);
#pragma unroll
                            for (int e = 0; e < 4; ++e) idx[e] = fmaf(__builtin_amdgcn_fmed3f(S[e], 0.f, __builtin_inff()), wq[hh], idx[e]);
                        }
                        v4u kv;
#pragma unroll
                        for (int e = 0; e < 4; ++e) { const int s = 32 * i + 16 * kb + 4 * kq + e; unsigned ord = __float_as_uint(idx[e]); ord ^= (ord >> 31) ? 0xFFFFFFFFu : 0x80000000u;
                            kv[e] = (s <= qpos) ? ((ord & 0xFFFFF800u) | (unsigned)(SEQ - 1 - s)) : 0u; }
                        { GAS unsigned* sct = (GAS unsigned*)(SC + 32 * i + 16 * kb); LAUNDER_G(sct); *(GAS v4u*)(sct + qloc * 2048 + 4 * kq) = kv; }
                    }
                }
            }
            __syncthreads();
#define SEL_LOAD(K, n) do { const GAS unsigned* sr = (const GAS unsigned*)(SC + (size_t)(4 * w + (n)) * 2048); LAUNDER_G(sr); \
                _Pragma("unroll") for (int r = 0; r < 32; ++r) K[r] = sr[r * 64 + lane]; } while (0)
#define SEL_RUN(K, n) do { const int qq = 4 * w + (n), qp = 32 * j + qq, nr = (qp >> 6) + 1; const size_t t = tok0 + qq; \
                _Pragma("unroll") for (int r = 0; r < 32; ++r) K[r] = (r * 64 + lane <= qp) ? K[r] : 0u; \
                unsigned thr = 1u; \
                if (qp >= 256) { \
                    unsigned lo = 0u; \
                    _Pragma("unroll 1") for (int bit = 31; bit >= 0; --bit) { \
                        const unsigned cand = lo | (1u << bit); int cnt = 0; \
                        _Pragma("unroll") for (int g = 0; g < 4; ++g) if (8 * g < nr) { \
                            unsigned long long m0, m1, m2, m3, m4, m5, m6, m7; \
                            asm volatile("v_cmp_ge_u32_e64 %0, %8, %16\n\tv_cmp_ge_u32_e64 %1, %9, %16\n\tv_cmp_ge_u32_e64 %2, %10, %16\n\tv_cmp_ge_u32_e64 %3, %11, %16\n\t" \
                                         "v_cmp_ge_u32_e64 %4, %12, %16\n\tv_cmp_ge_u32_e64 %5, %13, %16\n\tv_cmp_ge_u32_e64 %6, %14, %16\n\tv_cmp_ge_u32_e64 %7, %15, %16" \
                                         : "=&s"(m0), "=&s"(m1), "=&s"(m2), "=&s"(m3), "=&s"(m4), "=&s"(m5), "=&s"(m6), "=&s"(m7) \
                                         : "v"(K[8 * g]), "v"(K[8 * g + 1]), "v"(K[8 * g + 2]), "v"(K[8 * g + 3]), "v"(K[8 * g + 4]), "v"(K[8 * g + 5]), "v"(K[8 * g + 6]), "v"(K[8 * g + 7]), "s"(cand)); \
                            cnt += (__popcll(m0) + __popcll(m1)) + (__popcll(m2) + __popcll(m3)) + (__popcll(m4) + __popcll(m5)) + (__popcll(m6) + __popcll(m7)); } \
                        if (cnt >= 256) lo = cand; \
                        if (cnt == 256) break; \
                    } \
                    thr = lo; \
                } \
                  \
                thr = (thr < 1u) ? 1u : thr; unsigned mlo = 0u, mhi = 0u; \
                _Pragma("unroll") for (int r = 0; r < 32; ++r) { const unsigned long long bm = __ballot(K[r] >= thr); \
                    asm volatile("s_nop 4\n\tv_writelane_b32 %0, %2, %4\n\tv_writelane_b32 %1, %3, %4" : "+v"(mlo), "+v"(mhi) : "s"((unsigned)bm), "s"((unsigned)(bm >> 32)), "n"(r)); } \
                { GAS unsigned* mb_ = (GAS unsigned*)(MASK + t * 64); LAUNDER_G(mb_); if (lane < 32) { v2u mv_; mv_.x = mlo; mv_.y = mhi; *(GAS v2u*)(mb_ + 2 * lane) = mv_; } } \
                LDS_WAIT(); } while (0)
            { unsigned kA[32], kB[32];
              SEL_LOAD(kA, 0);
              SEL_LOAD(kB, 1); SEL_RUN(kA, 0);
              SEL_LOAD(kA, 2); SEL_RUN(kB, 1);
              SEL_LOAD(kB, 3); SEL_RUN(kA, 2);
              SEL_RUN(kB, 3); }
#undef SEL_LOAD
#undef SEL_RUN
            __syncthreads();
        }
    }
}

__device__ __forceinline__ void p2_index_v3(Frame& F) {
    const bf16 *QI = wsp<bf16>(F, WS_QI), *KI = wsp<bf16>(F, WS_KI); const float* WI = wsp<float>(F, WS_WI); unsigned* MASK = wsp<unsigned>(F, WS_MASK);
    const int lane = F.lane, w = F.wave, ql = lane & 15, kq = lane >> 4;
    constexpr int PITCH = 8192;
    LAS unsigned char* sc = F.lds;
#define IDX_LDQ(hs_) do { const int ui_ = (hs_) >> 1, b_ = unit_batch(c, ui_), j_ = unit_qtile(c, ui_); const size_t t0_ = (size_t)b_ * SEQ + 32 * j_; const int ql_ = 16 * ((hs_) & 1) + ql; \
        const GAS bf16* qb_ = (const GAS bf16*)(QI + t0_ * 512); LAUNDER_G(qb_); \
        _Pragma("unroll") for (int hh = 0; hh < 8; ++hh) _Pragma("unroll") for (int ks = 0; ks < 2; ++ks) qf[hh][ks] = *(const GAS bf16x8*)(qb_ + ql_ * 512 + hh * 64 + 32 * ks + 8 * kq); \
        const GAS float* wb_ = (const GAS float*)(WI + t0_ * 8); LAUNDER_G(wb_); wva = *(const GAS f32x4*)(wb_ + ql_ * 8); wvb = *(const GAS f32x4*)(wb_ + ql_ * 8 + 4); \
        const GAS bf16* kt_ = (const GAS bf16*)(KI + ((size_t)b_ * SEQ + (size_t)((w <= j_) ? w : 0) * 32) * 64); LAUNDER_G(kt_); \
        _Pragma("unroll") for (int kb = 0; kb < 2; ++kb) _Pragma("unroll") for (int ks = 0; ks < 2; ++ks) kf[kb][ks] = *(const GAS bf16x8*)(kt_ + kfo + kb * 1024 + ks * 32); } while (0)
    const int kfo = ql * 64 + 8 * kq;
    for (int c = blockIdx.x; c < 256; c += gridDim.x) {
        bf16x8 qf[8][2]; f32x4 wva, wvb; bf16x8 kf[2][2];
        IDX_LDQ(0);
#pragma unroll 1
        for (int hs = 0; hs < 16; ++hs) {
            const int ui = hs >> 1, qh = hs & 1;
            const int b = unit_batch(c, ui), j = unit_qtile(c, ui); const size_t tok0 = (size_t)b * SEQ + 32 * j;
            {
                if (w <= j) {
                    const int qloc = 16 * qh + ql, qpos = 32 * j + qloc;
                    const float wq[8] = {0.5f * wva[0], 0.5f * wva[1], 0.5f * wva[2], 0.5f * wva[3], 0.5f * wvb[0], 0.5f * wvb[1], 0.5f * wvb[2], 0.5f * wvb[3]};
                    bf16x8 qt[2];
#pragma unroll
                    for (int ks = 0; ks < 2; ++ks) { float a_[8];
#pragma unroll
                        for (int e = 0; e < 8; ++e) a_[e] = 0.f;
#pragma unroll
                        for (int hh = 0; hh < 8; ++hh)
#pragma unroll
                            for (int e = 0; e < 8; ++e) a_[e] = fmaf(__uint_as_float((unsigned)(unsigned short)qf[hh][ks][e] << 16), wq[hh], a_[e]);
                        typedef unsigned u32x4_q __attribute__((ext_vector_type(4)));
                        u32x4_q w_; w_.x = cvtpk(a_[0], a_[1]); w_.y = cvtpk(a_[2], a_[3]); w_.z = cvtpk(a_[4], a_[5]); w_.w = cvtpk(a_[6], a_[7]);
                        qt[ks] = __builtin_bit_cast(bf16x8, w_); }
                    const bf16* kbase = KI + (size_t)b * SEQ * 64;
#pragma unroll
                    for (int hh = 0; hh < 8; ++hh) { asm volatile("" : "+v"(qf[hh][0])); asm volatile("" : "+v"(qf[hh][1])); }
                    for (int i = w; i <= j; i += 8) {
                        bf16x8 kc[2][2];
#pragma unroll
                        for (int kb = 0; kb < 2; ++kb)
#pragma unroll
                            for (int ks = 0; ks < 2; ++ks) kc[kb][ks] = kf[kb][ks];
                        { const int i1 = (i + 8 <= j) ? i + 8 : i; const GAS bf16* kt = (const GAS bf16*)(kbase + (size_t)i1 * 32 * 64); LAUNDER_G(kt);
#pragma unroll
                          for (int kb = 0; kb < 2; ++kb)
#pragma unroll
                              for (int ks = 0; ks < 2; ++ks) kf[kb][ks] = *(const GAS bf16x8*)(kt + kfo + kb * 1024 + ks * 32); }
#pragma unroll
                        for (int kb = 0; kb < 2; ++kb) {
                            f32x4v idx = __builtin_amdgcn_mfma_f32_16x16x32_bf16(kc[kb][0], qt[0], (f32x4v){0.f, 0.f, 0.f, 0.f}, 0, 0, 0);
                            idx = __builtin_amdgcn_mfma_f32_16x16x32_bf16(kc[kb][1], qt[1], idx, 0, 0, 0);
#pragma unroll
                            for (int hh = 0; hh < 8; ++hh) {
                                f32x4v S = __builtin_amdgcn_mfma_f32_16x16x32_bf16(kc[kb][0], qf[hh][0], (f32x4v){0.f, 0.f, 0.f, 0.f}, 0, 0, 0);
                                S = __builtin_amdgcn_mfma_f32_16x16x32_bf16(kc[kb][1], qf[hh][1], S, 0, 0, 0);
#pragma unroll
                                for (int e = 0; e < 4; ++e) { float t_ = fmaf(__builtin_fabsf(S[e]), wq[hh], idx[e]); asm("" : "+v"(t_)); idx[e] = t_; }
                            }
                            v4u kv;
#pragma unroll
                            for (int e = 0; e < 4; ++e) { const int s_ = 32 * i + 16 * kb + 4 * kq + e; unsigned ord = __float_as_uint(idx[e]); ord ^= (ord >> 31) ? 0xFFFFFFFFu : 0x80000000u;
                                kv[e] = (s_ <= qpos) ? ((ord & 0xFFFFF800u) | (unsigned)(SEQ - 1 - s_)) : 0u; }
                            *(LAS v4u*)(sc + ql * PITCH + (((8 * i + 4 * kb + kq) ^ (ql & 7)) << 4)) = kv;
                        }
                    }
                }
                if (hs + 1 < 16) IDX_LDQ(hs + 1);
                asm volatile("s_waitcnt lgkmcnt(0)" ::: "memory"); __builtin_amdgcn_s_barrier(); asm volatile("" ::: "memory");
#define SEL_LOAD3(K, n) do { const int q_ = 2 * w + (n); const LAS unsigned* sr = (const LAS unsigned*)(sc + q_ * PITCH + ((((lane >> 2) ^ (q_ & 7)) << 4) | ((lane & 3) << 2))); \
                _Pragma("unroll") for (int r = 0; r < 32; ++r) K[r] = sr[r * 64]; } while (0)
#define SEL_RUN3(K, n) do { const int qq = 16 * qh + 2 * w + (n), qp = 32 * j + qq, nr = (qp >> 6) + 1; const size_t t = tok0 + qq; \
                _Pragma("unroll") for (int r = 0; r < 32; ++r) K[r] = (r * 64 + lane <= qp) ? K[r] : 0u; \
                unsigned thr = 1u; \
                if (qp >= 256) { \
                    unsigned lo = 0u; \
                    _Pragma("unroll 1") for (int bit = 31; bit >= 0; --bit) { \
                        const unsigned cand = lo | (1u << bit); int cnt = 0; \
                        _Pragma("unroll") for (int g = 0; g < 4; ++g) if (8 * g < nr) { \
                            unsigned long long m0, m1, m2, m3, m4, m5, m6, m7; \
                            asm volatile("v_cmp_ge_u32_e64 %0, %8, %16\n\tv_cmp_ge_u32_e64 %1, %9, %16\n\tv_cmp_ge_u32_e64 %2, %10, %16\n\tv_cmp_ge_u32_e64 %3, %11, %16\n\t" \
                                         "v_cmp_ge_u32_e64 %4, %12, %16\n\tv_cmp_ge_u32_e64 %5, %13, %16\n\tv_cmp_ge_u32_e64 %6, %14, %16\n\tv_cmp_ge_u32_e64 %7, %15, %16" \
                                         : "=&s"(m0), "=&s"(m1), "=&s"(m2), "=&s"(m3), "=&s"(m4), "=&s"(m5), "=&s"(m6), "=&s"(m7) \
                                         : "v"(K[8 * g]), "v"(K[8 * g + 1]), "v"(K[8 * g + 2]), "v"(K[8 * g + 3]), "v"(K[8 * g + 4]), "v"(K[8 * g + 5]), "v"(K[8 * g + 6]), "v"(K[8 * g + 7]), "s"(cand)); \
                            cnt += (__popcll(m0) + __popcll(m1)) + (__popcll(m2) + __popcll(m3)) + (__popcll(m4) + __popcll(m5)) + (__popcll(m6) + __popcll(m7)); } \
                        if (cnt >= 256) lo = cand; \
                        if (cnt == 256) break; \
                    } \
                    thr = lo; \
                } \
                  \
                thr = (thr < 1u) ? 1u : thr; unsigned mlo = 0u, mhi = 0u; \
                _Pragma("unroll") for (int r = 0; r < 32; ++r) { const unsigned long long bm = __ballot(K[r] >= thr); \
                    asm volatile("s_nop 4\n\tv_writelane_b32 %0, %2, %4\n\tv_writelane_b32 %1, %3, %4" : "+v"(mlo), "+v"(mhi) : "s"((unsigned)bm), "s"((unsigned)(bm >> 32)), "n"(r)); } \
                { GAS unsigned* mb_ = (GAS unsigned*)(MASK + t * 64); LAUNDER_G(mb_); if (lane < 32) { v2u mv_; mv_.x = mlo; mv_.y = mhi; *(GAS v2u*)(mb_ + 2 * lane) = mv_; } } \
                LDS_WAIT(); } while (0)
                { unsigned kA[32], kB[32];
                  SEL_LOAD3(kA, 0); SEL_LOAD3(kB, 1);
                  SEL_RUN3(kA, 0); SEL_RUN3(kB, 1); }
#undef SEL_LOAD3
#undef SEL_RUN3
                asm volatile("s_waitcnt lgkmcnt(0)" ::: "memory"); __builtin_amdgcn_s_barrier(); asm volatile("" ::: "memory");
            }
        }
    }
#undef IDX_LDQ
}

__device__ __forceinline__ void p10_final(Frame& F) {
    const float* parts = wsp<float>(F, WS_P3); const float* g = inp(F, 16); const bf16* XB = wsp<bf16>(F, WS_XB);
    f32x4 gv[4];
#pragma unroll
    for (int j = 0; j < 4; ++j) gv[j] = *((const f32x4*)g + F.lane + 64 * j);
    v2u wn[4][4]; f32x4 pq[4][4];
#define P9_LOAD(r0_) do { _Pragma("unroll") for (int u = 0; u < 4; ++u) { const int r = (r0_) + u * F.NGW; const v2u* xi = (const v2u*)(XB + (size_t)r * DM) + F.lane; \
            _Pragma("unroll") for (int j = 0; j < 4; ++j) wn[u][j] = xi[64 * j]; \
            const f32x4* pp = (const f32x4*)(parts + (size_t)r * 16); _Pragma("unroll") for (int k = 0; k < 4; ++k) pq[u][k] = pp[k]; } } while (0)
    P9_LOAD(F.gw);
    for (int r0 = F.gw; r0 < T; r0 += 4 * F.NGW) {
        v2u w[4][4]; float rs[4];
#pragma unroll
        for (int u = 0; u < 4; ++u) {
#pragma unroll
            for (int j = 0; j < 4; ++j) w[u][j] = wn[u][j];
            const f32x4 a = pq[u][0], b = pq[u][1], c = pq[u][2], d = pq[u][3];
            const float ss = ((a[0] + a[1]) + (a[2] + a[3])) + ((b[0] + b[1]) + (b[2] + b[3])) + ((c[0] + c[1]) + (c[2] + c[3])) + ((d[0] + d[1]) + (d[2] + d[3]));
            rs[u] = 1.0f / sqrtf(ss * (1.0f / DM) + EPS); }
        if (r0 + 4 * F.NGW < T) P9_LOAD(r0 + 4 * F.NGW);
#pragma unroll
        for (int u = 0; u < 4; ++u) { const int r = r0 + u * F.NGW; f32x4* o = (f32x4*)(outp(F) + (size_t)r * DM) + F.lane;
#pragma unroll
            for (int j = 0; j < 4; ++j) __builtin_nontemporal_store((f32x4){bflo(w[u][j].x), bfhi(w[u][j].x), bflo(w[u][j].y), bfhi(w[u][j].y)} * rs[u] * gv[j], o + 64 * j); }
    }
#undef P9_LOAD
}

#define RLX_AGENT __ATOMIC_RELAXED, __HIP_MEMORY_SCOPE_AGENT
#define XB_TMO      128
#define XB_XCNT(j)  (256  + 64 * (j))
#define XB_XSUB(j)  (1280 + 64 * (j))
#define XB_XGEN(j)  (2304 + 64 * (j))
#define XB_TOP      3328
#define XB_TOPGEN   3392
#define XCD_BAR_WORDS 3456
#define XB_SPIN_CAP (1u << 18)

__device__ __forceinline__ unsigned xb_ld(unsigned* p)              { return __hip_atomic_load(p, __ATOMIC_RELAXED, __HIP_MEMORY_SCOPE_AGENT); }
__device__ __forceinline__ unsigned xb_add(unsigned* p, unsigned v) { return __hip_atomic_fetch_add(p, v, __ATOMIC_RELAXED, __HIP_MEMORY_SCOPE_AGENT); }
__device__ __forceinline__ unsigned xb_xcc_id() { return (unsigned)__builtin_amdgcn_s_getreg((3 << 11) | 20) & 0xFu; }
#define XB_SPIN(cond, bar) do { unsigned _sp = 0; while (cond) { __builtin_amdgcn_s_sleep(1); \
    if ((++_sp & 255u) == 0u) { if (xb_ld(&(bar)[XB_TMO])) break; if (_sp > XB_SPIN_CAP) { atomicAdd(&(bar)[XB_TMO], 1u); break; } } } } while (0)

struct XcdBarrier {
    unsigned* bar; unsigned x;
    volatile LAS unsigned* st;
};

__device__ __forceinline__ XcdBarrier xcd_barrier_post(unsigned* bar, volatile LAS unsigned* st) {
    XcdBarrier b; b.bar = bar; b.x = xb_xcc_id(); b.st = st;
    if (threadIdx.x == 0) (void)xb_add(&bar[XB_XCNT(b.x)], 1u);
    return b;
}
__device__ __forceinline__ void xcd_barrier_complete(unsigned* bar, unsigned x, unsigned& nloc, unsigned& nx) {
    const unsigned G = gridDim.x * gridDim.y * gridDim.z;
    unsigned sum, cnt, mine, sp = 0u;
    for (;;) {
        sum = 0u; cnt = 0u; mine = 0u;
#pragma unroll
        for (unsigned j = 0; j < 16; ++j) { const unsigned c = xb_ld(&bar[XB_XCNT(j)]); sum += c; cnt += (c > 0u) ? 1u : 0u; mine = (j == x) ? c : mine; }
        if (sum == G) break;
        __builtin_amdgcn_s_sleep(1);
        if ((++sp & 255u) == 0u) { if (xb_ld(&bar[XB_TMO])) break; if (sp > XB_SPIN_CAP) { atomicAdd(&bar[XB_TMO], 1u); break; } }
    }
    nloc = mine > 0u ? mine : 1u; nx = cnt > 0u ? cnt : 1u;
}

__device__ __forceinline__ void xcd_barrier(const XcdBarrier& b, const bool t0) {
    asm volatile("s_waitcnt vmcnt(0)" ::: "memory");
    __syncthreads();
    if (t0) {
        unsigned* bar = b.bar;
        __builtin_amdgcn_s_waitcnt(0);
        unsigned nloc = b.st[0], nx = b.st[1];
        if (nloc == 0u) { xcd_barrier_complete(bar, b.x, nloc, nx); b.st[0] = nloc; b.st[1] = nx; }
        const unsigned old = xb_add(&bar[XB_XSUB(b.x)], 1u);
        const unsigned gen = old / nloc;
        if (old + 1u == (gen + 1u) * nloc) {
            __builtin_amdgcn_fence(__ATOMIC_RELEASE, "agent");
            asm volatile("s_waitcnt vmcnt(0)" ::: "memory");
            const unsigned og = xb_add(&bar[XB_TOP], 1u);
            const unsigned tg = og / nx;
            if (og + 1u == (tg + 1u) * nx) xb_add(&bar[XB_TOPGEN], 1u);
            else XB_SPIN(xb_ld(&bar[XB_TOPGEN]) == tg, bar);
            __builtin_amdgcn_fence(__ATOMIC_ACQUIRE, "agent");
            xb_add(&bar[XB_XGEN(b.x)], 1u);
            asm volatile("s_waitcnt vmcnt(0)" ::: "memory");
        } else {
            XB_SPIN(xb_ld(&bar[XB_XGEN(b.x)]) == gen, bar);
            __builtin_amdgcn_fence(__ATOMIC_ACQUIRE, "agent");
            asm volatile("s_waitcnt vmcnt(0)" ::: "memory");
        }
    }
    __syncthreads();
}

__device__ __forceinline__ void stagger_delay(int ticks100mhz) {
    if (ticks100mhz > 0) { const unsigned long long t0 = __builtin_amdgcn_s_memrealtime(); while (__builtin_amdgcn_s_memrealtime() - t0 < (unsigned long long)ticks100mhz) __builtin_amdgcn_s_sleep(32); }
}
struct Args { const float* in[17]; float* out; unsigned char* ws; int ph_lo, ph_hi; };
__global__ void __launch_bounds__(NWAVES * 64, 2) fwd_kernel(Args args) {
    extern __shared__ __attribute__((aligned(16))) unsigned char lds[];
    cg::grid_group grid = cg::this_grid();
    Frame F;
    F.lds = (LAS unsigned char*)lds;
    F.kargs = (const __attribute__((address_space(4))) char*)__builtin_amdgcn_kernarg_segment_ptr();
    F.out = args.out; F.ws = args.ws; F.wave_s = __builtin_amdgcn_readfirstlane((int)threadIdx.x >> 6); phase_ctx(F);
    volatile LAS unsigned* MISC = (volatile LAS unsigned*)(F.lds + 131072 + 64);
    if (threadIdx.x < 16) MISC[threadIdx.x] = 0u;
    __syncthreads();
    XcdBarrier bar = xcd_barrier_post((unsigned*)(args.ws + WS_CTL) + 1024, MISC + 8);
    const int lo = args.ph_lo, hi = args.ph_hi;
    if (hi < 0) grid.sync();
#define IN(k) (((PH_MASK >> (k)) & 1) && lo <= (k) && (k) < hi)
#define SEAM(k) do { if (IN(k) && IN((k) + 1)) { phase_ctx(F); xcd_barrier(bar, F.tid == 0); } phase_ctx(F); } while (0)
    LAS unsigned char* ring = (LAS unsigned char*)lds;

    if (IN(0)) { p0_prologue(F); if (DUP_MASK & 1) p0_prologue(F); }
    SEAM(0);
    if (IN(1)) for (int rep_ = 0; rep_ < ((DUP_MASK & 2) ? 2 : 1); ++rep_) {
        { pg8::Gemm g{wsp<bf16>(F, WS_XB), wsp<bf16>(F, WS_WIN), T, NIN, DM, DM, DM}; pg8::StaticOrder S; S.init(g, F.G, (int)blockIdx.x);
          EpiInProj E{wsp<unsigned char>(F, 0)};
          pg8::gemm_phase<EpiInProj, pg8::StaticOrder, true, true>(ring, g, S, E, F.wave); }
        { pg8::Gemm g{wsp<bf16>(F, WS_MEMB), wsp<bf16>(F, WS_WKV), TM, 2048, DM, DM, DM}; pg8::StaticOrder S; S.init(g, F.G, (int)blockIdx.x);
          EpiRowScale<0> E{wsp<bf16>(F, WS_KVC), 2048, wsp<float>(F, WS_RSTDM), nullptr, 1.0f, F.lds + LDS_TP + F.wave * 2048};
          pg8::gemm_phase<EpiRowScale<0>, pg8::StaticOrder, true, true>(ring, g, S, E, F.wave); }
    }
    SEAM(1);
    if (IN(2)) { p2_ckv_norm(F); p2_index_v3(F); if (DUP_MASK & 4) { __syncthreads(); p2_index_v3(F); } __syncthreads(); phase_ctx(F); p3_dilated_v4<0>(F); if (DUP_MASK & 32) p3_dilated_v4<0>(F); }
    SEAM(2);
    if (IN(3)) { if (DUP_MASK & 0x1000) p3_dsa_mfma5<1>(F); if (DUP_MASK & 0x2000) p3_dsa_mfma5<2>(F); if (DUP_MASK & 0x4000) p3_dsa_mfma5<3>(F); p3_dsa_mfma5<0>(F); if (DUP_MASK & 8) p3_dsa_mfma5<0>(F); p3_dilated_v4<1>(F); if (DUP_MASK & 16) p3_dilated_v4<1>(F); }
    SEAM(3);
    if (IN(4)) {
        int k256 = 256; asm volatile("" : "+s"(k256));
        { pg8::Gemm g{wsp<bf16>(F, WS_KVC), wsp<bf16>(F, WS_WQ), TM, DM, k256, 2048, DM};
          PreOrderA S{(int)blockIdx.x, (const char*)wsp<bf16>(F, WS_KVC), (const char*)wsp<bf16>(F, WS_WQ)};
          EpiRowScale<2> E{wsp<bf16>(F, WS_MT), DM, nullptr, nullptr, 1.0f, F.lds + LDS_TP + F.wave * 2048};
          pg8::gemm_phase<EpiRowScale<2>, PreOrderA, true, true>(ring, g, S, E, F.wave); }
        __syncthreads(); phase_ctx(F);
        { pg8::Gemm g{wsp<bf16>(F, WS_WO), wsp<bf16>(F, WS_KVC), DM, TM, k256, DM, 2048};
          PreOrderB S{(int)blockIdx.x, (const char*)wsp<bf16>(F, WS_KVC), (const char*)wsp<bf16>(F, WS_WO)};
          EpiRowScale<2> E{wsp<bf16>(F, WS_MT), DM, nullptr, nullptr, 1.0f, F.lds + LDS_TP + F.wave * 2048};
          pg8::gemm_phase<EpiRowScale<2>, PreOrderB, true, true>(ring, g, S, E, F.wave); }
        __syncthreads(); phase_ctx(F);
        { pg8::Gemm g{wsp<bf16>(F, WS_HX), wsp<bf16>(F, WS_WOUT), T, DM, KOUT, KOUT, KOUT}; pg8::StaticOrder S; S.init(g, F.G, (int)blockIdx.x);
          EpiResid E{wsp<bf16>(F, WS_XB), wsp<float>(F, WS_P1)};
          pg8::gemm_phase<EpiResid, pg8::StaticOrder, true, true>(ring, g, S, E, F.wave); }
    }
    SEAM(4);
    if (IN(5)) for (int rep_ = 0; rep_ < ((DUP_MASK & 32) ? 2 : 1); ++rep_) {
        pg8::Gemm g{wsp<bf16>(F, WS_XB), wsp<bf16>(F, WS_MT), T, DM, DM, DM, DM}; BatchOrder S; S.so.init(g, F.G, (int)blockIdx.x); S.bstride = (size_t)DM * DM * 2;
        EpiSoftmaxP E{wsp<bf16>(F, WS_QC), (LAS float*)(F.lds + 131072 + 1024), wsp<float>(F, WS_P1)};
        pg8::gemm_phase<EpiSoftmaxP, BatchOrder, true, true>(ring, g, S, E, F.wave);
    }
    SEAM(5);
    if (IN(6)) {
        pg8::Gemm g{wsp<bf16>(F, WS_QC), wsp<bf16>(F, WS_MT) + (size_t)32768 * DM, T, DM, DM, DM, DM}; BatchOrder S; S.so.init(g, F.G, (int)blockIdx.x); S.bstride = (size_t)DM * DM * 2;
        EpiResid E{wsp<bf16>(F, WS_XB), wsp<float>(F, WS_P2)};
        pg8::gemm_phase<EpiResid, BatchOrder, true, true>(ring, g, S, E, F.wave);
    }
    SEAM(6);
    if (IN(7)) for (int rep_ = 0; rep_ < ((DUP_MASK & 64) ? 2 : 1); ++rep_) {
        pg8::Gemm g{wsp<bf16>(F, WS_XB), wsp<bf16>(F, WS_WUP), T, FF, DM, DM, DM}; pg8::StaticOrder S; S.init(g, F.G, (int)blockIdx.x);
        EpiRowScale<1> E{wsp<bf16>(F, WS_HID), FF, nullptr, wsp<float>(F, WS_P2), 1.0f, F.lds + LDS_TP + F.wave * 2048};
        pg8::gemm_phase<EpiRowScale<1>, pg8::StaticOrder, true, true>(ring, g, S, E, F.wave);
    }
    SEAM(7);
    if (IN(8)) {
        pg8::Gemm g{wsp<bf16>(F, WS_HID), wsp<bf16>(F, WS_WDN), T, DM, FF, FF, FF}; pg8::StaticOrder S; S.init(g, F.G, (int)blockIdx.x);
        EpiResid E{wsp<bf16>(F, WS_XB), wsp<float>(F, WS_P3)};
        pg8::gemm_phase<EpiResid, pg8::StaticOrder, true, true>(ring, g, S, E, F.wave);
    }
    SEAM(8);
    if (IN(9)) { p10_final(F); }
#undef IN
#undef SEAM
}

#ifndef N_LAUNCH_SPLIT
#define N_LAUNCH_SPLIT 0
#endif
extern "C" void kernel_launch(void* const* d_in, const int* in_sizes, int n_in, void* d_out, int out_size, void* d_ws, size_t ws_size, hipStream_t stream) {
    static int grid = 0;
    if (grid == 0) {
        if (n_in != 17 || out_size != T * DM || ws_size < WS_END) { fprintf(stderr, "kernel_launch: unexpected shapes: n_in %d out %d ws %zu\n", n_in, out_size, ws_size); grid = -1; return; }
        int dev = 0, cus = 0, per_cu = 0;
        if (hipGetDevice(&dev) != hipSuccess || hipDeviceGetAttribute(&cus, hipDeviceAttributeMultiprocessorCount, dev) != hipSuccess) { grid = -1; return; }
        if (hipFuncSetAttribute((const void*)fwd_kernel, hipFuncAttributeMaxDynamicSharedMemorySize, LDS_BYTES) != hipSuccess) { fprintf(stderr, "hipFuncSetAttribute failed\n"); grid = -1; return; }
        if (hipOccupancyMaxActiveBlocksPerMultiprocessor(&per_cu, (const void*)fwd_kernel, NWAVES * 64, LDS_BYTES) != hipSuccess || per_cu < 1) { fprintf(stderr, "occupancy query: %d\n", per_cu); per_cu = 1; }
        (void)hipGetLastError();
        grid = cus;
        fprintf(stderr, "kernel_launch: cus %d per_cu %d grid %d ws %zu\n", cus, per_cu, grid, ws_size);
    }
    if (grid < 0) return;
    if (hipMemsetAsync((char*)d_ws + WS_CTL, 0, 65536, stream) != hipSuccess) { fprintf(stderr, "memset failed\n"); return; }
    Args a{};
    for (int i = 0; i < 17; ++i) a.in[i] = (const float*)d_in[i];
    a.out = (float*)d_out; a.ws = (unsigned char*)d_ws;
#if N_LAUNCH_SPLIT
    for (int p = 0; p < 10; ++p) { a.ph_lo = p; a.ph_hi = p + 1; void* kargs[] = {&a};
        hipError_t e = hipLaunchCooperativeKernel((const void*)fwd_kernel, dim3(grid), dim3(NWAVES * 64), kargs, LDS_BYTES, stream);
        if (e != hipSuccess) { fprintf(stderr, "launch %d failed: %s\n", p, hipGetErrorString(e)); break; } }
#else
    a.ph_lo = 0; a.ph_hi = 10; void* kargs[] = {&a};
    hipError_t e = hipLaunchCooperativeKernel((const void*)fwd_kernel, dim3(grid), dim3(NWAVES * 64), kargs, LDS_BYTES, stream);
    if (e != hipSuccess) fprintf(stderr, "cooperative launch failed: %s (grid %d)\n", hipGetErrorString(e), grid);
#endif
}
```
